# Optimizing an MI355X kernel written in HIP

```python
import numpy as np
import jax
import jax.numpy as jnp
from jax import lax

D_MODEL = 2048
BATCH = 4
SEQ = 4096
DEPTH = 1

POOL_WINDOWS = (2, 4, 8, 16)
POOL_GROUPS = 4
POOL_WIDTH = D_MODEL // 2
POOL_GROUP_DIM = POOL_WIDTH // POOL_GROUPS

HEAD_DIM = 64
N_HEADS = (D_MODEL // 2) // HEAD_DIM
N_KV_GROUPS = 4
HEADS_PER_GROUP = N_HEADS // N_KV_GROUPS
Q_WIDTH = N_HEADS * HEAD_DIM
KV_WIDTH = N_KV_GROUPS * HEAD_DIM
CMP_BLOCK = 32
CMP_STRIDE = 16
CMP_HIDDEN = 256
SEL_BLOCK = 64
SEL_TOP_N = 16
WINDOW = 512
WIN_Q_BLOCK = 128
SEL_Q_BLOCK = 64
ROPE_THETA = 10000.0
FORCE_SCORE = 1e6

N_EXPERT_GROUPS = 8
EXPERTS_PER_GROUP = 8
N_EXPERTS = N_EXPERT_GROUPS * EXPERTS_PER_GROUP
EXPERT_HIDDEN = D_MODEL // 4
TOP_K = 2
EXPERT_ROW_BLOCK = 128

DN_ALPHA = (2.0 * DEPTH) ** 0.25
DN_BETA = (8.0 * DEPTH) ** -0.25
LN_EPS = 1e-5

IN_SPLIT_SIZES = (POOL_WIDTH, Q_WIDTH, KV_WIDTH, KV_WIDTH, KV_WIDTH, KV_WIDTH, KV_WIDTH, KV_WIDTH, 3 * N_HEADS, 2 * D_MODEL)
IN_COLS = POOL_WIDTH + Q_WIDTH + 6 * KV_WIDTH + 3 * N_HEADS + 2 * D_MODEL

kernel_name = "hybrid_pool_nsa_hmoe_deepnorm"


def layer_norm(x, g, b):
    xf = x.astype(jnp.float32)
    mu = jnp.mean(xf, axis=-1, keepdims=True)
    var = jnp.mean(jnp.square(xf - mu), axis=-1, keepdims=True)
    y = (xf - mu) * lax.rsqrt(var + LN_EPS) * g.astype(jnp.float32) + b.astype(jnp.float32)
    return y.astype(x.dtype)


def rope(x, pos):
    half = HEAD_DIM // 2
    inv_freq = ROPE_THETA ** (-2.0 * jnp.arange(half, dtype=jnp.float32) / HEAD_DIM)
    ang = pos.astype(jnp.float32)[:, None] * inv_freq[None, :]
    cos = jnp.cos(ang).astype(x.dtype)
    sin = jnp.sin(ang).astype(x.dtype)
    x1, x2 = x[..., :half], x[..., half:]
    return jnp.concatenate([x1 * cos - x2 * sin, x2 * cos + x1 * sin], axis=-1)


def masked_softmax(s, mask):
    s = s.astype(jnp.float32)
    m = jnp.max(jnp.where(mask, s, -jnp.inf), axis=-1, keepdims=True)
    e = jnp.exp(jnp.where(mask, s - m, -jnp.inf))
    return e / jnp.maximum(jnp.sum(e, axis=-1, keepdims=True), 1e-30)


def to_heads(t, n):
    b, s, _ = t.shape
    return t.reshape(b, s, n, HEAD_DIM).transpose(0, 2, 1, 3)


def pool_mixer(u, pool_mix, pool_scale):
    b, s, _ = u.shape
    ug = u.reshape(b, s, POOL_GROUPS, POOL_GROUP_DIM)
    cs = jnp.pad(jnp.cumsum(ug.astype(jnp.float32), axis=1), ((0, 0), (1, 0), (0, 0), (0, 0)))
    t = jnp.arange(s)
    means = []
    for g, w in enumerate(POOL_WINDOWS):
        cg = cs[:, :, g]
        lo = jnp.maximum(t + 1 - w, 0)
        cnt = jnp.minimum(t + 1, w).astype(jnp.float32)
        means.append((cg[:, 1:] - cg[:, lo]) / cnt[None, :, None])
    pooled = jnp.stack(means, axis=2).astype(u.dtype) - ug
    mixed = jnp.einsum('bsgc,gcd->bsgd', pooled, pool_mix)
    return mixed.reshape(b, s, POOL_WIDTH) * pool_scale


def compress_blocks(blocks, pos_emb, w1, w2):
    z = blocks + pos_emb
    z = z.reshape(z.shape[:-2] + (CMP_BLOCK * HEAD_DIM,))
    return jax.nn.gelu(z @ w1) @ w2


def native_sparse_attention(q, kc, vc, ks, vs, kw, vw, g_nsa, cmp_pos_k, cmp_pos_v,
                            cmp_k_w1, cmp_k_w2, cmp_v_w1, cmp_v_w2):
    b, s, _ = q.shape
    G, HG = N_KV_GROUPS, HEADS_PER_GROUP
    scale = HEAD_DIM ** -0.5
    pos = jnp.arange(s)
    qh = rope(to_heads(q, N_HEADS), pos).reshape(b, G, HG, s, HEAD_DIM)

    n_cmp = (s - CMP_BLOCK) // CMP_STRIDE + 1
    blk_idx = np.arange(n_cmp)[:, None] * CMP_STRIDE + np.arange(CMP_BLOCK)[None, :]
    cmp_end = blk_idx[:, -1]
    k_cmp = compress_blocks(to_heads(kc, G)[:, :, blk_idx], cmp_pos_k, cmp_k_w1, cmp_k_w2)
    k_cmp = rope(k_cmp, jnp.asarray(cmp_end))
    v_cmp = compress_blocks(to_heads(vc, G)[:, :, blk_idx], cmp_pos_v, cmp_v_w1, cmp_v_w2)
    s_cmp = jnp.einsum('bghqd,bgcd->bghqc', qh, k_cmp) * scale
    cmp_mask = jnp.asarray(cmp_end)[None, :] <= pos[:, None]
    p_cmp = masked_softmax(s_cmp, cmp_mask)
    o_cmp = jnp.einsum('bghqc,bgcd->bghqd', p_cmp.astype(v_cmp.dtype), v_cmp)

    n_sel = s // SEL_BLOCK
    top_n = min(SEL_TOP_N, n_sel)
    c_start = np.arange(n_cmp) * CMP_STRIDE
    s_start = np.arange(n_sel) * SEL_BLOCK
    overlap = ((c_start[:, None] + CMP_BLOCK - 1 >= s_start[None, :]) &
               (c_start[:, None] <= s_start[None, :] + SEL_BLOCK - 1)).astype(np.float32)
    imp = jnp.einsum('bghqc,cj->bgqj', p_cmp, jnp.asarray(overlap))
    cur = pos // SEL_BLOCK
    j = jnp.arange(n_sel)
    forced = (j[None, :] == 0) | (j[None, :] == cur[:, None]) | (j[None, :] == cur[:, None] - 1)
    future = j[None, :] > cur[:, None]
    imp = jnp.where(forced, FORCE_SCORE, jnp.where(future, -FORCE_SCORE, imp))
    _, sel_idx = lax.top_k(imp, top_n)

    k_sb = rope(to_heads(ks, G), pos).reshape(b, G, n_sel, SEL_BLOCK, HEAD_DIM)
    v_sb = to_heads(vs, G).reshape(b, G, n_sel, SEL_BLOCK, HEAD_DIM)
    nqb = s // SEL_Q_BLOCK
    q_blk = qh.reshape(b, G, HG, nqb, SEL_Q_BLOCK, HEAD_DIM).transpose(3, 0, 1, 2, 4, 5)
    idx_blk = sel_idx.reshape(b, G, nqb, SEL_Q_BLOCK, top_n).transpose(2, 0, 1, 3, 4)
    bi = jnp.arange(b)[:, None, None, None]
    gi = jnp.arange(G)[None, :, None, None]

    def sel_step(args):
        qb, ib, blk = args
        kg = k_sb[bi, gi, ib]
        vg = v_sb[bi, gi, ib]
        sc = jnp.einsum('bghqd,bgqnkd->bghqnk', qb, kg) * scale
        tq = blk * SEL_Q_BLOCK + jnp.arange(SEL_Q_BLOCK)
        kpos = ib[..., None] * SEL_BLOCK + jnp.arange(SEL_BLOCK)
        mask = (kpos <= tq[:, None, None]).reshape(b, G, 1, SEL_Q_BLOCK, top_n * SEL_BLOCK)
        p = masked_softmax(sc.reshape(b, G, HG, SEL_Q_BLOCK, top_n * SEL_BLOCK), mask)
        p = p.reshape(sc.shape).astype(vg.dtype)
        return jnp.einsum('bghqnk,bgqnkd->bghqd', p, vg)

    o_slc = lax.map(sel_step, (q_blk, idx_blk, jnp.arange(nqb)))
    o_slc = o_slc.transpose(1, 2, 3, 0, 4, 5).reshape(b, G, HG, s, HEAD_DIM)

    k_w = rope(to_heads(kw, G), pos)
    v_w = to_heads(vw, G)
    kpad = jnp.pad(k_w, ((0, 0), (0, 0), (WINDOW, 0), (0, 0)))
    vpad = jnp.pad(v_w, ((0, 0), (0, 0), (WINDOW, 0), (0, 0)))
    span = WINDOW + WIN_Q_BLOCK
    nwb = s // WIN_Q_BLOCK
    q_wblk = qh.reshape(b, G, HG, nwb, WIN_Q_BLOCK, HEAD_DIM).transpose(3, 0, 1, 2, 4, 5)

    def win_step(args):
        qb, blk = args
        start = blk * WIN_Q_BLOCK
        kb = lax.dynamic_slice_in_dim(kpad, start, span, axis=2)
        vb = lax.dynamic_slice_in_dim(vpad, start, span, axis=2)
        sc = jnp.einsum('bghqd,bgkd->bghqk', qb, kb) * scale
        tq = start + jnp.arange(WIN_Q_BLOCK)
        kpos = start - WINDOW + jnp.arange(span)
        mask = ((kpos[None, :] <= tq[:, None]) & (kpos[None, :] > tq[:, None] - WINDOW)
                & (kpos[None, :] >= 0))
        p = masked_softmax(sc, mask).astype(vb.dtype)
        return jnp.einsum('bghqk,bgkd->bghqd', p, vb)

    o_win = lax.map(win_step, (q_wblk, jnp.arange(nwb)))
    o_win = o_win.transpose(1, 2, 3, 0, 4, 5).reshape(b, G, HG, s, HEAD_DIM)

    g = jax.nn.sigmoid(g_nsa.astype(jnp.float32)).astype(q.dtype)
    g = g.reshape(b, s, 3, G, HG).transpose(2, 0, 3, 4, 1)[..., None]
    o = g[0] * o_cmp + g[1] * o_slc + g[2] * o_win
    return o.reshape(b, N_HEADS, s, HEAD_DIM).transpose(0, 2, 1, 3).reshape(b, s, Q_WIDTH)


def token_mixer(h, w_in, pool_mix, pool_scale, w_pool_proj, w_nsa_proj, cmp_pos_k, cmp_pos_v,
                cmp_k_w1, cmp_k_w2, cmp_v_w1, cmp_v_w2, w_out):
    proj = h @ w_in
    points = [int(v) for v in np.cumsum(IN_SPLIT_SIZES)[:-1]]
    u_pool, q, kc, vc, ks, vs, kw, vw, g_nsa, g_merge = jnp.split(proj, points, axis=-1)
    y_pool = pool_mixer(u_pool, pool_mix, pool_scale) @ w_pool_proj
    y_attn = native_sparse_attention(q, kc, vc, ks, vs, kw, vw, g_nsa, cmp_pos_k, cmp_pos_v,
                                     cmp_k_w1, cmp_k_w2, cmp_v_w1, cmp_v_w2) @ w_nsa_proj
    gates = jax.nn.sigmoid(g_merge.astype(jnp.float32)).astype(h.dtype)
    g_pool, g_attn = gates[..., :D_MODEL], gates[..., D_MODEL:]
    return (g_pool * y_pool + g_attn * y_attn) @ w_out


def hierarchical_moe(h, router_group_w, router_group_b, router_expert_w, router_expert_b,
                     w_gate, w_up, w_down):
    b, s, d = h.shape
    n = b * s
    t = h.reshape(n, d)
    gl = (t @ router_group_w + router_group_b).astype(jnp.float32)
    gp = jax.nn.softmax(gl, axis=-1)
    grp = jnp.argmax(gl, axis=-1)
    g_gate = jnp.take_along_axis(gp, grp[:, None], axis=1)[:, 0]
    el = jnp.einsum('nd,gde->nge', t, router_expert_w) + router_expert_b
    el = jnp.take_along_axis(el, grp[:, None, None], axis=1)[:, 0].astype(jnp.float32)
    top_v, top_i = lax.top_k(el, TOP_K)
    wts = jax.nn.softmax(top_v, axis=-1) * g_gate[:, None]
    eid = grp[:, None] * EXPERTS_PER_GROUP + top_i
    m = n * TOP_K
    flat_e = eid.reshape(-1)
    order = jnp.argsort(flat_e)
    sorted_e = flat_e[order]
    tok = order // TOP_K
    w_sorted = wts.reshape(-1)[order]
    sizes = jnp.bincount(flat_e, length=N_EXPERTS)
    padded = (sizes + EXPERT_ROW_BLOCK - 1) // EXPERT_ROW_BLOCK * EXPERT_ROW_BLOCK
    ends = jnp.cumsum(padded)
    group_start = jnp.cumsum(sizes) - sizes
    dest = (ends - padded)[sorted_e] + (jnp.arange(m) - group_start[sorted_e])
    n_blk = -(-(m + N_EXPERTS * (EXPERT_ROW_BLOCK - 1)) // EXPERT_ROW_BLOCK)
    rows = n_blk * EXPERT_ROW_BLOCK
    xbuf = jnp.zeros((rows, d), t.dtype).at[dest].set(t[tok])
    blk_e = jnp.minimum(jnp.searchsorted(ends, jnp.arange(n_blk) * EXPERT_ROW_BLOCK, side='right'),
                        N_EXPERTS - 1)

    def expert_block(args):
        xb, e = args
        return (jax.nn.silu(xb @ w_gate[e]) * (xb @ w_up[e])) @ w_down[e]

    ybuf = lax.map(expert_block, (xbuf.reshape(n_blk, EXPERT_ROW_BLOCK, d), blk_e)).reshape(rows, d)
    contrib = ybuf[dest] * w_sorted[:, None].astype(t.dtype)
    y = jnp.zeros_like(t).at[tok].add(contrib)
    return y.reshape(b, s, d)


def setup_inputs(seed: int = 0) -> dict:
    key = jax.random.key(seed)
    ks = jax.random.split(key, 26)
    L, D = DEPTH, D_MODEL

    def nrm(k, shape, scale):
        return jax.random.normal(k, shape, jnp.float32) * scale

    return {
        "x": nrm(ks[0], (BATCH, SEQ, D), 1.0),
        "w_in": nrm(ks[1], (L, D, IN_COLS), D ** -0.5),
        "pool_mix": nrm(ks[2], (L, POOL_GROUPS, POOL_GROUP_DIM, POOL_GROUP_DIM), POOL_GROUP_DIM ** -0.5),
        "pool_scale": 1.0 + nrm(ks[3], (L, POOL_WIDTH), 0.1),
        "w_pool_proj": nrm(ks[4], (L, POOL_WIDTH, D), POOL_WIDTH ** -0.5),
        "w_nsa_proj": nrm(ks[5], (L, Q_WIDTH, D), Q_WIDTH ** -0.5),
        "cmp_pos_k": nrm(ks[6], (L, CMP_BLOCK, HEAD_DIM), 0.1),
        "cmp_pos_v": nrm(ks[7], (L, CMP_BLOCK, HEAD_DIM), 0.1),
        "cmp_k_w1": nrm(ks[8], (L, CMP_BLOCK * HEAD_DIM, CMP_HIDDEN), (CMP_BLOCK * HEAD_DIM) ** -0.5),
        "cmp_k_w2": nrm(ks[9], (L, CMP_HIDDEN, HEAD_DIM), CMP_HIDDEN ** -0.5),
        "cmp_v_w1": nrm(ks[10], (L, CMP_BLOCK * HEAD_DIM, CMP_HIDDEN), (CMP_BLOCK * HEAD_DIM) ** -0.5),
        "cmp_v_w2": nrm(ks[11], (L, CMP_HIDDEN, HEAD_DIM), CMP_HIDDEN ** -0.5),
        "w_out": nrm(ks[12], (L, D, D), D ** -0.5 * DN_BETA),
        "ln1_g": 1.0 + nrm(ks[13], (L, D), 0.05),
        "ln1_b": nrm(ks[14], (L, D), 0.02),
        "router_group_w": nrm(ks[15], (L, D, N_EXPERT_GROUPS), D ** -0.5),
        "router_group_b": nrm(ks[16], (L, N_EXPERT_GROUPS), 0.01),
        "router_expert_w": nrm(ks[17], (L, N_EXPERT_GROUPS, D, EXPERTS_PER_GROUP), D ** -0.5),
        "router_expert_b": nrm(ks[18], (L, N_EXPERT_GROUPS, EXPERTS_PER_GROUP), 0.01),
        "w_gate": nrm(ks[19], (L, N_EXPERTS, D, EXPERT_HIDDEN), D ** -0.5),
        "w_up": nrm(ks[20], (L, N_EXPERTS, D, EXPERT_HIDDEN), D ** -0.5),
        "w_down": nrm(ks[21], (L, N_EXPERTS, EXPERT_HIDDEN, D), EXPERT_HIDDEN ** -0.5 * DN_BETA),
        "ln2_g": 1.0 + nrm(ks[22], (L, D), 0.05),
        "ln2_b": nrm(ks[23], (L, D), 0.02),
    }


def reference(x, w_in, pool_mix, pool_scale, w_pool_proj, w_nsa_proj, cmp_pos_k, cmp_pos_v,
              cmp_k_w1, cmp_k_w2, cmp_v_w1, cmp_v_w2, w_out, ln1_g, ln1_b,
              router_group_w, router_group_b, router_expert_w, router_expert_b,
              w_gate, w_up, w_down, ln2_g, ln2_b):
    h = x
    for l in range(DEPTH):
        y = token_mixer(h, w_in[l], pool_mix[l], pool_scale[l], w_pool_proj[l], w_nsa_proj[l],
                        cmp_pos_k[l], cmp_pos_v[l], cmp_k_w1[l], cmp_k_w2[l], cmp_v_w1[l],
                        cmp_v_w2[l], w_out[l])
        h = layer_norm(DN_ALPHA * h + y, ln1_g[l], ln1_b[l])
        y = hierarchical_moe(h, router_group_w[l], router_group_b[l], router_expert_w[l],
                             router_expert_b[l], w_gate[l], w_up[l], w_down[l])
        h = layer_norm(DN_ALPHA * h + y, ln2_g[l], ln2_b[l])
    return h
```

```cpp
#include <hip/hip_runtime.h>
#include <hip/hip_cooperative_groups.h>
#include <cstdio>
#include <cstdint>
namespace cg = cooperative_groups;

#ifndef MK_PER_PHASE_LAUNCH
#define MK_PER_PHASE_LAUNCH 1
#endif

#define GAS __attribute__((address_space(1)))
#define LAS __attribute__((address_space(3)))
typedef unsigned short bf16_t;
typedef short bf16x8 __attribute__((ext_vector_type(8)));
typedef short s16x4 __attribute__((ext_vector_type(4)));
typedef float f32x2 __attribute__((ext_vector_type(2)));
typedef float f32x4 __attribute__((ext_vector_type(4)));
typedef float f32x16 __attribute__((ext_vector_type(16)));
typedef unsigned u32x2 __attribute__((ext_vector_type(2)));
typedef unsigned u32x4 __attribute__((ext_vector_type(4)));
typedef unsigned long long u64;

constexpr int NB = 4, SEQ = 4096, DM = 2048, NT = NB * SEQ;
constexpr int NH = 16, HD = 64, NG = 4;
constexpr int PW = 1024;
constexpr int IN_COLS = 7728, IN_PAD = 7936;
constexpr int NE = 64, EH = 512;
constexpr int MPAD = 49152;
constexpr float DN_ALPHA = 1.18920711500272f;
constexpr float LN_EPS = 1e-5f;
constexpr float C2 = 0.125f * 1.4426950408889634f;
constexpr int NPHASE = 12;
#ifndef DBG_NPH
#define DBG_NPH NPHASE
#endif
#define DBG_OFF (504ull << 20)
#define DBG_LD 4096
#define DBG_COLS 2048
#define DBG_ROWS 16384

constexpr size_t MiB = 1u << 20;
constexpr size_t WS_CTL = 0, CTL_ZERO_BYTES = 1 * MiB;
constexpr size_t WS_WGU = 1 * MiB, WS_WD = 257 * MiB, WS_WIN = 385 * MiB, WS_WPP = 416 * MiB, WS_WNP = 420 * MiB, WS_WO = 424 * MiB, WS_PM = 432 * MiB;
constexpr size_t WS_CW1K = 433 * MiB, WS_CW1V = 434 * MiB, WS_CW2K = 435 * MiB, WS_CW2V = 435 * MiB + 65536, WS_WRH = 436 * MiB, WS_WRL = 436 * MiB + 512 * 1024;
constexpr size_t WS_ROPE = 437 * MiB, WS_CBIAS = 438 * MiB;
constexpr size_t WS_XB = 440 * MiB, WS_POOLED = 440 * MiB, WS_MIXED = 472 * MiB, WS_H1B = 440 * MiB;
constexpr size_t WS_GM = 504 * MiB, WS_U = 632 * MiB, WS_Q = 664 * MiB;
constexpr size_t WS_KC = 696 * MiB, WS_VC = 705 * MiB, WS_KS = 714 * MiB, WS_VS = 722 * MiB, WS_KW = 730 * MiB, WS_VW = 738 * MiB;
constexpr size_t WS_GN = 746 * MiB, WS_KCMP = 750 * MiB, WS_VCMP = 750 * MiB + 512 * 1024, WS_HK = 751 * MiB, WS_HV = 753 * MiB;
constexpr size_t WS_ZP = 756 * MiB, WS_O = 820 * MiB, WS_Z = 852 * MiB;
constexpr size_t WS_STATS = 916 * MiB, WS_RTE = 917 * MiB, WS_RTW = 917 * MiB + 256 * 1024, WS_RTP = 917 * MiB + 512 * 1024, WS_ROWMAP = 919 * MiB, WS_ROWW = 920 * MiB;
constexpr size_t WS_XBUF = 504 * MiB, WS_HID = 696 * MiB, WS_YB = 756 * MiB;
constexpr size_t WS_END = 921 * MiB;
constexpr int CW_BAR = 4096, CW_CNT = 8192;

constexpr int RING_BYTES = 131072;
constexpr int MISC_OFF = 132096;
constexpr int TAB_OFF = MISC_OFF + 256;
constexpr int LDS_BYTES = 163840;

#define RLX_AGENT __ATOMIC_RELAXED, __HIP_MEMORY_SCOPE_AGENT
__device__ __forceinline__ unsigned f2bf(float f) { unsigned u = __builtin_bit_cast(unsigned, f); return (u + 0x7fffu + ((u >> 16) & 1u)) >> 16; }
__device__ __forceinline__ unsigned pk2(float lo, float hi) { return f2bf(lo) | (f2bf(hi) << 16); }
__device__ __forceinline__ float bf2f(unsigned short b) { return __builtin_bit_cast(float, (unsigned)b << 16); }
__device__ __forceinline__ float bflo(unsigned w) { return __builtin_bit_cast(float, w << 16); }
__device__ __forceinline__ float bfhi(unsigned w) { return __builtin_bit_cast(float, w & 0xffff0000u); }
typedef __bf16 bf16x2_t __attribute__((ext_vector_type(2)));
__device__ __forceinline__ unsigned cvt_pk_bf16(float lo, float hi) { const f32x2 v = {lo, hi}; const bf16x2_t b = __builtin_convertvector(v, bf16x2_t); return __builtin_bit_cast(unsigned, b); }
__device__ __forceinline__ void store8(bf16_t* p, f32x4 a, f32x4 b) { u32x4 w; w.x = cvt_pk_bf16(a[0], a[1]); w.y = cvt_pk_bf16(a[2], a[3]); w.z = cvt_pk_bf16(b[0], b[1]); w.w = cvt_pk_bf16(b[2], b[3]); *(u32x4*)p = w; }
__device__ __forceinline__ void load8(const bf16_t* p, f32x4& a, f32x4& b) { const u32x4 w = *(const u32x4*)p; a = (f32x4){bflo(w.x), bfhi(w.x), bflo(w.y), bfhi(w.y)}; b = (f32x4){bflo(w.z), bfhi(w.z), bflo(w.w), bfhi(w.w)}; }
__device__ __forceinline__ float fast_exp2(float x) { return __builtin_amdgcn_exp2f(x); }
__device__ __forceinline__ float sigmoidf_(float x) { return __builtin_amdgcn_rcpf(1.f + fast_exp2(-1.4426950408889634f * x)); }
__device__ __forceinline__ f32x4 sigmoid4(f32x4 v) { return (f32x4){sigmoidf_(v[0]), sigmoidf_(v[1]), sigmoidf_(v[2]), sigmoidf_(v[3])}; }
__device__ __forceinline__ float gelu_tanh(float x) { const float y = 0.7978845608028654f * (x + 0.044715f * x * x * x); const float e = fast_exp2(2.f * 1.4426950408889634f * y); const float th = 1.f - 2.f * __builtin_amdgcn_rcpf(e + 1.f); return 0.5f * x * (1.f + th); }
__device__ __forceinline__ float wave_sum(float v) {
#pragma unroll
    for (int o = 1; o < 64; o <<= 1) v += __shfl_xor(v, o);
    return v;
}

namespace pg8 {
constexpr int BM = 256, BK = 64, HALF = 128, HTB = HALF * BK * 2, STAGE_BYTES = 8 * HTB;
__host__ __device__ __forceinline__ int lds_byte(int r, int c) { const int st = (r >> 4) * 2 + (c >> 5), rr = r & 15, cc = c & 31, ob = rr * 64 + cc * 2; return st * 1024 + (ob ^ (((ob >> 9) & 1) << 5)); }
__host__ __device__ __forceinline__ void stage_rc(int b, int& R, int& C) { const int st = b / 1024, sb = b % 1024, swz = sb ^ (((sb >> 9) & 1) << 5); R = (st >> 1) * 16 + swz / 64; C = (st & 1) * 32 + (swz % 64) / 2; }
__host__ __device__ __forceinline__ int perm32(int rho) { const int n = rho >> 4, i = rho & 15; return 8 * (i >> 2) + 4 * n + (i & 3); }

struct Unit { int pm, pn; const char* a; const char* b; };
struct Gemm { int K; unsigned lda, ldb; };

template <class Epi, class Sched, bool ALIGN_EPI>
__device__ __forceinline__ void gemm_phase(LAS unsigned char* lds, const Gemm g, const Sched& S, const Epi& E) {
    const int tid = threadIdx.x, wid = __builtin_amdgcn_readfirstlane(tid >> 6), lane = tid & 63, wr = wid >> 2, wc = wid & 3, fr = lane & 15, fq = lane >> 4;
    const int K = g.K, nt = K / BK;
    unsigned voffA[2], voffB[2];
#pragma unroll
    for (int i = 0; i < 2; ++i) { int R, C; stage_rc(tid * 16 + i * 8192, R, C); const int Rb = Epi::PERM ? ((R & ~31) + perm32(R & 31)) : R;
        voffA[i] = (unsigned)R * g.lda + (unsigned)C * 2u; voffB[i] = (unsigned)Rb * g.ldb + (unsigned)C * 2u; }
    const size_t kstep = (size_t)(BK * 2);
    const size_t hstepA = (size_t)HALF * g.lda, hstepB = (size_t)HALF * g.ldb;
    const unsigned ldsw = (unsigned)wid * 1024u;
    const int aoff = lds_byte(wr * 64 + fr, fq * 8), boff = lds_byte(wc * 32 + fr, fq * 8);
#define PG8_SA(b, h) (((b) * 2 + (h)) * HTB)
#define PG8_SB(b, h) ((4 + (b) * 2 + (h)) * HTB)
#define PG8_STAGE(bufoff, gbase, voff) do { _Pragma("unroll") for (int _i = 0; _i < 2; ++_i) \
        __builtin_amdgcn_global_load_lds((const unsigned*)((const char*)(gbase) + (voff)[_i]), (LAS unsigned*)(lds + (bufoff) + ldsw + _i * 8192), 16, 0, 0); } while (0)
#define PG8_LDA(dst, b, h) do { _Pragma("unroll") for (int m = 0; m < 4; ++m) _Pragma("unroll") for (int k = 0; k < 2; ++k) dst[m][k] = *(const LAS bf16x8*)(lds + PG8_SA(b, h) + aoff + m * 2048 + k * 1024); } while (0)
#define PG8_LDB(dst, b, h) do { _Pragma("unroll") for (int n = 0; n < 2; ++n) _Pragma("unroll") for (int k = 0; k < 2; ++k) dst[n][k] = *(const LAS bf16x8*)(lds + PG8_SB(b, h) + boff + n * 2048 + k * 1024); } while (0)
#define PG8_MMA(ai, bj, At, Bt) do { __builtin_amdgcn_s_setprio(1); _Pragma("unroll") for (int m = 0; m < 4; ++m) _Pragma("unroll") for (int n = 0; n < 2; ++n) _Pragma("unroll") for (int k = 0; k < 2; ++k) \
        acc[ai][bj][m][n] = __builtin_amdgcn_mfma_f32_16x16x32_bf16(Bt[n][k], At[m][k], acc[ai][bj][m][n], 0, 0, 0); __builtin_amdgcn_s_setprio(0); } while (0)
#define PG8_WAIT_V(n) asm volatile("s_waitcnt vmcnt(" #n ")" ::: "memory")
#define PG8_WAIT_L(n) asm volatile("s_waitcnt lgkmcnt(" #n ")" ::: "memory")
#define PG8_BAR __builtin_amdgcn_s_barrier()
#define PG8_SCHED __builtin_amdgcn_sched_barrier(0)
    Unit cur, nxt; int ui = 0;
    if (!S.next(0, cur)) return;
    f32x4 acc[2][2][4][2];
#pragma unroll
    for (int a = 0; a < 2; ++a)
#pragma unroll
        for (int b = 0; b < 2; ++b)
#pragma unroll
            for (int m = 0; m < 4; ++m)
#pragma unroll
                for (int n = 0; n < 2; ++n) acc[a][b][m][n] = (f32x4){0.f, 0.f, 0.f, 0.f};
    bf16x8 At[4][2], B0[2][2], B1[2][2];
    const char* cA = cur.a; const char* cB = cur.b;
    PG8_STAGE(PG8_SB(0, 0), cB, voffB); PG8_STAGE(PG8_SB(0, 1), cB + hstepB, voffB); PG8_STAGE(PG8_SA(0, 0), cA, voffA); PG8_STAGE(PG8_SA(0, 1), cA + hstepA, voffA);
    if (wr == 1) PG8_BAR;
    PG8_WAIT_V(2); PG8_BAR;
    PG8_STAGE(PG8_SB(1, 0), cB + kstep, voffB); PG8_STAGE(PG8_SA(1, 0), cA + kstep, voffA); PG8_STAGE(PG8_SB(1, 1), cB + hstepB + kstep, voffB);
    PG8_WAIT_V(6); PG8_BAR;
    for (;;) {
        const bool has_next = S.next(ui + 1, nxt);
        const char* nA = has_next ? nxt.a : cA; const char* nB = has_next ? nxt.b : cB;
#pragma unroll 1
        for (int t = 0; t < nt; t += 2) {
            const bool last = (t == nt - 2);
            const char* a1 = cA + (size_t)(t + 1) * kstep;
            const char* a2 = last ? nA : cA + (size_t)(t + 2) * kstep; const char* b2 = last ? nB : cB + (size_t)(t + 2) * kstep;
            const char* a3 = a2 + kstep; const char* b3 = b2 + kstep;
            PG8_LDB(B0, 0, 0); PG8_LDB(B1, 0, 1); PG8_SCHED; PG8_LDA(At, 0, 0); PG8_STAGE(PG8_SA(1, 1), a1 + hstepA, voffA);
            PG8_WAIT_V(8); PG8_WAIT_L(0); PG8_BAR; PG8_MMA(0, 0, At, B0); PG8_MMA(0, 1, At, B1); PG8_BAR; PG8_SCHED;
            PG8_LDA(At, 0, 1); PG8_STAGE(PG8_SB(0, 0), b2, voffB); PG8_STAGE(PG8_SB(0, 1), b2 + hstepB, voffB); PG8_STAGE(PG8_SA(0, 0), a2, voffA);
            PG8_WAIT_V(8); PG8_WAIT_L(0); PG8_BAR; PG8_MMA(1, 0, At, B0); PG8_MMA(1, 1, At, B1); PG8_BAR; PG8_SCHED;
            PG8_LDB(B0, 1, 0); PG8_LDB(B1, 1, 1); PG8_SCHED; PG8_LDA(At, 1, 0); PG8_STAGE(PG8_SA(0, 1), a2 + hstepA, voffA);
            PG8_WAIT_V(8); PG8_WAIT_L(0); PG8_BAR; PG8_MMA(0, 0, At, B0); PG8_MMA(0, 1, At, B1); PG8_BAR; PG8_SCHED;
            PG8_LDA(At, 1, 1); PG8_STAGE(PG8_SB(1, 0), b3, voffB); PG8_STAGE(PG8_SB(1, 1), b3 + hstepB, voffB); PG8_STAGE(PG8_SA(1, 0), a3, voffA);
            PG8_WAIT_V(8); PG8_WAIT_L(0); PG8_BAR; PG8_MMA(1, 0, At, B0); PG8_MMA(1, 1, At, B1); PG8_BAR; PG8_SCHED;
        }
        if constexpr (ALIGN_EPI) { if (wr == 0) PG8_BAR; }
        E(acc, cur, wr, wc, fr, fq);
        if (!has_next) break;
#pragma unroll
        for (int a = 0; a < 2; ++a)
#pragma unroll
            for (int b = 0; b < 2; ++b)
#pragma unroll
                for (int m = 0; m < 4; ++m)
#pragma unroll
                    for (int n = 0; n < 2; ++n) acc[a][b][m][n] = (f32x4){0.f, 0.f, 0.f, 0.f};
        cur = nxt; cA = nA; cB = nB; ++ui;
        if constexpr (ALIGN_EPI) { if (wr == 1) PG8_BAR; }
    }
    PG8_WAIT_V(0);
    if constexpr (!ALIGN_EPI) { if (wr == 0) PG8_BAR; }
    PG8_BAR;
#undef PG8_SA
#undef PG8_SB
#undef PG8_STAGE
#undef PG8_LDA
#undef PG8_LDB
#undef PG8_MMA
#undef PG8_WAIT_V
#undef PG8_WAIT_L
#undef PG8_BAR
#undef PG8_SCHED
}
}
using pg8::Unit;

struct RectSched {
    int nM, nN, nwg, G, c; const char* A; const char* B; size_t tA, tB;
    __device__ void init(int M, int N, int G_, int c_, const void* A_, unsigned lda, const void* B_, unsigned ldb) { nM = M / 256; nN = N / 256; nwg = nM * nN; G = G_; c = c_; A = (const char*)A_; B = (const char*)B_; tA = (size_t)256 * lda; tB = (size_t)256 * ldb; }
    __device__ bool next(int i, Unit& u) const {
        const long L = (long)i * G + c; if (L >= nwg) return false;
        int wgid = (int)L; { const int q = nwg / 8, r = nwg % 8, xcd = wgid % 8, off = wgid / 8; wgid = (xcd < r ? xcd * (q + 1) : r * (q + 1) + (xcd - r) * q) + off; }
        const int nig = 8 * nN, gid = wgid / nig, fm = gid * 8, gsz = (nM - fm) < 8 ? (nM - fm) : 8;
        u.pm = fm + ((wgid % nig) % gsz); u.pn = (wgid % nig) / gsz; u.a = A + (size_t)u.pm * tA; u.b = B + (size_t)u.pn * tB; return true;
    }
};
struct CmpSched {
    int vcu; const char* A0; const char* A1; const char* B0; const char* B1;
    __device__ bool next(int i, Unit& u) const { if (i > 0 || vcu >= 32) return false; u.pm = vcu & 15; u.pn = vcu >> 4; u.a = (u.pn ? A1 : A0) + (size_t)u.pm * 256 * 2048; u.b = u.pn ? B1 : B0; return true; }
};
struct MixSched {
    int vcu, G; const char* A; const char* B;
    __device__ bool next(int i, Unit& u) const { const int L = i * G + vcu; if (L >= 256) return false; u.pm = L >> 2; u.pn = L & 3; u.a = A + (size_t)u.pm * 256 * 2048 + u.pn * 512; u.b = B + (size_t)u.pn * 256 * 512; return true; }
};
template <int NCT, int NEXP_ROWS  > struct MoeSched {
    int vcu, G, ntile; const char* A; const char* B; unsigned lda, ldb; const LAS int* texp;
    __device__ bool next(int i, Unit& u) const { const int L = i * G + vcu; if (L >= ntile * NCT) return false; u.pm = L / NCT; u.pn = L % NCT; const int e = texp[u.pm];
        u.a = A + (size_t)u.pm * 256 * lda; u.b = B + ((size_t)e * NEXP_ROWS + (size_t)u.pn * 256) * ldb; return true; }
};

struct EpiInProj {
    static constexpr bool PERM = true;
    bf16_t* U; bf16_t* Q; bf16_t* KVb; bf16_t* GM; float* GN; const f32x4* rope;
    __device__ __forceinline__ void operator()(const f32x4 (&acc)[2][2][4][2], const Unit& u, int wr, int wc, int fr, int fq) const {
        const int pn = u.pn, row0 = u.pm * 256 + wr * 64 + fr, cit = wc * 32 + 8 * fq;
        if (pn < 4) {
#pragma unroll
            for (int ai = 0; ai < 2; ++ai)
#pragma unroll
                for (int m = 0; m < 4; ++m) { bf16_t* rp = U + (size_t)(row0 + ai * 128 + m * 16) * PW + pn * 256 + cit;
#pragma unroll
                    for (int bj = 0; bj < 2; ++bj) store8(rp + bj * 128, acc[ai][bj][m][0], acc[ai][bj][m][1]); }
        } else if (pn < 14) {
            const bool isq = pn < 8; const int kind = pn - 8; const bool dorope = isq || kind == 2 || kind == 4;
            const int p0 = 32 * (wc & 1) + 8 * fq, gI = 4 * (wc & 1) + fq;
            const size_t kvo = kind == 1 ? (WS_VC - WS_KC) : kind == 2 ? (WS_KS - WS_KC) : kind == 3 ? (WS_VS - WS_KC) : kind == 4 ? (WS_KW - WS_KC) : kind == 5 ? (WS_VW - WS_KC) : 0;
            bf16_t* base = isq ? Q : (bf16_t*)((char*)KVb + kvo);
            const float sc = isq ? C2 : 1.f;
#pragma unroll
            for (int ai = 0; ai < 2; ++ai)
#pragma unroll
                for (int m = 0; m < 4; ++m) { const int row = row0 + ai * 128 + m * 16, b = row >> 12, t = row & 4095;
                    f32x4 cs0 = (f32x4){1.f, 0.f, 1.f, 0.f}, cs1 = cs0;
                    if (dorope) { cs0 = rope[t * 16 + gI * 2]; cs1 = rope[t * 16 + gI * 2 + 1]; }
#pragma unroll
                    for (int bj = 0; bj < 2; ++bj) { const int hit = 2 * bj + (wc >> 1);
                        const f32x4 x1 = acc[ai][bj][m][0], x2 = acc[ai][bj][m][1];
                        const f32x4 c = (f32x4){cs0[0], cs0[2], cs1[0], cs1[2]}, s = (f32x4){cs0[1], cs0[3], cs1[1], cs1[3]};
                        const f32x4 y1 = (x1 * c - x2 * s) * sc, y2 = (x2 * c + x1 * s) * sc;
                        const size_t hrow = isq ? ((size_t)(b * NH + (pn - 4) * 4 + hit) * SEQ + t) : ((size_t)(b * NG + hit) * SEQ + t);
                        store8(base + hrow * HD + p0, y1, y2); } }
        } else if (pn < 30) {
#pragma unroll
            for (int ai = 0; ai < 2; ++ai)
#pragma unroll
                for (int m = 0; m < 4; ++m) { bf16_t* rp = GM + (size_t)(row0 + ai * 128 + m * 16) * 4096 + (pn - 14) * 256 + cit;
#pragma unroll
                    for (int bj = 0; bj < 2; ++bj) store8(rp + bj * 128, sigmoid4(acc[ai][bj][m][0]), sigmoid4(acc[ai][bj][m][1])); }
        } else {
            if (wc < 2) {
#pragma unroll
                for (int ai = 0; ai < 2; ++ai)
#pragma unroll
                    for (int m = 0; m < 4; ++m) { float* rp = GN + (size_t)(row0 + ai * 128 + m * 16) * 64;
#pragma unroll
                        for (int n = 0; n < 2; ++n) { const int col = cit + 4 * n; if (col < 48) *(f32x4*)(rp + col) = sigmoid4(acc[ai][0][m][n]); } }
            }
        }
    }
};
struct EpiCmp1 {
    static constexpr bool PERM = true;
    bf16_t* H0; bf16_t* H1; const float* bias;
    __device__ __forceinline__ void operator()(const f32x4 (&acc)[2][2][4][2], const Unit& u, int wr, int wc, int fr, int fq) const {
        const int row0 = u.pm * 256 + wr * 64 + fr, cit = wc * 32 + 8 * fq; bf16_t* out = u.pn ? H1 : H0; const float* bs = bias + u.pn * 256;
#pragma unroll
        for (int bj = 0; bj < 2; ++bj) { const f32x4 b0 = *(const f32x4*)(bs + bj * 128 + cit), b1 = *(const f32x4*)(bs + bj * 128 + cit + 4);
#pragma unroll
            for (int ai = 0; ai < 2; ++ai)
#pragma unroll
                for (int m = 0; m < 4; ++m) { f32x4 v0 = acc[ai][bj][m][0] + b0, v1 = acc[ai][bj][m][1] + b1;
#pragma unroll
                    for (int j = 0; j < 4; ++j) { v0[j] = gelu_tanh(v0[j]); v1[j] = gelu_tanh(v1[j]); }
                    store8(out + (size_t)(row0 + ai * 128 + m * 16) * 256 + bj * 128 + cit, v0, v1); } }
    }
};
struct EpiMix {
    static constexpr bool PERM = true;
    bf16_t* out; const float* scale;
    __device__ __forceinline__ void operator()(const f32x4 (&acc)[2][2][4][2], const Unit& u, int wr, int wc, int fr, int fq) const {
        const int row0 = u.pm * 256 + wr * 64 + fr, cit = wc * 32 + 8 * fq, cb = u.pn * 256;
#pragma unroll
        for (int bj = 0; bj < 2; ++bj) { const f32x4 s0 = *(const f32x4*)(scale + cb + bj * 128 + cit), s1 = *(const f32x4*)(scale + cb + bj * 128 + cit + 4);
#pragma unroll
            for (int ai = 0; ai < 2; ++ai)
#pragma unroll
                for (int m = 0; m < 4; ++m) store8(out + (size_t)(row0 + ai * 128 + m * 16) * PW + cb + bj * 128 + cit, acc[ai][bj][m][0] * s0, acc[ai][bj][m][1] * s1); }
    }
};
struct EpiZP {
    static constexpr bool PERM = true;
    bf16_t* ZP; const bf16_t* GM;
    __device__ __forceinline__ void operator()(const f32x4 (&acc)[2][2][4][2], const Unit& u, int wr, int wc, int fr, int fq) const {
        const int row0 = u.pm * 256 + wr * 64 + fr, col0 = u.pn * 256 + wc * 32 + 8 * fq;
#pragma unroll
        for (int ai = 0; ai < 2; ++ai)
#pragma unroll
            for (int m = 0; m < 4; ++m) { const size_t row = row0 + ai * 128 + m * 16;
#pragma unroll
                for (int bj = 0; bj < 2; ++bj) { f32x4 g0, g1; load8(GM + row * 4096 + col0 + bj * 128, g0, g1);
                    store8(ZP + row * DM + col0 + bj * 128, acc[ai][bj][m][0] * g0, acc[ai][bj][m][1] * g1); } }
    }
};
struct EpiZ {
    static constexpr bool PERM = true;
    bf16_t* Z; const bf16_t* ZP; const bf16_t* GM;
    __device__ __forceinline__ void operator()(const f32x4 (&acc)[2][2][4][2], const Unit& u, int wr, int wc, int fr, int fq) const {
        const int row0 = u.pm * 256 + wr * 64 + fr, col0 = u.pn * 256 + wc * 32 + 8 * fq;
#pragma unroll
        for (int ai = 0; ai < 2; ++ai)
#pragma unroll
            for (int m = 0; m < 4; ++m) { const size_t row = row0 + ai * 128 + m * 16;
#pragma unroll
                for (int bj = 0; bj < 2; ++bj) { f32x4 g0, g1, z0, z1; load8(GM + row * 4096 + 2048 + col0 + bj * 128, g0, g1); load8(ZP + row * DM + col0 + bj * 128, z0, z1);
                    store8(Z + row * DM + col0 + bj * 128, z0 + acc[ai][bj][m][0] * g0, z1 + acc[ai][bj][m][1] * g1); } }
    }
};
struct EpiV1 {
    static constexpr bool PERM = false;
    float* V1; const float* x;
    __device__ __forceinline__ void operator()(const f32x4 (&acc)[2][2][4][2], const Unit& u, int wr, int wc, int fr, int fq) const {
        const int row0 = u.pm * 256 + wr * 64 + fr, col0 = u.pn * 256 + wc * 32 + 4 * fq;
#pragma unroll
        for (int ai = 0; ai < 2; ++ai)
#pragma unroll
            for (int m = 0; m < 4; ++m) { const size_t off = (size_t)(row0 + ai * 128 + m * 16) * DM + col0;
#pragma unroll
                for (int bj = 0; bj < 2; ++bj)
#pragma unroll
                    for (int n = 0; n < 2; ++n) { const f32x4 xv = *(const f32x4*)(x + off + bj * 128 + n * 16); *(f32x4*)(V1 + off + bj * 128 + n * 16) = xv * DN_ALPHA + acc[ai][bj][m][n]; } }
    }
};
struct EpiUp {
    static constexpr bool PERM = true;
    bf16_t* HID;
    __device__ __forceinline__ void operator()(const f32x4 (&acc)[2][2][4][2], const Unit& u, int wr, int wc, int fr, int fq) const {
        const int row0 = u.pm * 256 + wr * 64 + fr, col0 = u.pn * 128 + wc * 32 + 8 * fq;
#pragma unroll
        for (int ai = 0; ai < 2; ++ai)
#pragma unroll
            for (int m = 0; m < 4; ++m) { f32x4 h0, h1;
#pragma unroll
                for (int j = 0; j < 4; ++j) { const float g0 = acc[ai][0][m][0][j], g1 = acc[ai][0][m][1][j]; h0[j] = g0 * sigmoidf_(g0) * acc[ai][1][m][0][j]; h1[j] = g1 * sigmoidf_(g1) * acc[ai][1][m][1][j]; }
                store8(HID + (size_t)(row0 + ai * 128 + m * 16) * EH + col0, h0, h1); }
    }
};
struct EpiDown {
    static constexpr bool PERM = true;
    bf16_t* YB; const int* rowmap; const float* roww;
    __device__ __forceinline__ void operator()(const f32x4 (&acc)[2][2][4][2], const Unit& u, int wr, int wc, int fr, int fq) const {
        const int row0 = u.pm * 256 + wr * 64 + fr, col0 = u.pn * 256 + wc * 32 + 8 * fq;
#pragma unroll
        for (int ai = 0; ai < 2; ++ai)
#pragma unroll
            for (int m = 0; m < 4; ++m) { const int dest = row0 + ai * 128 + m * 16; const int slot = rowmap[dest]; const float w = roww[dest];
                if (slot >= 0) {
#pragma unroll
                    for (int bj = 0; bj < 2; ++bj) store8(YB + (size_t)slot * DM + col0 + bj * 128, acc[ai][bj][m][0] * w, acc[ai][bj][m][1] * w); } }
    }
};

#define XB_TMO      128
#define XB_XCNT(j)  (256  + 64 * (j))
#define XB_XSUB(j)  (1280 + 64 * (j))
#define XB_XGEN(j)  (2304 + 64 * (j))
#define XB_TOP      3328
#define XB_TOPGEN   3392
#define XCD_BAR_WORDS 3456
#define XB_SPIN_CAP (1u << 20)
__device__ __forceinline__ unsigned xb_ld(unsigned* p)              { return __hip_atomic_load(p, __ATOMIC_RELAXED, __HIP_MEMORY_SCOPE_AGENT); }
__device__ __forceinline__ unsigned xb_add(unsigned* p, unsigned v) { return __hip_atomic_fetch_add(p, v, __ATOMIC_RELAXED, __HIP_MEMORY_SCOPE_AGENT); }
__device__ __forceinline__ unsigned xb_xcc_id() { return (unsigned)__builtin_amdgcn_s_getreg((3 << 11) | 20) & 0xFu; }
#define XB_SPIN(cond, bar) do { unsigned _sp = 0; while (cond) { __builtin_amdgcn_s_sleep(1); \
    if ((++_sp & 255u) == 0u) { if (xb_ld(&(bar)[XB_TMO])) break; if (_sp > XB_SPIN_CAP) { atomicAdd(&(bar)[XB_TMO], 1u); break; } } } } while (0)
struct XcdBarrier { unsigned* bar; unsigned x; volatile LAS unsigned* st; };
__device__ __forceinline__ XcdBarrier xcd_barrier_post(unsigned* bar, volatile LAS unsigned* st) {
    XcdBarrier b; b.bar = bar; b.x = xb_xcc_id(); b.st = st;
    if (threadIdx.x == 0) (void)xb_add(&bar[XB_XCNT(b.x)], 1u);
    return b;
}
__device__ __forceinline__ void xcd_barrier_complete(unsigned* bar, unsigned x, unsigned& nloc, unsigned& nx) {
    const unsigned G = gridDim.x * gridDim.y * gridDim.z;
    unsigned sum, cnt, mine, sp = 0u;
    for (;;) {
        sum = 0u; cnt = 0u; mine = 0u;
#pragma unroll
        for (unsigned j = 0; j < 16; ++j) { const unsigned c = xb_ld(&bar[XB_XCNT(j)]); sum += c; cnt += (c > 0u) ? 1u : 0u; mine = (j == x) ? c : mine; }
        if (sum == G) break;
        __builtin_amdgcn_s_sleep(1);
        if ((++sp & 255u) == 0u) { if (xb_ld(&bar[XB_TMO])) break; if (sp > XB_SPIN_CAP) { atomicAdd(&bar[XB_TMO], 1u); break; } }
    }
    nloc = mine > 0u ? mine : 1u; nx = cnt > 0u ? cnt : 1u;
}
__device__ __forceinline__ void xcd_barrier(const XcdBarrier& b) {
    asm volatile("s_waitcnt vmcnt(0)" ::: "memory");
    __syncthreads();
    if (threadIdx.x == 0) {
        unsigned* bar = b.bar;
        __builtin_amdgcn_s_waitcnt(0);
        unsigned nloc = b.st[0], nx = b.st[1];
        if (nloc == 0u) { xcd_barrier_complete(bar, b.x, nloc, nx); b.st[0] = nloc; b.st[1] = nx; }
        const unsigned old = xb_add(&bar[XB_XSUB(b.x)], 1u);
        const unsigned gen = old / nloc;
        if (old + 1u == (gen + 1u) * nloc) {
            __builtin_amdgcn_fence(__ATOMIC_RELEASE, "agent");
            asm volatile("s_waitcnt vmcnt(0)" ::: "memory");
            const unsigned og = xb_add(&bar[XB_TOP], 1u);
            const unsigned tg = og / nx;
            if (og + 1u == (tg + 1u) * nx) xb_add(&bar[XB_TOPGEN], 1u);
            else XB_SPIN(xb_ld(&bar[XB_TOPGEN]) == tg, bar);
            __builtin_amdgcn_fence(__ATOMIC_ACQUIRE, "agent");
            xb_add(&bar[XB_XGEN(b.x)], 1u);
            asm volatile("s_waitcnt vmcnt(0)" ::: "memory");
        } else {
            XB_SPIN(xb_ld(&bar[XB_XGEN(b.x)]) == gen, bar);
            __builtin_amdgcn_fence(__ATOMIC_ACQUIRE, "agent");
            asm volatile("s_waitcnt vmcnt(0)" ::: "memory");
        }
    }
    __syncthreads();
}

struct Args { const float* in[24]; float* out; unsigned char* ws; int ph_lo, ph_hi; };
struct Frame {
    LAS unsigned char* lds; unsigned char* ws; const float* const* in; float* out;
    int tid, lane, wave, vcu, G;
};
#define WSP(T, off) ((T*)(F.ws + (off)))

__device__ __forceinline__ int ropepos(int d) { return d < 32 ? 8 * (d >> 2) + (d & 3) : 8 * ((d - 32) >> 2) + 4 + (d & 3); }
__device__ __forceinline__ int in_map(int n) {
    if (n < 1024) return n;
    if (n < 2048) { const int r = n - 1024; return 1024 + (r & ~63) + ropepos(r & 63); }
    if (n < 3584) { const int seg = (n - 2048) >> 8; if (seg == 2 || seg == 4) { const int r = n - 2048; return 2048 + (r & ~63) + ropepos(r & 63); } return n; }
    if (n < 3632) return 7680 + (n - 3584);
    return 3584 + (n - 3632);
}
template <int MAP  >
__device__ __forceinline__ void transpose_item(const float* W, int N, bf16_t* WT, int ldt, LAS float* scr, int item, int lane) {
    const int nblk = (N + 31) / 32, kb = item / nblk, nb = item % nblk, k0 = 64 * kb, n0 = 32 * nb;
    const int ncol = n0 + (lane & 31); const bool okc = ncol < N;
#pragma unroll 8
    for (int i = 0; i < 32; ++i) { const int kk = 2 * i + (lane >> 5); scr[kk * 33 + (lane & 31)] = okc ? W[(size_t)(k0 + kk) * N + ncol] : 0.f; }
    asm volatile("s_waitcnt lgkmcnt(0)" ::: "memory");
    const int c = lane & 7;
#pragma unroll
    for (int j = 0; j < 4; ++j) { const int nl = (lane >> 3) + 8 * j, n = n0 + nl; const LAS float* s = scr + (8 * c) * 33 + nl;
        u32x4 o; o.x = pk2(s[0 * 33], s[1 * 33]); o.y = pk2(s[2 * 33], s[3 * 33]); o.z = pk2(s[4 * 33], s[5 * 33]); o.w = pk2(s[6 * 33], s[7 * 33]);
        int dr = n; if (MAP == 1) dr = in_map(n); if (MAP == 2) dr = (n >> 7) * 256 + (n & 127); if (MAP == 3) dr = (n >> 7) * 256 + 128 + (n & 127);
        if (n < N) *(u32x4*)(WT + (size_t)dr * ldt + k0 + 8 * c) = o; }
    asm volatile("s_waitcnt lgkmcnt(0)" ::: "memory");
}
__device__ __forceinline__ void p0_prologue(Frame& F) {
    LAS float* scr = (LAS float*)(F.lds + F.wave * 16384);
    const int gw = F.vcu * 8 + F.wave, NGW = F.G * 8, lane = F.lane;
    const float* const* in = F.in;
    constexpr int I_IN = 32 * 242, I_PP = 16 * 64, I_NP = 16 * 64, I_WO = 32 * 64, I_PM = 4 * 4 * 8, I_C1 = 32 * 8, I_C2 = 4 * 2, I_G = 32 * 16, I_D = 8 * 64;
    constexpr int NSMALL = I_IN + I_PP + I_NP + I_WO + I_PM + 2 * I_C1 + 2 * I_C2;
    constexpr int NITEMS = NSMALL + NE * (2 * I_G + I_D);
    for (int it = gw; it < NITEMS; it += NGW) {
        int r = it;
        if (r < NSMALL) {
            if (r < I_IN) { transpose_item<1>(in[1], IN_COLS, WSP(bf16_t, WS_WIN), DM, scr, r, lane); continue; } r -= I_IN;
            if (r < I_PP) { transpose_item<0>(in[4], DM, WSP(bf16_t, WS_WPP), PW, scr, r, lane); continue; } r -= I_PP;
            if (r < I_NP) { transpose_item<0>(in[5], DM, WSP(bf16_t, WS_WNP), 1024, scr, r, lane); continue; } r -= I_NP;
            if (r < I_WO) { transpose_item<0>(in[12], DM, WSP(bf16_t, WS_WO), DM, scr, r, lane); continue; } r -= I_WO;
            if (r < I_PM) { const int g = r / 32; transpose_item<0>(in[2] + (size_t)g * 65536, 256, WSP(bf16_t, WS_PM) + (size_t)g * 65536, 256, scr, r % 32, lane); continue; } r -= I_PM;
            if (r < I_C1) { transpose_item<0>(in[8], 256, WSP(bf16_t, WS_CW1K), 2048, scr, r, lane); continue; } r -= I_C1;
            if (r < I_C1) { transpose_item<0>(in[10], 256, WSP(bf16_t, WS_CW1V), 2048, scr, r, lane); continue; } r -= I_C1;
            if (r < I_C2) { transpose_item<0>(in[9], 64, WSP(bf16_t, WS_CW2K), 256, scr, r, lane); continue; } r -= I_C2;
            transpose_item<0>(in[11], 64, WSP(bf16_t, WS_CW2V), 256, scr, r, lane); continue;
        }
        r -= NSMALL;
        const int e = r / (2 * I_G + I_D); r -= e * (2 * I_G + I_D);
        if (r < I_G) { transpose_item<2>(in[19] + (size_t)e * DM * EH, EH, WSP(bf16_t, WS_WGU) + (size_t)e * 1024 * DM, DM, scr, r, lane); continue; } r -= I_G;
        if (r < I_G) { transpose_item<3>(in[20] + (size_t)e * DM * EH, EH, WSP(bf16_t, WS_WGU) + (size_t)e * 1024 * DM, DM, scr, r, lane); continue; } r -= I_G;
        transpose_item<0>(in[21] + (size_t)e * EH * DM, DM, WSP(bf16_t, WS_WD) + (size_t)e * DM * EH, EH, scr, r, lane);
    }
    const size_t gt = (size_t)F.vcu * 512 + F.tid, TT = (size_t)F.G * 512;
    { const float* x = in[0]; bf16_t* xb = WSP(bf16_t, WS_XB);
      for (size_t i = gt; i < (size_t)NT * DM / 8; i += TT) { const f32x4 a = *(const f32x4*)(x + i * 8), b = *(const f32x4*)(x + i * 8 + 4); u32x4 o; o.x = pk2(a[0], a[1]); o.y = pk2(a[2], a[3]); o.z = pk2(b[0], b[1]); o.w = pk2(b[2], b[3]); *(u32x4*)(xb + i * 8) = o; } }
    {
      const float invf[32] = {1.f, 0.749894261f, 0.562341332f, 0.421696514f, 0.316227764f, 0.237137377f, 0.177827939f, 0.133352131f, 0.100000001f, 0.0749894157f, 0.0562341325f, 0.0421696529f, 0.0316227749f, 0.0237137377f, 0.0177827943f, 0.0133352149f, 0.00999999978f, 0.00749894185f, 0.00562341325f, 0.00421696482f, 0.00316227763f, 0.00237137359f, 0.00177827943f, 0.00133352145f, 0.00100000005f, 0.000749894243f, 0.000562341302f, 0.000421696517f, 0.000316227757f, 0.00023713737f, 0.00017782794f, 0.00013335215f};
      f32x2* rt = WSP(f32x2, WS_ROPE);
      for (size_t i = gt; i < (size_t)SEQ * 32; i += TT) { const int t = (int)(i >> 5), k = (int)(i & 31);
          float fr = 1.f;
#pragma unroll
          for (int q = 0; q < 32; ++q) fr = (k == q) ? invf[q] : fr;
          const float ang = (float)t * fr; double rev = (double)ang * 0.15915494309189535; rev -= __builtin_rint(rev); const float r = (float)rev;
          rt[i] = (f32x2){__builtin_amdgcn_cosf(r), __builtin_amdgcn_sinf(r)}; } }
    {
      bf16_t* wh = WSP(bf16_t, WS_WRH); bf16_t* wl = WSP(bf16_t, WS_WRL);
      for (size_t i = gt; i < (size_t)80 * DM; i += TT) { const int r = (int)(i / DM), k = (int)(i % DM); float v = 0.f;
          if (r < 8) v = in[15][(size_t)k * 8 + r]; else if (r < 72) { const int g = (r - 8) >> 3, e = (r - 8) & 7; v = in[17][((size_t)g * DM + k) * 8 + e]; }
          const unsigned h = f2bf(v); const float hv = __builtin_bit_cast(float, h << 16); wh[i] = (bf16_t)h; wl[i] = (bf16_t)f2bf(v - hv); } }
    {
      float* cb = WSP(float, WS_CBIAS);
      for (int o = gw; o < 512; o += NGW) { const int side = o >> 8, col = o & 255; const float* pos = in[side ? 7 : 6]; const float* w1 = in[side ? 10 : 8]; float s = 0.f;
          for (int k = lane; k < 2048; k += 64) s += pos[k] * w1[(size_t)k * 256 + col];
          s = wave_sum(s); if (lane == 0) cb[o] = s; } }
}

__device__ __forceinline__ void p2_pool(Frame& F) {
    const bf16_t* U = WSP(bf16_t, WS_U); bf16_t* P = WSP(bf16_t, WS_POOLED);
    const int gt = F.vcu * 512 + F.tid, TT = F.G * 512;
    for (int it = gt; it < (NT / 16) * 128; it += TT) {
        const int cc = it & 127, rb = it >> 7, m0 = rb * 16, t0 = m0 & 4095, g = cc >> 5, w = 2 << g;
        const bf16_t* up = U + (size_t)m0 * PW + cc * 8;
        f32x4 s0 = (f32x4){0.f, 0.f, 0.f, 0.f}, s1 = s0;
        for (int j = 1; j < w; ++j) if (t0 - j >= 0) { f32x4 a, b; load8(up - (size_t)j * PW, a, b); s0 += a; s1 += b; }
        for (int i = 0; i < 16; ++i) { const int t = t0 + i; f32x4 a, b; load8(up + (size_t)i * PW, a, b); s0 += a; s1 += b;
            const float inv = 1.f / (float)((t + 1 < w) ? (t + 1) : w);
            store8(P + (size_t)(m0 + i) * PW + cc * 8, s0 * inv - a, s1 * inv - b);
            if (t - w + 1 >= 0) { f32x4 c, d; load8(up + (size_t)(i - w + 1) * PW, c, d); s0 -= c; s1 -= d; } }
    }
}

__device__ __forceinline__ void p3_cmp2(Frame& F) {
    const int gw = F.vcu * 8 + F.wave, NGW = F.G * 8, lane = F.lane, fr = lane & 15, kg = lane >> 4;
    const f32x2* rope = WSP(f32x2, WS_ROPE);
    for (int it = gw; it < 512; it += NGW) {
        const int side = it >> 8, rb = it & 255, r0 = rb * 16;
        const bf16_t* H = WSP(bf16_t, side ? WS_HV : WS_HK) + (size_t)(r0 + fr) * 256 + kg * 8;
        const bf16_t* W = WSP(bf16_t, side ? WS_CW2V : WS_CW2K) + (size_t)fr * 256 + kg * 8;
        f32x4 acc[4];
#pragma unroll
        for (int nb = 0; nb < 4; ++nb) acc[nb] = (f32x4){0.f, 0.f, 0.f, 0.f};
#pragma unroll
        for (int s = 0; s < 8; ++s) { const bf16x8 a = *(const bf16x8*)(H + s * 32);
#pragma unroll
            for (int nb = 0; nb < 4; ++nb) { const bf16x8 b = *(const bf16x8*)(W + (size_t)nb * 16 * 256 + s * 32); acc[nb] = __builtin_amdgcn_mfma_f32_16x16x32_bf16(a, b, acc[nb], 0, 0, 0); } }
        bf16_t* out = WSP(bf16_t, side ? WS_VCMP : WS_KCMP);
#pragma unroll
        for (int r = 0; r < 4; ++r) { const int row = r0 + 4 * kg + r, c = row & 255;
            if (side == 0) { const int pos = c * 16 + 31;
#pragma unroll
                for (int nb = 0; nb < 2; ++nb) { const int i = nb * 16 + fr; const f32x2 cs = rope[(size_t)(pos & 4095) * 32 + i]; const float x1 = acc[nb][r], x2 = acc[nb + 2][r];
                    out[(size_t)row * 64 + ropepos(i)] = (bf16_t)f2bf(x1 * cs.x - x2 * cs.y); out[(size_t)row * 64 + ropepos(i + 32)] = (bf16_t)f2bf(x2 * cs.x + x1 * cs.y); }
            } else {
#pragma unroll
                for (int nb = 0; nb < 4; ++nb) out[(size_t)row * 64 + nb * 16 + fr] = (bf16_t)f2bf(acc[nb][r]); } }
    }
}

namespace att {
constexpr int KV0 = 0, SLOTB = 16384, IMP = 32768, IMPLD = 65, OST = 32768, WSF = 100352, SEL = 102400, UNI = 102912, IMPL = 103424;
constexpr float THR = 8.f;
__device__ __forceinline__ int crow(int r, int hi) { return (r & 3) + 8 * (r >> 2) + 4 * hi; }
__device__ __forceinline__ s16x4 vtr(const LAS char* p) { return __builtin_bit_cast(s16x4, __builtin_amdgcn_ds_read_tr16_b64_v4i16((LAS s16x4*)p)); }
__device__ __forceinline__ float swap_max(float m) { auto rr = __builtin_amdgcn_permlane32_swap(__float_as_uint(m), __float_as_uint(m), false, false); return fmaxf(__uint_as_float(rr[0]), __uint_as_float(rr[1])); }
__device__ __forceinline__ float swap_sum(float m) { auto rr = __builtin_amdgcn_permlane32_swap(__float_as_uint(m), __float_as_uint(m), false, false); return __uint_as_float(rr[0]) + __uint_as_float(rr[1]); }
__device__ __forceinline__ float swap_other(float m, int hi) { auto rr = __builtin_amdgcn_permlane32_swap(__float_as_uint(m), __float_as_uint(m), false, false); return __uint_as_float(hi ? rr[0] : rr[1]); }
__device__ __forceinline__ float rowmax32(const f32x16& p0, const f32x16& p1) {
    float a = fmaxf(p0[0], p1[0]);
#pragma unroll
    for (int r = 1; r < 16; ++r) a = fmaxf(a, fmaxf(p0[r], p1[r]));
    return swap_max(a);
}
struct TileRegs { u32x4 k, v; };
__device__ __forceinline__ void tile_load(TileRegs& t, const bf16_t* Kg, const bf16_t* Vg, int row0, int wid, int lane) {
    t.k = *(const u32x4*)(Kg + (size_t)(row0 + lane) * 64 + wid * 8);
    t.v = *(const u32x4*)(Vg + (size_t)(row0 + 16 * (wid & 3) + (lane >> 2)) * 64 + (wid >> 2) * 32 + (lane & 3) * 8);
}
__device__ __forceinline__ void tile_store(const TileRegs& t, LAS char* slot, int wid, int lane) {
    *(LAS u32x4*)(slot + wid * 1024 + lane * 16) = t.k;
    *(LAS u32x4*)(slot + 8192 + wid * 1024 + lane * 16) = t.v;
}
__device__ __forceinline__ void qkt(f32x16& p0, f32x16& p1, const LAS char* kslot, const bf16x8 (&qr)[4], int r32, int hi) {
    const LAS char* kb = kslot + hi * 1024 + r32 * 16;
    p0 = (f32x16){}; p1 = (f32x16){};
#pragma unroll
    for (int d0 = 0; d0 < 4; ++d0) { const bf16x8 b0 = *(const LAS bf16x8*)(kb + d0 * 2048), b1 = *(const LAS bf16x8*)(kb + d0 * 2048 + 512);
        p0 = __builtin_amdgcn_mfma_f32_32x32x16_bf16(b0, qr[d0], p0, 0, 0, 0); p1 = __builtin_amdgcn_mfma_f32_32x32x16_bf16(b1, qr[d0], p1, 0, 0, 0); }
}
__device__ __forceinline__ bf16x8 pack8(const f32x16& p, int base) {
    u32x4 w; w.x = cvt_pk_bf16(p[base], p[base + 1]); w.y = cvt_pk_bf16(p[base + 2], p[base + 3]); w.z = cvt_pk_bf16(p[base + 4], p[base + 5]); w.w = cvt_pk_bf16(p[base + 6], p[base + 7]);
    return __builtin_bit_cast(bf16x8, w);
}
__device__ __forceinline__ void pv(f32x16 (&o)[2], const LAS char* vslot, const f32x16& p0, const f32x16& p1, int lane, int hi) {
    const LAS char* vb = vslot + ((lane >> 4) & 1) * 32 + (lane & 3) * 8 + (4 * hi + ((lane & 15) >> 2)) * 64;
    bf16x8 pa[4]; pa[0] = pack8(p0, 0); pa[1] = pack8(p0, 8); pa[2] = pack8(p1, 0); pa[3] = pack8(p1, 8);
#pragma unroll
    for (int dh = 0; dh < 2; ++dh) {
#pragma unroll
        for (int ks = 0; ks < 4; ++ks) { const s16x4 lo = vtr(vb + dh * 4096 + ks * 1024), hh = vtr(vb + dh * 4096 + ks * 1024 + 512);
            const bf16x8 vf = (bf16x8){lo[0], lo[1], lo[2], lo[3], hh[0], hh[1], hh[2], hh[3]};
            o[dh] = __builtin_amdgcn_mfma_f32_32x32x16_bf16(pa[ks], vf, o[dh], 0, 0, 0); } }
}
__device__ __forceinline__ void kmask(f32x16& p0, f32x16& p1, int klo, int khi, int hi) {
#pragma unroll
    for (int r = 0; r < 16; ++r) { const int k0 = crow(r, hi); if (k0 < klo || k0 > khi) p0[r] = -INFINITY; if (k0 + 32 < klo || k0 + 32 > khi) p1[r] = -INFINITY; }
}
__device__ __forceinline__ void acc_scaled(f32x16 (&ofin)[2], const f32x16 (&o)[2], volatile LAS float* wsf, float scale, int r32, int hi) {
    if (hi == 0) wsf[r32] = scale;
    asm volatile("s_waitcnt lgkmcnt(0)" ::: "memory");
#pragma unroll
    for (int r = 0; r < 16; ++r) { const float f = wsf[crow(r, hi)]; ofin[0][r] += o[0][r] * f; ofin[1][r] += o[1][r] * f; }
    asm volatile("s_waitcnt lgkmcnt(0)" ::: "memory");
}
__device__ __forceinline__ void acc_scaled_lds(LAS float* stg, const f32x16 (&o)[2], volatile LAS float* wsf, float scale, int r32, int hi) {
    if (hi == 0) wsf[r32] = scale;
    asm volatile("s_waitcnt lgkmcnt(0)" ::: "memory");
#pragma unroll
    for (int r = 0; r < 16; ++r) { const int orow = crow(r, hi); const float f = wsf[orow]; stg[orow * 64 + r32] += o[0][r] * f; stg[orow * 64 + 32 + r32] += o[1][r] * f; }
    asm volatile("s_waitcnt lgkmcnt(0)" ::: "memory");
}
template <int MODE>
__device__ __forceinline__ void branch(LAS float* stg, const bf16_t* Kg, const bf16_t* Vg, int dj, u64 rest, int tj, u64 selmask, float gate, int qq,
                                       const bf16x8 (&qr)[4], LAS char* lds, int wid, int lane, int r32, int hi) {
    volatile LAS float* wsf = (volatile LAS float*)(lds + WSF) + wid * 64;
    f32x16 o[2]; o[0] = (f32x16){}; o[1] = (f32x16){};
    float m = 0.f, l = 0.f; bool first = true;
    TileRegs tr; tile_load(tr, Kg, Vg, dj * 64, wid, lane); tile_store(tr, lds + KV0, wid, lane);
    __syncthreads();
    int cj = dj, slot = 0;
    for (;;) {
        const bool has_next = rest != 0ull; int nj = 0;
        if (has_next) { nj = __builtin_ctzll(rest); rest &= rest - 1ull; tile_load(tr, Kg, Vg, nj * 64, wid, lane); }
        const LAS char* ks = lds + KV0 + slot * SLOTB;
        f32x16 p0, p1; qkt(p0, p1, ks, qr, r32, hi);
        int klo = 0, khi = 63;
        if (cj == dj) khi = qq;
        else if (MODE == 0) { if (!((selmask >> cj) & 1ull)) khi = -1; }
        else { if (cj == tj) klo = qq + 1; }
        kmask(p0, p1, klo, khi, hi);
        const float rm = rowmax32(p0, p1);
        if (first) { m = rm; first = false; }
        else { const float rel = rm - m;
            if (__any(rel > THR)) { const float dl = fmaxf(rel, 0.f), f = fast_exp2(-dl); m += dl; l *= f;
                if (hi == 0) wsf[r32] = f;
                asm volatile("s_waitcnt lgkmcnt(0)" ::: "memory");
#pragma unroll
                for (int r = 0; r < 16; ++r) { const float ff = wsf[crow(r, hi)]; o[0][r] *= ff; o[1][r] *= ff; }
                asm volatile("s_waitcnt lgkmcnt(0)" ::: "memory"); } }
        float s = 0.f;
#pragma unroll
        for (int r = 0; r < 16; ++r) { p0[r] = fast_exp2(p0[r] - m); p1[r] = fast_exp2(p1[r] - m); s += p0[r] + p1[r]; }
        l += s;
        pv(o, ks + 8192, p0, p1, lane, hi);
        if (has_next) tile_store(tr, lds + KV0 + (slot ^ 1) * SLOTB, wid, lane);
        __syncthreads();
        if (!has_next) break;
        cj = nj; slot ^= 1;
    }
    const float lt = swap_sum(l);
    acc_scaled_lds(stg, o, wsf, gate / lt, r32, hi);
}

__device__ __forceinline__ void unit(Frame& F, int b, int g, int qb) {
    LAS char* lds = (LAS char*)F.lds;
    const int lane = F.lane, wid = F.wave, r32 = lane & 31, hi = lane >> 5;
    const int hl = wid >> 1, h = g * 4 + hl, qq = (wid & 1) * 32 + r32, t = qb * 64 + qq;
    const bf16_t* Qp = WSP(bf16_t, WS_Q) + ((size_t)(b * NH + h) * SEQ + t) * HD;
    const size_t kvoff = (size_t)(b * NG + g) * SEQ * HD;
    bf16x8 qr[4];
#pragma unroll
    for (int d0 = 0; d0 < 4; ++d0) qr[d0] = *(const bf16x8*)(Qp + d0 * 16 + hi * 8);
    const float* gn = WSP(float, WS_GN) + (size_t)(b * SEQ + t) * 64;
    const float g0 = gn[h], g1 = gn[16 + h], g2 = gn[32 + h];
    volatile LAS float* wsf = (volatile LAS float*)(lds + WSF) + wid * 64;
    f32x16 ofin[2]; ofin[0] = (f32x16){}; ofin[1] = (f32x16){};

    {
        const bf16_t* Kc = WSP(bf16_t, WS_KCMP) + (size_t)(b * NG + g) * 256 * HD; const bf16_t* Vc = WSP(bf16_t, WS_VCMP) + (size_t)(b * NG + g) * 256 * HD;
        const int nct = (4 * qb + 2) / 64 + 1;
        const int cmax = (t >= 31) ? ((t - 31) >> 4) : -1;
        TileRegs tr; float m = -INFINITY;
        for (int T = 0; T < nct; ++T) {
            tile_load(tr, Kc, Vc, T * 64, wid, lane); tile_store(tr, lds + KV0 + (T & 1) * SLOTB, wid, lane);
            __syncthreads();
            f32x16 p0, p1; qkt(p0, p1, lds + KV0 + (T & 1) * SLOTB, qr, r32, hi);
            kmask(p0, p1, 0, cmax - T * 64, hi);
            m = fmaxf(m, rowmax32(p0, p1));
        }
        __syncthreads();
        if (m == -INFINITY) m = 0.f;
        f32x16 o[2]; o[0] = (f32x16){}; o[1] = (f32x16){}; float l = 0.f, prev_last = 0.f;
        LAS float* impl = (LAS float*)(lds + IMP) + (size_t)(hl * 64 + qq) * IMPLD;
#pragma unroll 1
        for (int T = 0; T < nct; ++T) {
            tile_load(tr, Kc, Vc, T * 64, wid, lane); tile_store(tr, lds + KV0 + (T & 1) * SLOTB, wid, lane);
            __syncthreads();
            f32x16 p0, p1; qkt(p0, p1, lds + KV0 + (T & 1) * SLOTB, qr, r32, hi);
            kmask(p0, p1, 0, cmax - T * 64, hi);
            float s = 0.f;
#pragma unroll
            for (int r = 0; r < 16; ++r) { p0[r] = fast_exp2(p0[r] - m); p1[r] = fast_exp2(p1[r] - m); s += p0[r] + p1[r]; }
            l += s;
            pv(o, lds + KV0 + (T & 1) * SLOTB + 8192, p0, p1, lane, hi);
#pragma unroll
            for (int hf = 0; hf < 2; ++hf)
#pragma unroll
                for (int a = 0; a < 4; ++a) { const float e0 = hf ? p1[4 * a] : p0[4 * a], e1 = hf ? p1[4 * a + 1] : p0[4 * a + 1], e2 = hf ? p1[4 * a + 2] : p0[4 * a + 2], e3 = hf ? p1[4 * a + 3] : p0[4 * a + 3];
                    const float send = hi ? prev_last : e3;
                    impl[2 * (8 * T + 4 * hf + a) + hi] = ((e0 + e1) + (e2 + e3)) + swap_other(send, hi);
                    prev_last = e3; }
        }
        const float lt = swap_sum(l), inv = lt > 0.f ? 1.f / lt : 0.f;
        if (hi == 0) ((LAS float*)(lds + IMPL))[hl * 64 + qq] = inv;
        acc_scaled(ofin, o, wsf, g0 * inv, r32, hi);
    }
    __syncthreads();
    {
        u64 un = 0ull; const LAS float* impb = (const LAS float*)(lds + IMP);
        for (int i = 0; i < 8; ++i) { const int q = wid * 8 + i;
            const LAS float* il = (const LAS float*)(lds + IMPL);
            float v = ((impb[(0 * 64 + q) * IMPLD + lane] * il[q] + impb[(1 * 64 + q) * IMPLD + lane] * il[64 + q]) + impb[(2 * 64 + q) * IMPLD + lane] * il[128 + q]) + impb[(3 * 64 + q) * IMPLD + lane] * il[192 + q];
            if (lane > qb) v = 0.f;
            unsigned key = (__float_as_uint(v) & ~63u) | (unsigned)(63 - lane);
            if (lane == 0 || lane == qb || lane == qb - 1) key = 0xFFFFFFC0u | (unsigned)(63 - lane); else if (lane > qb) key = (unsigned)(63 - lane);
            int rank = 0;
            for (int s = 0; s < 64; ++s) { const unsigned ks = (unsigned)__builtin_amdgcn_readlane((int)key, s); rank += (ks > key) ? 1 : 0; }
            const u64 mk = __ballot(rank < 16);
            if (lane == 0) *(LAS u64*)(lds + SEL + q * 8) = mk;
            un |= mk; }
        if (lane == 0) *(LAS u64*)(lds + UNI + wid * 8) = un;
    }
    __syncthreads();
    LAS float* stg = (LAS float*)(lds + OST) + wid * 2048;
#pragma unroll
    for (int r = 0; r < 16; ++r) { const int orow = crow(r, hi); stg[orow * 64 + r32] = ofin[0][r]; stg[orow * 64 + 32 + r32] = ofin[1][r]; }
    const u64 selmask = *(const LAS u64*)(lds + SEL + qq * 8);
    u64 uni = 0ull;
#pragma unroll
    for (int i = 0; i < 8; ++i) uni |= *(const LAS u64*)(lds + UNI + i * 8);
    uni = ((u64)(unsigned)__builtin_amdgcn_readfirstlane((int)(uni >> 32)) << 32) | (u64)(unsigned)__builtin_amdgcn_readfirstlane((int)(uni & 0xffffffffull));
    const u64 below = (qb == 0) ? 0ull : ((1ull << qb) - 1ull);
    branch<0>(stg, WSP(bf16_t, WS_KS) + kvoff, WSP(bf16_t, WS_VS) + kvoff, qb, uni & below, -1, selmask, g1, qq, qr, lds, wid, lane, r32, hi);
    { const int lo = qb >= 8 ? qb - 8 : 0; const u64 wrest = below & ~((lo == 0) ? 0ull : ((1ull << lo) - 1ull));
      branch<1>(stg, WSP(bf16_t, WS_KW) + kvoff, WSP(bf16_t, WS_VW) + kvoff, qb, wrest, qb >= 8 ? qb - 8 : -1, 0ull, g2, qq, qr, lds, wid, lane, r32, hi); }
    { asm volatile("s_waitcnt lgkmcnt(0)" ::: "memory");
      bf16_t* Ow = WSP(bf16_t, WS_O) + ((size_t)b * SEQ + qb * 64 + (wid & 1) * 32) * 1024 + h * 64;
#pragma unroll
      for (int i = 0; i < 4; ++i) { const int row = i * 8 + (lane >> 3), ch = lane & 7; const f32x4 v0 = *(const LAS f32x4*)(stg + row * 64 + ch * 8), v1 = *(const LAS f32x4*)(stg + row * 64 + ch * 8 + 4); store8(Ow + (size_t)row * 1024 + ch * 8, v0, v1); } }
    __syncthreads();
}
__device__ __forceinline__ void phase(Frame& F) {
    for (int L = F.vcu; L < 256; L += F.G) { const int bg = L >> 4, s = L & 15;
        for (int i = 0; i < 4; ++i) { const int qb = (i == 0) ? s : (i == 1) ? 31 - s : (i == 2) ? 32 + s : 63 - s; unit(F, bg >> 2, bg & 3, qb); } }
}
}

__device__ __forceinline__ void p7_router(Frame& F, unsigned* ctl) {
    constexpr int RLD = 2052;
    LAS float* rows = (LAS float*)F.lds;
    LAS float* red = (LAS float*)F.lds;
    LAS float* st = (LAS float*)(F.lds + TAB_OFF);
    const int tid = F.tid, lane = F.lane, wid = F.wave;
    const float* V1 = F.out; const float* g1 = F.in[13]; const float* b1 = F.in[14];
    bf16_t* H1B = WSP(bf16_t, WS_H1B); float* stats = WSP(float, WS_STATS);
    const bf16_t* WRH = WSP(bf16_t, WS_WRH); const bf16_t* WRL = WSP(bf16_t, WS_WRL);
    const f32x4 gv = *(const f32x4*)(g1 + tid * 4), bv = *(const f32x4*)(b1 + tid * 4);
    for (int ub = F.vcu; ub < NT / 16; ub += F.G) {
        const int m0 = ub * 16;
        f32x4 v[16];
#pragma unroll
        for (int i = 0; i < 16; ++i) v[i] = *(const f32x4*)(V1 + (size_t)(m0 + i) * DM + tid * 4);
#pragma unroll
        for (int i = 0; i < 16; ++i) *(LAS f32x4*)(rows + i * RLD + tid * 4) = v[i];
        __syncthreads();
#pragma unroll
        for (int rr = 0; rr < 2; ++rr) { const int r = wid * 2 + rr; float s = 0.f;
#pragma unroll
            for (int j = 0; j < 8; ++j) { const f32x4 x = *(const LAS f32x4*)(rows + r * RLD + j * 256 + lane * 4); s += (x[0] + x[1]) + (x[2] + x[3]); }
            const float mean = wave_sum(s) * (1.f / DM); float q = 0.f;
#pragma unroll
            for (int j = 0; j < 8; ++j) { const f32x4 x = *(const LAS f32x4*)(rows + r * RLD + j * 256 + lane * 4) - mean; q += (x[0] * x[0] + x[1] * x[1]) + (x[2] * x[2] + x[3] * x[3]); }
            const float rstd = 1.f / sqrtf(wave_sum(q) * (1.f / DM) + LN_EPS);
            if (lane == 0) { st[r * 2] = mean; st[r * 2 + 1] = rstd; stats[(size_t)(m0 + r) * 2] = mean; stats[(size_t)(m0 + r) * 2 + 1] = rstd; } }
        __syncthreads();
#pragma unroll
        for (int i = 0; i < 16; ++i) { const float mean = st[i * 2], rstd = st[i * 2 + 1]; const f32x4 hrow = (v[i] - mean) * rstd * gv + bv;
            *(LAS f32x4*)(rows + i * RLD + tid * 4) = hrow; u32x2 o; o.x = pk2(hrow[0], hrow[1]); o.y = pk2(hrow[2], hrow[3]); *(u32x2*)(H1B + (size_t)(m0 + i) * DM + tid * 4) = o; }
        __syncthreads();
        f32x4 acc[5];
#pragma unroll
        for (int nb = 0; nb < 5; ++nb) acc[nb] = (f32x4){0.f, 0.f, 0.f, 0.f};
        { const int fr = lane & 15, kg = lane >> 4;
#pragma unroll 1
          for (int s = 0; s < 8; ++s) { const int k0 = wid * 256 + s * 32 + kg * 8;
              const f32x4 a0 = *(const LAS f32x4*)(rows + fr * RLD + k0), a1 = *(const LAS f32x4*)(rows + fr * RLD + k0 + 4);
              u32x4 ah, al;
#pragma unroll
              for (int j = 0; j < 4; ++j) { const float x0 = j < 2 ? a0[2 * j] : a1[2 * j - 4], x1 = j < 2 ? a0[2 * j + 1] : a1[2 * j - 3];
                  const unsigned h0 = f2bf(x0), h1 = f2bf(x1); ah[j] = h0 | (h1 << 16); al[j] = pk2(x0 - __builtin_bit_cast(float, h0 << 16), x1 - __builtin_bit_cast(float, h1 << 16)); }
              const bf16x8 Ah = __builtin_bit_cast(bf16x8, ah), Al = __builtin_bit_cast(bf16x8, al);
#pragma unroll
              for (int nb = 0; nb < 5; ++nb) { const bf16x8 Bh = *(const bf16x8*)(WRH + (size_t)(nb * 16 + fr) * DM + k0), Bl = *(const bf16x8*)(WRL + (size_t)(nb * 16 + fr) * DM + k0);
                  acc[nb] = __builtin_amdgcn_mfma_f32_16x16x32_bf16(Ah, Bh, acc[nb], 0, 0, 0); acc[nb] = __builtin_amdgcn_mfma_f32_16x16x32_bf16(Al, Bh, acc[nb], 0, 0, 0); acc[nb] = __builtin_amdgcn_mfma_f32_16x16x32_bf16(Ah, Bl, acc[nb], 0, 0, 0); } } }
        __syncthreads();
        { const int fr = lane & 15, kg = lane >> 4;
#pragma unroll
          for (int nb = 0; nb < 5; ++nb)
#pragma unroll
              for (int r = 0; r < 4; ++r) red[(wid * 16 + 4 * kg + r) * 80 + nb * 16 + fr] = acc[nb][r]; }
        __syncthreads();
        if (tid < 16) { const int m = m0 + tid;
            const float* gb = F.in[16]; const float* eb = F.in[18];
            float gl[8]; int grp = 0; float gmax = -INFINITY;
#pragma unroll
            for (int i = 0; i < 8; ++i) { float s = 0.f;
#pragma unroll
                for (int w = 0; w < 8; ++w) s += red[(w * 16 + tid) * 80 + i];
                gl[i] = s + gb[i]; if (gl[i] > gmax) { gmax = gl[i]; grp = i; } }
            float gs = 0.f;
#pragma unroll
            for (int i = 0; i < 8; ++i) gs += __expf(gl[i] - gmax);
            const float ggate = 1.f / gs;
            float el[8];
#pragma unroll
            for (int i = 0; i < 8; ++i) { float s = 0.f;
#pragma unroll
                for (int w = 0; w < 8; ++w) s += red[(w * 16 + tid) * 80 + 8 + grp * 8 + i];
                el[i] = s + eb[grp * 8 + i]; }
            int i0 = 0; float v0 = -INFINITY;
#pragma unroll
            for (int i = 0; i < 8; ++i) if (el[i] > v0) { v0 = el[i]; i0 = i; }
            int i1 = 0; float v1 = -INFINITY;
#pragma unroll
            for (int i = 0; i < 8; ++i) if (i != i0 && el[i] > v1) { v1 = el[i]; i1 = i; }
            const float e1 = __expf(v1 - v0), w0 = ggate / (1.f + e1), w1 = ggate * e1 / (1.f + e1);
            const int ea = grp * 8 + i0, ebx = grp * 8 + i1;
            const unsigned pa = __hip_atomic_fetch_add(ctl + CW_CNT + 16 * ea, 1u, RLX_AGENT), pb = __hip_atomic_fetch_add(ctl + CW_CNT + 16 * ebx, 1u, RLX_AGENT);
            int* rte = WSP(int, WS_RTE); float* rtw = WSP(float, WS_RTW); int* rtp = WSP(int, WS_RTP);
            rte[m * 2] = ea; rte[m * 2 + 1] = ebx; rtw[m * 2] = w0; rtw[m * 2 + 1] = w1; rtp[m * 2] = (int)pa; rtp[m * 2 + 1] = (int)pb; }
        __syncthreads();
    }
}
__device__ __forceinline__ int expert_tables(Frame& F, unsigned* ctl) {
    LAS int* off = (LAS int*)(F.lds + TAB_OFF + 256); LAS int* texp = off + 68; LAS int* ntl = texp + 200;
    __syncthreads();
    if (F.tid < 64) { const int e = F.tid; const int c = (int)__hip_atomic_load(ctl + CW_CNT + 16 * e, RLX_AGENT); const int nt = (c + 255) >> 8;
        int pre = nt;
#pragma unroll
        for (int o = 1; o < 64; o <<= 1) { const int x = __shfl_up(pre, o); if (e >= o) pre += x; }
        const int base = pre - nt; off[e] = base * 256;
        for (int i = 0; i < nt; ++i) texp[base + i] = e;
        if (e == 63) ntl[0] = pre; }
    __syncthreads();
    return ntl[0];
}
__device__ __forceinline__ void p8_gather(Frame& F, unsigned* ctl) {
    (void)expert_tables(F, ctl);
    const LAS int* off = (const LAS int*)(F.lds + TAB_OFF + 256);
    const int gw = F.vcu * 8 + F.wave, NGW = F.G * 8, lane = F.lane;
    const int* rte = WSP(int, WS_RTE); const float* rtw = WSP(float, WS_RTW); const int* rtp = WSP(int, WS_RTP);
    int* rowmap = WSP(int, WS_ROWMAP); float* roww = WSP(float, WS_ROWW);
    const bf16_t* H1B = WSP(bf16_t, WS_H1B); bf16_t* XB = WSP(bf16_t, WS_XBUF);
    for (int s = gw; s < NT * 2; s += NGW) { const int e = rte[s], dest = off[e] + rtp[s]; const int m = s >> 1;
        const u32x4* src = (const u32x4*)(H1B + (size_t)m * DM); u32x4* dst = (u32x4*)(XB + (size_t)dest * DM);
        u32x4 r[4];
#pragma unroll
        for (int j = 0; j < 4; ++j) r[j] = src[j * 64 + lane];
#pragma unroll
        for (int j = 0; j < 4; ++j) dst[j * 64 + lane] = r[j];
        if (lane == 0) { rowmap[dest] = s; roww[dest] = rtw[s]; } }
    for (int e = gw; e < NE; e += NGW) { const int c = (int)__hip_atomic_load(ctl + CW_CNT + 16 * e, RLX_AGENT); const int pend = ((c + 255) >> 8) << 8;
        for (int i = c + lane; i < pend; i += 64) { rowmap[off[e] + i] = -1; roww[off[e] + i] = 0.f; } }
}
__device__ __forceinline__ void p11_final(Frame& F) {
    const int gw = F.vcu * 8 + F.wave, NGW = F.G * 8, lane = F.lane;
    const float* g1 = F.in[13]; const float* b1 = F.in[14]; const float* g2 = F.in[22]; const float* b2 = F.in[23];
    const float* stats = WSP(float, WS_STATS); const bf16_t* YB = WSP(bf16_t, WS_YB); float* out = F.out;
    for (int m = gw; m < NT; m += NGW) {
        const float mean = stats[(size_t)m * 2], rstd = stats[(size_t)m * 2 + 1];
        const float* vr = out + (size_t)m * DM; const bf16_t* y0 = YB + (size_t)(2 * m) * DM; const bf16_t* y1 = y0 + DM;
        f32x4 v[8]; float s = 0.f;
#pragma unroll
        for (int j = 0; j < 4; ++j) { const int c = j * 512 + lane * 8; f32x4 a0, a1, c0, c1; load8(y0 + c, a0, a1); load8(y1 + c, c0, c1);
            const f32x4 x0 = *(const f32x4*)(vr + c), x1 = *(const f32x4*)(vr + c + 4);
            const f32x4 h0 = (x0 - mean) * rstd * *(const f32x4*)(g1 + c) + *(const f32x4*)(b1 + c), h1 = (x1 - mean) * rstd * *(const f32x4*)(g1 + c + 4) + *(const f32x4*)(b1 + c + 4);
            v[2 * j] = h0 * DN_ALPHA + (a0 + c0); v[2 * j + 1] = h1 * DN_ALPHA + (a1 + c1);
            s += ((v[2 * j][0] + v[2 * j][1]) + (v[2 * j][2] + v[2 * j][3])) + ((v[2 * j + 1][0] + v[2 * j + 1][1]) + (v[2 * j + 1][2] + v[2 * j + 1][3])); }
        const float mu = wave_sum(s) * (1.f / DM); float q = 0.f;
#pragma unroll
        for (int j = 0; j < 8; ++j) { v[j] = v[j] - mu; q += (v[j][0] * v[j][0] + v[j][1] * v[j][1]) + (v[j][2] * v[j][2] + v[j][3] * v[j][3]); }
        const float rs = 1.f / sqrtf(wave_sum(q) * (1.f / DM) + LN_EPS);
#pragma unroll
        for (int j = 0; j < 4; ++j) { const int c = j * 512 + lane * 8;
            *(f32x4*)(out + (size_t)m * DM + c) = v[2 * j] * rs * *(const f32x4*)(g2 + c) + *(const f32x4*)(b2 + c);
            *(f32x4*)(out + (size_t)m * DM + c + 4) = v[2 * j + 1] * rs * *(const f32x4*)(g2 + c + 4) + *(const f32x4*)(b2 + c + 4); }
    }
}

__global__ void __launch_bounds__(512, 2) mk_fwd(Args args) {
    extern __shared__ __attribute__((aligned(16))) unsigned char lds_raw[];
    Frame F;
    F.lds = (LAS unsigned char*)lds_raw; F.ws = args.ws; F.in = args.in; F.out = args.out;
    F.tid = threadIdx.x; F.lane = F.tid & 63; F.wave = __builtin_amdgcn_readfirstlane(F.tid >> 6);
    F.G = gridDim.x; { const int bx = blockIdx.x; F.vcu = (F.G % 8 == 0) ? (bx % 8) * (F.G / 8) + bx / 8 : bx; }
    unsigned* ctl = (unsigned*)(args.ws + WS_CTL);
    volatile LAS unsigned* MISC = (volatile LAS unsigned*)(F.lds + MISC_OFF);
    if (F.tid < 32) MISC[F.tid] = 0u;
    __syncthreads();
    const int lo = args.ph_lo, hi = args.ph_hi;
    const bool multi = (hi - lo) > 1;
    __builtin_amdgcn_fence(__ATOMIC_ACQUIRE, "agent"); asm volatile("s_waitcnt vmcnt(0)" ::: "memory"); __syncthreads();
    XcdBarrier bar; bar.bar = ctl + CW_BAR; bar.x = 0; bar.st = MISC + 8;
    if (multi) bar = xcd_barrier_post(ctl + CW_BAR, MISC + 8);
    bool first_sync = true;
#ifndef PHASE_MASK
#define PHASE_MASK 0xFFF
#endif
#define IN(k) (((PHASE_MASK >> (k)) & 1) && lo <= (k) && (k) < hi)
#define SEAM(k) do { if (IN(k) && IN((k) + 1)) { if (first_sync) { first_sync = false; __threadfence(); cg::this_grid().sync(); } else xcd_barrier(bar); } } while (0)
    LAS unsigned char* ring = F.lds;

    if (IN(0)) { p0_prologue(F); SEAM(0); }
    if (IN(1)) {
        pg8::Gemm g{DM, DM * 2, DM * 2}; RectSched S; S.init(NT, IN_PAD, F.G, (int)blockIdx.x, WSP(bf16_t, WS_XB), DM * 2, WSP(bf16_t, WS_WIN), DM * 2);
        EpiInProj E; E.U = WSP(bf16_t, WS_U); E.Q = WSP(bf16_t, WS_Q); E.KVb = WSP(bf16_t, WS_KC);
        E.GM = WSP(bf16_t, WS_GM); E.GN = WSP(float, WS_GN); E.rope = WSP(const f32x4, WS_ROPE);
        pg8::gemm_phase<EpiInProj, RectSched, true>(ring, g, S, E);
        SEAM(1);
    }
    if (IN(2)) {
        p2_pool(F);
        __syncthreads();
        pg8::Gemm g{2048, 2048, 4096}; CmpSched S; S.vcu = F.vcu; S.A0 = (const char*)WSP(bf16_t, WS_KC); S.A1 = (const char*)WSP(bf16_t, WS_VC); S.B0 = (const char*)WSP(bf16_t, WS_CW1K); S.B1 = (const char*)WSP(bf16_t, WS_CW1V);
        EpiCmp1 E; E.H0 = WSP(bf16_t, WS_HK); E.H1 = WSP(bf16_t, WS_HV); E.bias = WSP(float, WS_CBIAS);
        pg8::gemm_phase<EpiCmp1, CmpSched, false>(ring, g, S, E);
        SEAM(2);
    }
    if (IN(3)) {
        pg8::Gemm g{256, 2048, 512}; MixSched S; S.vcu = F.vcu; S.G = F.G; S.A = (const char*)WSP(bf16_t, WS_POOLED); S.B = (const char*)WSP(bf16_t, WS_PM);
        EpiMix E; E.out = WSP(bf16_t, WS_MIXED); E.scale = F.in[3];
#ifndef NO_G4
        pg8::gemm_phase<EpiMix, MixSched, true>(ring, g, S, E);
#endif
#ifndef NO_ATT
        p3_cmp2(F);
#endif
        SEAM(3);
    }
    if (IN(4)) {
        pg8::Gemm g{1024, 2048, 2048}; RectSched S; S.init(NT, DM, F.G, (int)blockIdx.x, WSP(bf16_t, WS_MIXED), 2048, WSP(bf16_t, WS_WPP), 2048);
        EpiZP E; E.ZP = WSP(bf16_t, WS_ZP); E.GM = WSP(bf16_t, WS_GM);
#ifndef NO_G4
        pg8::gemm_phase<EpiZP, RectSched, true>(ring, g, S, E);
#endif
        __syncthreads();
#ifndef NO_ATT
        att::phase(F);
#endif
        SEAM(4);
    }
    if (IN(5)) {
        pg8::Gemm g{1024, 2048, 2048}; RectSched S; S.init(NT, DM, F.G, (int)blockIdx.x, WSP(bf16_t, WS_O), 2048, WSP(bf16_t, WS_WNP), 2048);
        EpiZ E; E.Z = WSP(bf16_t, WS_Z); E.ZP = WSP(bf16_t, WS_ZP); E.GM = WSP(bf16_t, WS_GM);
        pg8::gemm_phase<EpiZ, RectSched, true>(ring, g, S, E);
        SEAM(5);
    }
    if (IN(6)) {
        pg8::Gemm g{DM, DM * 2, DM * 2}; RectSched S; S.init(NT, DM, F.G, (int)blockIdx.x, WSP(bf16_t, WS_Z), DM * 2, WSP(bf16_t, WS_WO), DM * 2);
        EpiV1 E; E.V1 = F.out; E.x = F.in[0];
        pg8::gemm_phase<EpiV1, RectSched, true>(ring, g, S, E);
        SEAM(6);
    }
    if (IN(7)) { p7_router(F, ctl); SEAM(7); }
    if (IN(8)) { p8_gather(F, ctl); SEAM(8); }
    if (IN(9)) {
        const int ntile = expert_tables(F, ctl);
        pg8::Gemm g{DM, DM * 2, DM * 2}; MoeSched<4, 1024> S; S.vcu = F.vcu; S.G = F.G; S.ntile = ntile; S.A = (const char*)WSP(bf16_t, WS_XBUF); S.B = (const char*)WSP(bf16_t, WS_WGU); S.lda = DM * 2; S.ldb = DM * 2; S.texp = (const LAS int*)(F.lds + TAB_OFF + 256) + 68;
        EpiUp E; E.HID = WSP(bf16_t, WS_HID);
        pg8::gemm_phase<EpiUp, MoeSched<4, 1024>, true>(ring, g, S, E);
        SEAM(9);
    }
    if (IN(10)) {
        const int ntile = expert_tables(F, ctl);
        pg8::Gemm g{EH, EH * 2, EH * 2}; MoeSched<8, 2048> S; S.vcu = F.vcu; S.G = F.G; S.ntile = ntile; S.A = (const char*)WSP(bf16_t, WS_HID); S.B = (const char*)WSP(bf16_t, WS_WD); S.lda = EH * 2; S.ldb = EH * 2; S.texp = (const LAS int*)(F.lds + TAB_OFF + 256) + 68;
        EpiDown E; E.YB = WSP(bf16_t, WS_YB); E.rowmap = WSP(int, WS_ROWMAP); E.roww = WSP(float, WS_ROWW);
        pg8::gemm_phase<EpiDown, MoeSched<8, 2048>, true>(ring, g, S, E);
        SEAM(10);
    }
    if (IN(11)) { p11_final(F); }
    asm volatile("s_waitcnt vmcnt(0)" ::: "memory"); __syncthreads(); __builtin_amdgcn_fence(__ATOMIC_RELEASE, "agent"); asm volatile("s_waitcnt vmcnt(0)" ::: "memory");
#undef IN
#undef SEAM
}


#ifdef DBG_DUMP
__global__ void __launch_bounds__(512) dbg_dump(const unsigned char* ws, float* out) {
    const bf16_t* src = (const bf16_t*)(ws + (size_t)DBG_OFF);
    for (size_t i = (size_t)blockIdx.x * 512 + threadIdx.x; i < (size_t)NT * DM; i += (size_t)gridDim.x * 512) { const size_t m = i / DM, c = i % DM; out[i] = bf2f(src[(m % DBG_ROWS) * DBG_LD + (c % DBG_COLS)]); }
}
#endif

#ifdef DBG_CHECK
__global__ void __launch_bounds__(256) dbg_check(const float* x, const float* w_in, const unsigned char* ws, unsigned* errbits) {
    const int s = blockIdx.x * 256 + threadIdx.x;
    unsigned h = (unsigned)s * 2654435761u; h ^= h >> 15; h *= 2246822519u; h ^= h >> 13;
    const int m = h % NT; const int c = (h >> 14) % 4096;
    float acc = 0.f, accu = 0.f; const int cu = c % 1024;
    for (int k = 0; k < DM; ++k) { const float xv = x[(size_t)m * DM + k]; acc += xv * w_in[(size_t)k * IN_COLS + 3632 + c]; accu += xv * w_in[(size_t)k * IN_COLS + cu]; }
    const float ref = 1.f / (1.f + __expf(-acc));
    const float got = bf2f(((const bf16_t*)(ws + WS_GM))[(size_t)m * 4096 + c]);
    const float gotu = bf2f(((const bf16_t*)(ws + WS_U))[(size_t)m * PW + cu]);
    const float e = fabsf(got - ref), eu = fabsf(gotu - accu);
#if DBG_CHECK == 1
    if (!(eu < 0.06f)) atomicAdd(errbits, 1u);
#elif DBG_CHECK == 3
    { const int n = 3632 + c, k = (h >> 3) % DM; const float wv = w_in[(size_t)k * IN_COLS + n]; const float gw_ = bf2f(((const bf16_t*)(ws + WS_WIN))[(size_t)in_map(n) * DM + k]);
      if (!(fabsf(gw_ - wv) <= 0.01f * fabsf(wv) + 1e-6f)) atomicAdd(errbits, 1u); }
#else
    if (!(e < 0.02f)) atomicAdd(errbits, 1u);
#endif
}
__global__ void __launch_bounds__(512) dbg_fill(float* out, const unsigned* errbits) {
    const float v = 1.f + (float)(*errbits);
    for (size_t i = (size_t)blockIdx.x * 512 + threadIdx.x; i < (size_t)NT * DM; i += (size_t)gridDim.x * 512) out[i] = v;
}
#endif
extern "C" void kernel_launch(void* const* d_in, const int* in_sizes, int n_in, void* d_out, int out_size, void* d_ws, size_t ws_size, hipStream_t stream) {
    static int grid = 0;
    if (grid == 0) {
        if (n_in != 24 || out_size != NT * DM || ws_size < WS_END) { fprintf(stderr, "kernel_launch: unexpected problem (n_in %d, out %d, ws %zu < %zu)\n", n_in, out_size, ws_size, (size_t)WS_END); grid = -1; return; }
        int dev = 0, cus = 0, per_cu = 0;
        hipGetDevice(&dev); hipDeviceGetAttribute(&cus, hipDeviceAttributeMultiprocessorCount, dev);
        if (hipFuncSetAttribute((const void*)mk_fwd, hipFuncAttributeMaxDynamicSharedMemorySize, LDS_BYTES) != hipSuccess) { fprintf(stderr, "kernel_launch: hipFuncSetAttribute failed\n"); grid = -1; return; }
        if (hipOccupancyMaxActiveBlocksPerMultiprocessor(&per_cu, (const void*)mk_fwd, 512, LDS_BYTES) != hipSuccess || per_cu < 1) { fprintf(stderr, "kernel_launch: occupancy query says %d blocks per CU\n", per_cu); grid = -1; (void)hipGetLastError(); return; }
        grid = cus;
    }
    if (grid < 0) return;
    hipMemsetAsync((char*)d_ws + WS_CTL, 0, CTL_ZERO_BYTES, stream);
    Args a{};
    for (int i = 0; i < 24; ++i) a.in[i] = (const float*)d_in[i];
    a.out = (float*)d_out; a.ws = (unsigned char*)d_ws;
#if MK_PER_PHASE_LAUNCH
    for (int p = 0; p < DBG_NPH; ++p) { a.ph_lo = p; a.ph_hi = p + 1; hipLaunchKernelGGL(mk_fwd, dim3(grid), dim3(512), LDS_BYTES, stream, a); }
#ifdef DBG_CHECK
    hipMemsetAsync((char*)d_ws + 65536, 0, 4, stream);
    hipLaunchKernelGGL(dbg_check, dim3(16), dim3(256), 0, stream, (const float*)d_in[0], (const float*)d_in[1], (const unsigned char*)d_ws, (unsigned*)((char*)d_ws + 65536));
    hipLaunchKernelGGL(dbg_fill, dim3(1024), dim3(512), 0, stream, (float*)d_out, (const unsigned*)((char*)d_ws + 65536));
#endif
#ifdef DBG_DUMP
    hipLaunchKernelGGL(dbg_dump, dim3(1024), dim3(512), 0, stream, (const unsigned char*)d_ws, (float*)d_out);
#endif
#else
    a.ph_lo = 0; a.ph_hi = NPHASE;
    void* kargs[] = {&a};
    hipError_t e = hipLaunchCooperativeKernel((const void*)mk_fwd, dim3(grid), dim3(512), kargs, LDS_BYTES, stream);
    if (e != hipSuccess) fprintf(stderr, "kernel_launch: cooperative launch failed: %s (grid %d)\n", hipGetErrorString(e), grid);
#endif
}
```

```cpp
#include <hip/hip_runtime.h>
#include <hip/hip_cooperative_groups.h>
#include <cstdio>
#include <cstdint>
namespace cg = cooperative_groups;

#ifndef MK_PER_PHASE_LAUNCH
#define MK_PER_PHASE_LAUNCH 0
#endif

#define GAS __attribute__((address_space(1)))
#define LAS __attribute__((address_space(3)))
typedef unsigned short bf16_t;
typedef short bf16x8 __attribute__((ext_vector_type(8)));
typedef short s16x4 __attribute__((ext_vector_type(4)));
typedef float f32x2 __attribute__((ext_vector_type(2)));
typedef float f32x4 __attribute__((ext_vector_type(4)));
typedef float f32x16 __attribute__((ext_vector_type(16)));
typedef unsigned u32x2 __attribute__((ext_vector_type(2)));
typedef unsigned u32x4 __attribute__((ext_vector_type(4)));
typedef unsigned long long u64;

constexpr int NB = 4, SEQ = 4096, DM = 2048, NT = NB * SEQ;
constexpr int NH = 16, HD = 64, NG = 4;
constexpr int PW = 1024;
constexpr int IN_COLS = 7728, IN_PAD = 7936;
constexpr int NE = 64, EH = 512;
constexpr int MPAD = 49152;
constexpr float DN_ALPHA = 1.18920711500272f;
constexpr float LN_EPS = 1e-5f;
constexpr float C2 = 0.125f * 1.4426950408889634f;
constexpr int NPHASE = 12;
#ifndef DBG_NPH
#define DBG_NPH NPHASE
#endif
#define DBG_OFF (504ull << 20)
#define DBG_LD 4096
#define DBG_COLS 2048
#define DBG_ROWS 16384

constexpr size_t MiB = 1u << 20;
constexpr size_t WS_CTL = 0, CTL_ZERO_BYTES = 1 * MiB;
constexpr size_t WS_WGU = 1 * MiB, WS_WD = 257 * MiB, WS_WIN = 385 * MiB, WS_WPP = 416 * MiB, WS_WNP = 420 * MiB, WS_WO = 424 * MiB, WS_PM = 432 * MiB;
constexpr size_t WS_CW1K = 433 * MiB, WS_CW1V = 434 * MiB, WS_CW2K = 435 * MiB, WS_CW2V = 435 * MiB + 65536, WS_WRH = 436 * MiB, WS_WRL = 436 * MiB + 512 * 1024;
constexpr size_t WS_ROPE = 437 * MiB, WS_CBIAS = 438 * MiB;
constexpr size_t WS_XB = 440 * MiB, WS_POOLED = 440 * MiB, WS_MIXED = 472 * MiB, WS_H1B = 440 * MiB;
constexpr size_t WS_GM = 504 * MiB, WS_U = 632 * MiB, WS_Q = 664 * MiB;
constexpr size_t WS_KC = 696 * MiB, WS_VC = 705 * MiB, WS_KS = 714 * MiB, WS_VS = 722 * MiB, WS_KW = 730 * MiB, WS_VW = 738 * MiB;
constexpr size_t WS_GN = 746 * MiB, WS_KCMP = 750 * MiB, WS_VCMP = 750 * MiB + 512 * 1024, WS_HK = 751 * MiB, WS_HV = 753 * MiB;
constexpr size_t WS_ZP = 756 * MiB, WS_O = 820 * MiB, WS_Z = 852 * MiB;
constexpr size_t WS_STATS = 916 * MiB, WS_RTE = 917 * MiB, WS_RTW = 917 * MiB + 256 * 1024, WS_RTP = 917 * MiB + 512 * 1024, WS_ROWMAP = 919 * MiB, WS_ROWW = 920 * MiB;
constexpr size_t WS_XBUF = 504 * MiB, WS_HID = 696 * MiB, WS_YB = 756 * MiB;
constexpr size_t WS_END = 921 * MiB;
constexpr int CW_BAR = 4096, CW_CNT = 8192;

constexpr int RING_BYTES = 131072;
constexpr int MISC_OFF = 132096;
constexpr int TAB_OFF = MISC_OFF + 256;
constexpr int LDS_BYTES = 163840;

#define RLX_AGENT __ATOMIC_RELAXED, __HIP_MEMORY_SCOPE_AGENT
__device__ __forceinline__ unsigned f2bf(float f) { unsigned u = __builtin_bit_cast(unsigned, f); return (u + 0x7fffu + ((u >> 16) & 1u)) >> 16; }
__device__ __forceinline__ unsigned pk2(float lo, float hi) { return f2bf(lo) | (f2bf(hi) << 16); }
__device__ __forceinline__ float bf2f(unsigned short b) { return __builtin_bit_cast(float, (unsigned)b << 16); }
__device__ __forceinline__ float bflo(unsigned w) { return __builtin_bit_cast(float, w << 16); }
__device__ __forceinline__ float bfhi(unsigned w) { return __builtin_bit_cast(float, w & 0xffff0000u); }
typedef __bf16 bf16x2_t __attribute__((ext_vector_type(2)));
__device__ __forceinline__ unsigned cvt_pk_bf16(float lo, float hi) { const f32x2 v = {lo, hi}; const bf16x2_t b = __builtin_convertvector(v, bf16x2_t); return __builtin_bit_cast(unsigned, b); }
__device__ __forceinline__ void store8(bf16_t* p, f32x4 a, f32x4 b) { u32x4 w; w.x = cvt_pk_bf16(a[0], a[1]); w.y = cvt_pk_bf16(a[2], a[3]); w.z = cvt_pk_bf16(b[0], b[1]); w.w = cvt_pk_bf16(b[2], b[3]); *(u32x4*)p = w; }
__device__ __forceinline__ void load8(const bf16_t* p, f32x4& a, f32x4& b) { const u32x4 w = *(const u32x4*)p; a = (f32x4){bflo(w.x), bfhi(w.x), bflo(w.y), bfhi(w.y)}; b = (f32x4){bflo(w.z), bfhi(w.z), bflo(w.w), bfhi(w.w)}; }
__device__ __forceinline__ float fast_exp2(float x) { return __builtin_amdgcn_exp2f(x); }
__device__ __forceinline__ float sigmoidf_(float x) { return __builtin_amdgcn_rcpf(1.f + fast_exp2(-1.4426950408889634f * x)); }
__device__ __forceinline__ f32x4 sigmoid4(f32x4 v) { return (f32x4){sigmoidf_(v[0]), sigmoidf_(v[1]), sigmoidf_(v[2]), sigmoidf_(v[3])}; }
__device__ __forceinline__ float gelu_tanh(float x) { const float y = 0.7978845608028654f * (x + 0.044715f * x * x * x); const float e = fast_exp2(2.f * 1.4426950408889634f * y); const float th = 1.f - 2.f * __builtin_amdgcn_rcpf(e + 1.f); return 0.5f * x * (1.f + th); }
__device__ __forceinline__ float wave_sum(float v) {
#pragma unroll
    for (int o = 1; o < 64; o <<= 1) v += __shfl_xor(v, o);
    return v;
}

namespace pg8 {
constexpr int BM = 256, BK = 64, HALF = 128, HTB = HALF * BK * 2, STAGE_BYTES = 8 * HTB;
__host__ __device__ __forceinline__ int lds_byte(int r, int c) { const int st = (r >> 4) * 2 + (c >> 5), rr = r & 15, cc = c & 31, ob = rr * 64 + cc * 2; return st * 1024 + (ob ^ (((ob >> 9) & 1) << 5)); }
__host__ __device__ __forceinline__ void stage_rc(int b, int& R, int& C) { const int st = b / 1024, sb = b % 1024, swz = sb ^ (((sb >> 9) & 1) << 5); R = (st >> 1) * 16 + swz / 64; C = (st & 1) * 32 + (swz % 64) / 2; }
__host__ __device__ __forceinline__ int perm32(int rho) { const int n = rho >> 4, i = rho & 15; return 8 * (i >> 2) + 4 * n + (i & 3); }

struct Unit { int pm, pn; const char* a; const char* b; };
struct Gemm { int K; unsigned lda, ldb; };

template <class Epi, class Sched, bool ALIGN_EPI>
__device__ __forceinline__ void gemm_phase(LAS unsigned char* lds, const Gemm g, const Sched& S, const Epi& E) {
    const int tid = threadIdx.x, wid = __builtin_amdgcn_readfirstlane(tid >> 6), lane = tid & 63, wr = wid >> 2, wc = wid & 3, fr = lane & 15, fq = lane >> 4;
    const int K = g.K, nt = K / BK;
    unsigned voffA[2], voffB[2];
#pragma unroll
    for (int i = 0; i < 2; ++i) { int R, C; stage_rc(tid * 16 + i * 8192, R, C); const int Rb = Epi::PERM ? ((R & ~31) + perm32(R & 31)) : R;
        voffA[i] = (unsigned)R * g.lda + (unsigned)C * 2u; voffB[i] = (unsigned)Rb * g.ldb + (unsigned)C * 2u; }
    const size_t kstep = (size_t)(BK * 2);
    const size_t hstepA = (size_t)HALF * g.lda, hstepB = (size_t)HALF * g.ldb;
    const unsigned ldsw = (unsigned)wid * 1024u;
    const int aoff = lds_byte(wr * 64 + fr, fq * 8), boff = lds_byte(wc * 32 + fr, fq * 8);
#define PG8_SA(b, h) (((b) * 2 + (h)) * HTB)
#define PG8_SB(b, h) ((4 + (b) * 2 + (h)) * HTB)
#define PG8_STAGE(bufoff, gbase, voff) do { _Pragma("unroll") for (int _i = 0; _i < 2; ++_i) \
        __builtin_amdgcn_global_load_lds((const unsigned*)((const char*)(gbase) + (voff)[_i]), (LAS unsigned*)(lds + (bufoff) + ldsw + _i * 8192), 16, 0, 0); } while (0)
#define PG8_LDA(dst, b, h) do { _Pragma("unroll") for (int m = 0; m < 4; ++m) _Pragma("unroll") for (int k = 0; k < 2; ++k) dst[m][k] = *(const LAS bf16x8*)(lds + PG8_SA(b, h) + aoff + m * 2048 + k * 1024); } while (0)
#define PG8_LDB(dst, b, h) do { _Pragma("unroll") for (int n = 0; n < 2; ++n) _Pragma("unroll") for (int k = 0; k < 2; ++k) dst[n][k] = *(const LAS bf16x8*)(lds + PG8_SB(b, h) + boff + n * 2048 + k * 1024); } while (0)
#define PG8_MMA(ai, bj, At, Bt) do { __builtin_amdgcn_s_setprio(1); _Pragma("unroll") for (int m = 0; m < 4; ++m) _Pragma("unroll") for (int n = 0; n < 2; ++n) _Pragma("unroll") for (int k = 0; k < 2; ++k) \
        acc[ai][bj][m][n] = __builtin_amdgcn_mfma_f32_16x16x32_bf16(Bt[n][k], At[m][k], acc[ai][bj][m][n], 0, 0, 0); __builtin_amdgcn_s_setprio(0); } while (0)
#define PG8_WAIT_V(n) asm volatile("s_waitcnt vmcnt(" #n ")" ::: "memory")
#define PG8_WAIT_L(n) asm volatile("s_waitcnt lgkmcnt(" #n ")" ::: "memory")
#define PG8_BAR __builtin_amdgcn_s_barrier()
#define PG8_SCHED __builtin_amdgcn_sched_barrier(0)
    Unit cur, nxt; int ui = 0;
    if (!S.next(0, cur)) return;
    f32x4 acc[2][2][4][2];
#pragma unroll
    for (int a = 0; a < 2; ++a)
#pragma unroll
        for (int b = 0; b < 2; ++b)
#pragma unroll
            for (int m = 0; m < 4; ++m)
#pragma unroll
                for (int n = 0; n < 2; ++n) acc[a][b][m][n] = (f32x4){0.f, 0.f, 0.f, 0.f};
    bf16x8 At[4][2], B0[2][2], B1[2][2];
    const char* cA = cur.a; const char* cB = cur.b;
    PG8_STAGE(PG8_SB(0, 0), cB, voffB); PG8_STAGE(PG8_SB(0, 1), cB + hstepB, voffB); PG8_STAGE(PG8_SA(0, 0), cA, voffA); PG8_STAGE(PG8_SA(0, 1), cA + hstepA, voffA);
    if (wr == 1) PG8_BAR;
    PG8_WAIT_V(2); PG8_BAR;
    PG8_STAGE(PG8_SB(1, 0), cB + kstep, voffB); PG8_STAGE(PG8_SA(1, 0), cA + kstep, voffA); PG8_STAGE(PG8_SB(1, 1), cB + hstepB + kstep, voffB);
    PG8_WAIT_V(6); PG8_BAR;
    for (;;) {
        const bool has_next = S.next(ui + 1, nxt);
        const char* nA = has_next ? nxt.a : cA; const char* nB = has_next ? nxt.b : cB;
#pragma unroll 1
        for (int t = 0; t < nt; t += 2) {
            const bool last = (t == nt - 2);
            const char* a1 = cA + (size_t)(t + 1) * kstep;
            const char* a2 = last ? nA : cA + (size_t)(t + 2) * kstep; const char* b2 = last ? nB : cB + (size_t)(t + 2) * kstep;
            const char* a3 = a2 + kstep; const char* b3 = b2 + kstep;
            PG8_LDB(B0, 0, 0); PG8_LDB(B1, 0, 1); PG8_SCHED; PG8_LDA(At, 0, 0); PG8_STAGE(PG8_SA(1, 1), a1 + hstepA, voffA);
            PG8_WAIT_V(8); PG8_WAIT_L(0); PG8_BAR; PG8_MMA(0, 0, At, B0); PG8_MMA(0, 1, At, B1); PG8_BAR; PG8_SCHED;
            PG8_LDA(At, 0, 1); PG8_STAGE(PG8_SB(0, 0), b2, voffB); PG8_STAGE(PG8_SB(0, 1), b2 + hstepB, voffB); PG8_STAGE(PG8_SA(0, 0), a2, voffA);
            PG8_WAIT_V(8); PG8_WAIT_L(0); PG8_BAR; PG8_MMA(1, 0, At, B0); PG8_MMA(1, 1, At, B1); PG8_BAR; PG8_SCHED;
            PG8_LDB(B0, 1, 0); PG8_LDB(B1, 1, 1); PG8_SCHED; PG8_LDA(At, 1, 0); PG8_STAGE(PG8_SA(0, 1), a2 + hstepA, voffA);
            PG8_WAIT_V(8); PG8_WAIT_L(0); PG8_BAR; PG8_MMA(0, 0, At, B0); PG8_MMA(0, 1, At, B1); PG8_BAR; PG8_SCHED;
            PG8_LDA(At, 1, 1); PG8_STAGE(PG8_SB(1, 0), b3, voffB); PG8_STAGE(PG8_SB(1, 1), b3 + hstepB, voffB); PG8_STAGE(PG8_SA(1, 0), a3, voffA);
            PG8_WAIT_V(8); PG8_WAIT_L(0); PG8_BAR; PG8_MMA(1, 0, At, B0); PG8_MMA(1, 1, At, B1); PG8_BAR; PG8_SCHED;
        }
        if constexpr (ALIGN_EPI) { if (wr == 0) PG8_BAR; }
        E(acc, cur, wr, wc, fr, fq);
        if (!has_next) break;
#pragma unroll
        for (int a = 0; a < 2; ++a)
#pragma unroll
            for (int b = 0; b < 2; ++b)
#pragma unroll
                for (int m = 0; m < 4; ++m)
#pragma unroll
                    for (int n = 0; n < 2; ++n) acc[a][b][m][n] = (f32x4){0.f, 0.f, 0.f, 0.f};
        cur = nxt; cA = nA; cB = nB; ++ui;
        if constexpr (ALIGN_EPI) { if (wr == 1) PG8_BAR; }
    }
    PG8_WAIT_V(0);
    if constexpr (!ALIGN_EPI) { if (wr == 0) PG8_BAR; }
    PG8_BAR;
#undef PG8_SA
#undef PG8_SB
#undef PG8_STAGE
#undef PG8_LDA
#undef PG8_LDB
#undef PG8_MMA
#undef PG8_WAIT_V
#undef PG8_WAIT_L
#undef PG8_BAR
#undef PG8_SCHED
}
}
using pg8::Unit;

struct RectSched {
    int nM, nN, nwg, G, c; const char* A; const char* B; size_t tA, tB;
    __device__ void init(int M, int N, int G_, int c_, const void* A_, unsigned lda, const void* B_, unsigned ldb) { nM = M / 256; nN = N / 256; nwg = nM * nN; G = G_; c = c_; A = (const char*)A_; B = (const char*)B_; tA = (size_t)256 * lda; tB = (size_t)256 * ldb; }
    __device__ bool next(int i, Unit& u) const {
        const long L = (long)i * G + c; if (L >= nwg) return false;
        int wgid = (int)L; { const int q = nwg / 8, r = nwg % 8, xcd = wgid % 8, off = wgid / 8; wgid = (xcd < r ? xcd * (q + 1) : r * (q + 1) + (xcd - r) * q) + off; }
        const int nig = 8 * nN, gid = wgid / nig, fm = gid * 8, gsz = (nM - fm) < 8 ? (nM - fm) : 8;
        u.pm = fm + ((wgid % nig) % gsz); u.pn = (wgid % nig) / gsz; u.a = A + (size_t)u.pm * tA; u.b = B + (size_t)u.pn * tB; return true;
    }
};
struct CmpSched {
    int vcu; const char* A0; const char* A1; const char* B0; const char* B1;
    __device__ bool next(int i, Unit& u) const { if (i > 0 || vcu >= 32) return false; u.pm = vcu & 15; u.pn = vcu >> 4; u.a = (u.pn ? A1 : A0) + (size_t)u.pm * 256 * 2048; u.b = u.pn ? B1 : B0; return true; }
};
struct MixSched {
    int vcu, G; const char* A; const char* B;
    __device__ bool next(int i, Unit& u) const { const int L = i * G + vcu; if (L >= 256) return false; u.pm = L >> 2; u.pn = L & 3; u.a = A + (size_t)u.pm * 256 * 2048 + u.pn * 512; u.b = B + (size_t)u.pn * 256 * 512; return true; }
};
template <int NCT, int NEXP_ROWS  > struct MoeSched {
    int vcu, G, ntile; const char* A; const char* B; unsigned lda, ldb; const LAS int* texp;
    __device__ bool next(int i, Unit& u) const { const int L = i * G + vcu; if (L >= ntile * NCT) return false; u.pm = L / NCT; u.pn = L % NCT; const int e = texp[u.pm];
        u.a = A + (size_t)u.pm * 256 * lda; u.b = B + ((size_t)e * NEXP_ROWS + (size_t)u.pn * 256) * ldb; return true; }
};

struct EpiInProj {
    static constexpr bool PERM = true;
    bf16_t* U; bf16_t* Q; bf16_t* KVb; bf16_t* GM; float* GN; const f32x4* rope;
    __device__ __forceinline__ void operator()(const f32x4 (&acc)[2][2][4][2], const Unit& u, int wr, int wc, int fr, int fq) const {
        const int pn = u.pn, row0 = u.pm * 256 + wr * 64 + fr, cit = wc * 32 + 8 * fq;
        if (pn < 4) {
#pragma unroll
            for (int ai = 0; ai < 2; ++ai)
#pragma unroll
                for (int m = 0; m < 4; ++m) { bf16_t* rp = U + (size_t)(row0 + ai * 128 + m * 16) * PW + pn * 256 + cit;
#pragma unroll
                    for (int bj = 0; bj < 2; ++bj) store8(rp + bj * 128, acc[ai][bj][m][0], acc[ai][bj][m][1]); }
        } else if (pn < 14) {
            const bool isq = pn < 8; const int kind = pn - 8; const bool dorope = isq || kind == 2 || kind == 4;
            const int p0 = 32 * (wc & 1) + 8 * fq, gI = 4 * (wc & 1) + fq;
            const size_t kvo = kind == 1 ? (WS_VC - WS_KC) : kind == 2 ? (WS_KS - WS_KC) : kind == 3 ? (WS_VS - WS_KC) : kind == 4 ? (WS_KW - WS_KC) : kind == 5 ? (WS_VW - WS_KC) : 0;
            bf16_t* base = isq ? Q : (bf16_t*)((char*)KVb + kvo);
            const float sc = isq ? C2 : 1.f;
#pragma unroll
            for (int ai = 0; ai < 2; ++ai)
#pragma unroll
                for (int m = 0; m < 4; ++m) { const int row = row0 + ai * 128 + m * 16, b = row >> 12, t = row & 4095;
                    f32x4 cs0 = (f32x4){1.f, 0.f, 1.f, 0.f}, cs1 = cs0;
                    if (dorope) { cs0 = rope[t * 16 + gI * 2]; cs1 = rope[t * 16 + gI * 2 + 1]; }
#pragma unroll
                    for (int bj = 0; bj < 2; ++bj) { const int hit = 2 * bj + (wc >> 1);
                        const f32x4 x1 = acc[ai][bj][m][0], x2 = acc[ai][bj][m][1];
                        const f32x4 c = (f32x4){cs0[0], cs0[2], cs1[0], cs1[2]}, s = (f32x4){cs0[1], cs0[3], cs1[1], cs1[3]};
                        const f32x4 y1 = (x1 * c - x2 * s) * sc, y2 = (x2 * c + x1 * s) * sc;
                        const size_t hrow = isq ? ((size_t)(b * NH + (pn - 4) * 4 + hit) * SEQ + t) : ((size_t)(b * NG + hit) * SEQ + t);
                        store8(base + hrow * HD + p0, y1, y2); } }
        } else if (pn < 30) {
#pragma unroll
            for (int ai = 0; ai < 2; ++ai)
#pragma unroll
                for (int m = 0; m < 4; ++m) { bf16_t* rp = GM + (size_t)(row0 + ai * 128 + m * 16) * 4096 + (pn - 14) * 256 + cit;
#pragma unroll
                    for (int bj = 0; bj < 2; ++bj) store8(rp + bj * 128, sigmoid4(acc[ai][bj][m][0]), sigmoid4(acc[ai][bj][m][1])); }
        } else {
            if (wc < 2) {
#pragma unroll
                for (int ai = 0; ai < 2; ++ai)
#pragma unroll
                    for (int m = 0; m < 4; ++m) { float* rp = GN + (size_t)(row0 + ai * 128 + m * 16) * 64;
#pragma unroll
                        for (int n = 0; n < 2; ++n) { const int col = cit + 4 * n; if (col < 48) *(f32x4*)(rp + col) = sigmoid4(acc[ai][0][m][n]); } }
            }
        }
    }
};
struct EpiCmp1 {
    static constexpr bool PERM = true;
    bf16_t* H0; bf16_t* H1; const float* bias;
    __device__ __forceinline__ void operator()(const f32x4 (&acc)[2][2][4][2], const Unit& u, int wr, int wc, int fr, int fq) const {
        const int row0 = u.pm * 256 + wr * 64 + fr, cit = wc * 32 + 8 * fq; bf16_t* out = u.pn ? H1 : H0; const float* bs = bias + u.pn * 256;
#pragma unroll
        for (int bj = 0; bj < 2; ++bj) { const f32x4 b0 = *(const f32x4*)(bs + bj * 128 + cit), b1 = *(const f32x4*)(bs + bj * 128 + cit + 4);
#pragma unroll
            for (int ai = 0; ai < 2; ++ai)
#pragma unroll
                for (int m = 0; m < 4; ++m) { f32x4 v0 = acc[ai][bj][m][0] + b0, v1 = acc[ai][bj][m][1] + b1;
#pragma unroll
                    for (int j = 0; j < 4; ++j) { v0[j] = gelu_tanh(v0[j]); v1[j] = gelu_tanh(v1[j]); }
                    store8(out + (size_t)(row0 + ai * 128 + m * 16) * 256 + bj * 128 + cit, v0, v1); } }
    }
};
struct EpiMix {
    static constexpr bool PERM = true;
    bf16_t* out; const float* scale;
    __device__ __forceinline__ void operator()(const f32x4 (&acc)[2][2][4][2], const Unit& u, int wr, int wc, int fr, int fq) const {
        const int row0 = u.pm * 256 + wr * 64 + fr, cit = wc * 32 + 8 * fq, cb = u.pn * 256;
#pragma unroll
        for (int bj = 0; bj < 2; ++bj) { const f32x4 s0 = *(const f32x4*)(scale + cb + bj * 128 + cit), s1 = *(const f32x4*)(scale + cb + bj * 128 + cit + 4);
#pragma unroll
            for (int ai = 0; ai < 2; ++ai)
#pragma unroll
                for (int m = 0; m < 4; ++m) store8(out + (size_t)(row0 + ai * 128 + m * 16) * PW + cb + bj * 128 + cit, acc[ai][bj][m][0] * s0, acc[ai][bj][m][1] * s1); }
    }
};
struct EpiZP {
    static constexpr bool PERM = true;
    bf16_t* ZP; const bf16_t* GM;
    __device__ __forceinline__ void operator()(const f32x4 (&acc)[2][2][4][2], const Unit& u, int wr, int wc, int fr, int fq) const {
        const int row0 = u.pm * 256 + wr * 64 + fr, col0 = u.pn * 256 + wc * 32 + 8 * fq;
#pragma unroll
        for (int ai = 0; ai < 2; ++ai)
#pragma unroll
            for (int m = 0; m < 4; ++m) { const size_t row = row0 + ai * 128 + m * 16;
#pragma unroll
                for (int bj = 0; bj < 2; ++bj) { f32x4 g0, g1; load8(GM + row * 4096 + col0 + bj * 128, g0, g1);
                    store8(ZP + row * DM + col0 + bj * 128, acc[ai][bj][m][0] * g0, acc[ai][bj][m][1] * g1); } }
    }
};
struct EpiZ {
    static constexpr bool PERM = true;
    bf16_t* Z; const bf16_t* ZP; const bf16_t* GM;
    __device__ __forceinline__ void operator()(const f32x4 (&acc)[2][2][4][2], const Unit& u, int wr, int wc, int fr, int fq) const {
        const int row0 = u.pm * 256 + wr * 64 + fr, col0 = u.pn * 256 + wc * 32 + 8 * fq;
#pragma unroll
        for (int ai = 0; ai < 2; ++ai)
#pragma unroll
            for (int m = 0; m < 4; ++m) { const size_t row = row0 + ai * 128 + m * 16;
#pragma unroll
                for (int bj = 0; bj < 2; ++bj) { f32x4 g0, g1, z0, z1; load8(GM + row * 4096 + 2048 + col0 + bj * 128, g0, g1); load8(ZP + row * DM + col0 + bj * 128, z0, z1);
                    store8(Z + row * DM + col0 + bj * 128, z0 + acc[ai][bj][m][0] * g0, z1 + acc[ai][bj][m][1] * g1); } }
    }
};
struct EpiV1 {
    static constexpr bool PERM = false;
    float* V1; const float* x;
    __device__ __forceinline__ void operator()(const f32x4 (&acc)[2][2][4][2], const Unit& u, int wr, int wc, int fr, int fq) const {
        const int row0 = u.pm * 256 + wr * 64 + fr, col0 = u.pn * 256 + wc * 32 + 4 * fq;
#pragma unroll
        for (int ai = 0; ai < 2; ++ai)
#pragma unroll
            for (int m = 0; m < 4; ++m) { const size_t off = (size_t)(row0 + ai * 128 + m * 16) * DM + col0;
#pragma unroll
                for (int bj = 0; bj < 2; ++bj)
#pragma unroll
                    for (int n = 0; n < 2; ++n) { const f32x4 xv = *(const f32x4*)(x + off + bj * 128 + n * 16); *(f32x4*)(V1 + off + bj * 128 + n * 16) = xv * DN_ALPHA + acc[ai][bj][m][n]; } }
    }
};
struct EpiUp {
    static constexpr bool PERM = true;
    bf16_t* HID;
    __device__ __forceinline__ void operator()(const f32x4 (&acc)[2][2][4][2], const Unit& u, int wr, int wc, int fr, int fq) const {
        const int row0 = u.pm * 256 + wr * 64 + fr, col0 = u.pn * 128 + wc * 32 + 8 * fq;
#pragma unroll
        for (int ai = 0; ai < 2; ++ai)
#pragma unroll
            for (int m = 0; m < 4; ++m) { f32x4 h0, h1;
#pragma unroll
                for (int j = 0; j < 4; ++j) { const float g0 = acc[ai][0][m][0][j], g1 = acc[ai][0][m][1][j]; h0[j] = g0 * sigmoidf_(g0) * acc[ai][1][m][0][j]; h1[j] = g1 * sigmoidf_(g1) * acc[ai][1][m][1][j]; }
                store8(HID + (size_t)(row0 + ai * 128 + m * 16) * EH + col0, h0, h1); }
    }
};
struct EpiDown {
    static constexpr bool PERM = true;
    bf16_t* YB; const int* rowmap; const float* roww;
    __device__ __forceinline__ void operator()(const f32x4 (&acc)[2][2][4][2], const Unit& u, int wr, int wc, int fr, int fq) const {
        const int row0 = u.pm * 256 + wr * 64 + fr, col0 = u.pn * 256 + wc * 32 + 8 * fq;
#pragma unroll
        for (int ai = 0; ai < 2; ++ai)
#pragma unroll
            for (int m = 0; m < 4; ++m) { const int dest = row0 + ai * 128 + m * 16; const int slot = rowmap[dest]; const float w = roww[dest];
                if (slot >= 0) {
#pragma unroll
                    for (int bj = 0; bj < 2; ++bj) store8(YB + (size_t)slot * DM + col0 + bj * 128, acc[ai][bj][m][0] * w, acc[ai][bj][m][1] * w); } }
    }
};

#define XB_TMO      128
#define XB_XCNT(j)  (256  + 64 * (j))
#define XB_XSUB(j)  (1280 + 64 * (j))
#define XB_XGEN(j)  (2304 + 64 * (j))
#define XB_TOP      3328
#define XB_TOPGEN   3392
#define XCD_BAR_WORDS 3456
#define XB_SPIN_CAP (1u << 20)
__device__ __forceinline__ unsigned xb_ld(unsigned* p)              { return __hip_atomic_load(p, __ATOMIC_RELAXED, __HIP_MEMORY_SCOPE_AGENT); }
__device__ __forceinline__ unsigned xb_add(unsigned* p, unsigned v) { return __hip_atomic_fetch_add(p, v, __ATOMIC_RELAXED, __HIP_MEMORY_SCOPE_AGENT); }
__device__ __forceinline__ unsigned xb_xcc_id() { return (unsigned)__builtin_amdgcn_s_getreg((3 << 11) | 20) & 0xFu; }
#define XB_SPIN(cond, bar) do { unsigned _sp = 0; while (cond) { __builtin_amdgcn_s_sleep(1); \
    if ((++_sp & 255u) == 0u) { if (xb_ld(&(bar)[XB_TMO])) break; if (_sp > XB_SPIN_CAP) { atomicAdd(&(bar)[XB_TMO], 1u); break; } } } } while (0)
struct XcdBarrier { unsigned* bar; unsigned x; volatile LAS unsigned* st; };
__device__ __forceinline__ XcdBarrier xcd_barrier_post(unsigned* bar, volatile LAS unsigned* st) {
    XcdBarrier b; b.bar = bar; b.x = xb_xcc_id(); b.st = st;
    if (threadIdx.x == 0) (void)xb_add(&bar[XB_XCNT(b.x)], 1u);
    return b;
}
__device__ __forceinline__ void xcd_barrier_complete(unsigned* bar, unsigned x, unsigned& nloc, unsigned& nx) {
    const unsigned G = gridDim.x * gridDim.y * gridDim.z;
    unsigned sum, cnt, mine, sp = 0u;
    for (;;) {
        sum = 0u; cnt = 0u; mine = 0u;
#pragma unroll
        for (unsigned j = 0; j < 16; ++j) { const unsigned c = xb_ld(&bar[XB_XCNT(j)]); sum += c; cnt += (c > 0u) ? 1u : 0u; mine = (j == x) ? c : mine; }
        if (sum == G) break;
        __builtin_amdgcn_s_sleep(1);
        if ((++sp & 255u) == 0u) { if (xb_ld(&bar[XB_TMO])) break; if (sp > XB_SPIN_CAP) { atomicAdd(&bar[XB_TMO], 1u); break; } }
    }
    nloc = mine > 0u ? mine : 1u; nx = cnt > 0u ? cnt : 1u;
}
__device__ __forceinline__ void xcd_barrier(const XcdBarrier& b) {
    asm volatile("s_waitcnt vmcnt(0)" ::: "memory");
    __syncthreads();
    if (threadIdx.x == 0) {
        unsigned* bar = b.bar;
        __builtin_amdgcn_s_waitcnt(0);
        unsigned nloc = b.st[0], nx = b.st[1];
        if (nloc == 0u) { xcd_barrier_complete(bar, b.x, nloc, nx); b.st[0] = nloc; b.st[1] = nx; }
        const unsigned old = xb_add(&bar[XB_XSUB(b.x)], 1u);
        const unsigned gen = old / nloc;
        if (old + 1u == (gen + 1u) * nloc) {
            __builtin_amdgcn_fence(__ATOMIC_RELEASE, "agent");
            asm volatile("s_waitcnt vmcnt(0)" ::: "memory");
            const unsigned og = xb_add(&bar[XB_TOP], 1u);
            const unsigned tg = og / nx;
            if (og + 1u == (tg + 1u) * nx) xb_add(&bar[XB_TOPGEN], 1u);
            else XB_SPIN(xb_ld(&bar[XB_TOPGEN]) == tg, bar);
            __builtin_amdgcn_fence(__ATOMIC_ACQUIRE, "agent");
            xb_add(&bar[XB_XGEN(b.x)], 1u);
            asm volatile("s_waitcnt vmcnt(0)" ::: "memory");
        } else {
            XB_SPIN(xb_ld(&bar[XB_XGEN(b.x)]) == gen, bar);
            __builtin_amdgcn_fence(__ATOMIC_ACQUIRE, "agent");
            asm volatile("s_waitcnt vmcnt(0)" ::: "memory");
        }
    }
    __syncthreads();
}

struct Args { const float* in[24]; float* out; unsigned char* ws; int ph_lo, ph_hi; };
struct Frame {
    LAS unsigned char* lds; unsigned char* ws; const float* const* in; float* out;
    int tid, lane, wave, vcu, G;
};
#define WSP(T, off) ((T*)(F.ws + (off)))

__device__ __forceinline__ int ropepos(int d) { return d < 32 ? 8 * (d >> 2) + (d & 3) : 8 * ((d - 32) >> 2) + 4 + (d & 3); }
__device__ __forceinline__ int in_map(int n) {
    if (n < 1024) return n;
    if (n < 2048) { const int r = n - 1024; return 1024 + (r & ~63) + ropepos(r & 63); }
    if (n < 3584) { const int seg = (n - 2048) >> 8; if (seg == 2 || seg == 4) { const int r = n - 2048; return 2048 + (r & ~63) + ropepos(r & 63); } return n; }
    if (n < 3632) return 7680 + (n - 3584);
    return 3584 + (n - 3632);
}
template <int MAP  >
__device__ __forceinline__ void transpose_item(const float* W, int N, bf16_t* WT, int ldt, LAS float* scr, int item, int lane) {
    const int nblk = (N + 31) / 32, kb = item / nblk, nb = item % nblk, k0 = 64 * kb, n0 = 32 * nb;
    const int ncol = n0 + (lane & 31); const bool okc = ncol < N;
#pragma unroll 8
    for (int i = 0; i < 32; ++i) { const int kk = 2 * i + (lane >> 5); scr[kk * 33 + (lane & 31)] = okc ? W[(size_t)(k0 + kk) * N + ncol] : 0.f; }
    asm volatile("s_waitcnt lgkmcnt(0)" ::: "memory");
    const int c = lane & 7;
#pragma unroll
    for (int j = 0; j < 4; ++j) { const int nl = (lane >> 3) + 8 * j, n = n0 + nl; const LAS float* s = scr + (8 * c) * 33 + nl;
        u32x4 o; o.x = pk2(s[0 * 33], s[1 * 33]); o.y = pk2(s[2 * 33], s[3 * 33]); o.z = pk2(s[4 * 33], s[5 * 33]); o.w = pk2(s[6 * 33], s[7 * 33]);
        int dr = n; if (MAP == 1) dr = in_map(n); if (MAP == 2) dr = (n >> 7) * 256 + (n & 127); if (MAP == 3) dr = (n >> 7) * 256 + 128 + (n & 127);
        if (n < N) *(u32x4*)(WT + (size_t)dr * ldt + k0 + 8 * c) = o; }
    asm volatile("s_waitcnt lgkmcnt(0)" ::: "memory");
}
__device__ __forceinline__ void p0_prologue(Frame& F) {
    LAS float* scr = (LAS float*)(F.lds + F.wave * 16384);
    const int gw = F.vcu * 8 + F.wave, NGW = F.G * 8, lane = F.lane;
    const float* const* in = F.in;
    constexpr int I_IN = 32 * 242, I_PP = 16 * 64, I_NP = 16 * 64, I_WO = 32 * 64, I_PM = 4 * 4 * 8, I_C1 = 32 * 8, I_C2 = 4 * 2, I_G = 32 * 16, I_D = 8 * 64;
    constexpr int NSMALL = I_IN + I_PP + I_NP + I_WO + I_PM + 2 * I_C1 + 2 * I_C2;
    constexpr int NITEMS = NSMALL + NE * (2 * I_G + I_D);
    for (int it = gw; it < NITEMS; it += NGW) {
        int r = it;
        if (r < NSMALL) {
            if (r < I_IN) { transpose_item<1>(in[1], IN_COLS, WSP(bf16_t, WS_WIN), DM, scr, r, lane); continue; } r -= I_IN;
            if (r < I_PP) { transpose_item<0>(in[4], DM, WSP(bf16_t, WS_WPP), PW, scr, r, lane); continue; } r -= I_PP;
            if (r < I_NP) { transpose_item<0>(in[5], DM, WSP(bf16_t, WS_WNP), 1024, scr, r, lane); continue; } r -= I_NP;
            if (r < I_WO) { transpose_item<0>(in[12], DM, WSP(bf16_t, WS_WO), DM, scr, r, lane); continue; } r -= I_WO;
            if (r < I_PM) { const int g = r / 32; transpose_item<0>(in[2] + (size_t)g * 65536, 256, WSP(bf16_t, WS_PM) + (size_t)g * 65536, 256, scr, r % 32, lane); continue; } r -= I_PM;
            if (r < I_C1) { transpose_item<0>(in[8], 256, WSP(bf16_t, WS_CW1K), 2048, scr, r, lane); continue; } r -= I_C1;
            if (r < I_C1) { transpose_item<0>(in[10], 256, WSP(bf16_t, WS_CW1V), 2048, scr, r, lane); continue; } r -= I_C1;
            if (r < I_C2) { transpose_item<0>(in[9], 64, WSP(bf16_t, WS_CW2K), 256, scr, r, lane); continue; } r -= I_C2;
            transpose_item<0>(in[11], 64, WSP(bf16_t, WS_CW2V), 256, scr, r, lane); continue;
        }
        r -= NSMALL;
        const int e = r / (2 * I_G + I_D); r -= e * (2 * I_G + I_D);
        if (r < I_G) { transpose_item<2>(in[19] + (size_t)e * DM * EH, EH, WSP(bf16_t, WS_WGU) + (size_t)e * 1024 * DM, DM, scr, r, lane); continue; } r -= I_G;
        if (r < I_G) { transpose_item<3>(in[20] + (size_t)e * DM * EH, EH, WSP(bf16_t, WS_WGU) + (size_t)e * 1024 * DM, DM, scr, r, lane); continue; } r -= I_G;
        transpose_item<0>(in[21] + (size_t)e * EH * DM, DM, WSP(bf16_t, WS_WD) + (size_t)e * DM * EH, EH, scr, r, lane);
    }
    const size_t gt = (size_t)F.vcu * 512 + F.tid, TT = (size_t)F.G * 512;
    { const float* x = in[0]; bf16_t* xb = WSP(bf16_t, WS_XB);
      for (size_t i = gt; i < (size_t)NT * DM / 8; i += TT) { const f32x4 a = *(const f32x4*)(x + i * 8), b = *(const f32x4*)(x + i * 8 + 4); u32x4 o; o.x = pk2(a[0], a[1]); o.y = pk2(a[2], a[3]); o.z = pk2(b[0], b[1]); o.w = pk2(b[2], b[3]); *(u32x4*)(xb + i * 8) = o; } }
    {
      const float invf[32] = {1.f, 0.749894261f, 0.562341332f, 0.421696514f, 0.316227764f, 0.237137377f, 0.177827939f, 0.133352131f, 0.100000001f, 0.0749894157f, 0.0562341325f, 0.0421696529f, 0.0316227749f, 0.0237137377f, 0.0177827943f, 0.0133352149f, 0.00999999978f, 0.00749894185f, 0.00562341325f, 0.00421696482f, 0.00316227763f, 0.00237137359f, 0.00177827943f, 0.00133352145f, 0.00100000005f, 0.000749894243f, 0.000562341302f, 0.000421696517f, 0.000316227757f, 0.00023713737f, 0.00017782794f, 0.00013335215f};
      f32x2* rt = WSP(f32x2, WS_ROPE);
      for (size_t i = gt; i < (size_t)SEQ * 32; i += TT) { const int t = (int)(i >> 5), k = (int)(i & 31);
          float fr = 1.f;
#pragma unroll
          for (int q = 0; q < 32; ++q) fr = (k == q) ? invf[q] : fr;
          const float ang = (float)t * fr; double rev = (double)ang * 0.15915494309189535; rev -= __builtin_rint(rev); const float r = (float)rev;
          rt[i] = (f32x2){__builtin_amdgcn_cosf(r), __builtin_amdgcn_sinf(r)}; } }
    {
      bf16_t* wh = WSP(bf16_t, WS_WRH); bf16_t* wl = WSP(bf16_t, WS_WRL);
      for (size_t i = gt; i < (size_t)80 * DM; i += TT) { const int r = (int)(i / DM), k = (int)(i % DM); float v = 0.f;
          if (r < 8) v = in[15][(size_t)k * 8 + r]; else if (r < 72) { const int g = (r - 8) >> 3, e = (r - 8) & 7; v = in[17][((size_t)g * DM + k) * 8 + e]; }
          const unsigned h = f2bf(v); const float hv = __builtin_bit_cast(float, h << 16); wh[i] = (bf16_t)h; wl[i] = (bf16_t)f2bf(v - hv); } }
    {
      float* cb = WSP(float, WS_CBIAS);
      for (int o = gw; o < 512; o += NGW) { const int side = o >> 8, col = o & 255; const float* pos = in[side ? 7 : 6]; const float* w1 = in[side ? 10 : 8]; float s = 0.f;
          for (int k = lane; k < 2048; k += 64) s += pos[k] * w1[(size_t)k * 256 + col];
          s = wave_sum(s); if (lane == 0) cb[o] = s; } }
}

__device__ __forceinline__ void p2_pool(Frame& F) {
    const bf16_t* U = WSP(bf16_t, WS_U); bf16_t* P = WSP(bf16_t, WS_POOLED);
    const int gt = F.vcu * 512 + F.tid, TT = F.G * 512;
    for (int it = gt; it < (NT / 16) * 128; it += TT) {
        const int cc = it & 127, rb = it >> 7, m0 = rb * 16, t0 = m0 & 4095, g = cc >> 5, w = 2 << g;
        const bf16_t* up = U + (size_t)m0 * PW + cc * 8;
        f32x4 s0 = (f32x4){0.f, 0.f, 0.f, 0.f}, s1 = s0;
        for (int j = 1; j < w; ++j) if (t0 - j >= 0) { f32x4 a, b; load8(up - (size_t)j * PW, a, b); s0 += a; s1 += b; }
        for (int i = 0; i < 16; ++i) { const int t = t0 + i; f32x4 a, b; load8(up + (size_t)i * PW, a, b); s0 += a; s1 += b;
            const float inv = 1.f / (float)((t + 1 < w) ? (t + 1) : w);
            store8(P + (size_t)(m0 + i) * PW + cc * 8, s0 * inv - a, s1 * inv - b);
            if (t - w + 1 >= 0) { f32x4 c, d; load8(up + (size_t)(i - w + 1) * PW, c, d); s0 -= c; s1 -= d; } }
    }
}

__device__ __forceinline__ void p3_cmp2(Frame& F) {
    const int gw = F.vcu * 8 + F.wave, NGW = F.G * 8, lane = F.lane, fr = lane & 15, kg = lane >> 4;
    const f32x2* rope = WSP(f32x2, WS_ROPE);
    for (int it = gw; it < 512; it += NGW) {
        const int side = it >> 8, rb = it & 255, r0 = rb * 16;
        const bf16_t* H = WSP(bf16_t, side ? WS_HV : WS_HK) + (size_t)(r0 + fr) * 256 + kg * 8;
        const bf16_t* W = WSP(bf16_t, side ? WS_CW2V : WS_CW2K) + (size_t)fr * 256 + kg * 8;
        f32x4 acc[4];
#pragma unroll
        for (int nb = 0; nb < 4; ++nb) acc[nb] = (f32x4){0.f, 0.f, 0.f, 0.f};
#pragma unroll
        for (int s = 0; s < 8; ++s) { const bf16x8 a = *(const bf16x8*)(H + s * 32);
#pragma unroll
            for (int nb = 0; nb < 4; ++nb) { const bf16x8 b = *(const bf16x8*)(W + (size_t)nb * 16 * 256 + s * 32); acc[nb] = __builtin_amdgcn_mfma_f32_16x16x32_bf16(a, b, acc[nb], 0, 0, 0); } }
        bf16_t* out = WSP(bf16_t, side ? WS_VCMP : WS_KCMP);
#pragma unroll
        for (int r = 0; r < 4; ++r) { const int row = r0 + 4 * kg + r, c = row & 255;
            if (side == 0) { const int pos = c * 16 + 31;
#pragma unroll
                for (int nb = 0; nb < 2; ++nb) { const int i = nb * 16 + fr; const f32x2 cs = rope[(size_t)(pos & 4095) * 32 + i]; const float x1 = acc[nb][r], x2 = acc[nb + 2][r];
                    out[(size_t)row * 64 + ropepos(i)] = (bf16_t)f2bf(x1 * cs.x - x2 * cs.y); out[(size_t)row * 64 + ropepos(i + 32)] = (bf16_t)f2bf(x2 * cs.x + x1 * cs.y); }
            } else {
#pragma unroll
                for (int nb = 0; nb < 4; ++nb) out[(size_t)row * 64 + nb * 16 + fr] = (bf16_t)f2bf(acc[nb][r]); } }
    }
}

namespace att {
constexpr int KV0 = 0, SLOTB = 16384, IMP = 32768, IMPLD = 65, OST = 32768, WSF = 100352, SEL = 102400, UNI = 102912, IMPL = 103424;
constexpr float THR = 8.f;
__device__ __forceinline__ int crow(int r, int hi) { return (r & 3) + 8 * (r >> 2) + 4 * hi; }
__device__ __forceinline__ s16x4 vtr(const LAS char* p) { return __builtin_bit_cast(s16x4, __builtin_amdgcn_ds_read_tr16_b64_v4i16((LAS s16x4*)p)); }
__device__ __forceinline__ float swap_max(float m) { auto rr = __builtin_amdgcn_permlane32_swap(__float_as_uint(m), __float_as_uint(m), false, false); return fmaxf(__uint_as_float(rr[0]), __uint_as_float(rr[1])); }
__device__ __forceinline__ float swap_sum(float m) { auto rr = __builtin_amdgcn_permlane32_swap(__float_as_uint(m), __float_as_uint(m), false, false); return __uint_as_float(rr[0]) + __uint_as_float(rr[1]); }
__device__ __forceinline__ float swap_other(float m, int hi) { auto rr = __builtin_amdgcn_permlane32_swap(__float_as_uint(m), __float_as_uint(m), false, false); return __uint_as_float(hi ? rr[0] : rr[1]); }
__device__ __forceinline__ float rowmax32(const f32x16& p0, const f32x16& p1) {
    float a = fmaxf(p0[0], p1[0]);
#pragma unroll
    for (int r = 1; r < 16; ++r) a = fmaxf(a, fmaxf(p0[r], p1[r]));
    return swap_max(a);
}
struct TileRegs { u32x4 k, v; };
__device__ __forceinline__ void tile_load(TileRegs& t, const bf16_t* Kg, const bf16_t* Vg, int row0, int wid, int lane) {
    t.k = *(const u32x4*)(Kg + (size_t)(row0 + lane) * 64 + wid * 8);
    t.v = *(const u32x4*)(Vg + (size_t)(row0 + 16 * (wid & 3) + (lane >> 2)) * 64 + (wid >> 2) * 32 + (lane & 3) * 8);
}
__device__ __forceinline__ void tile_store(const TileRegs& t, LAS char* slot, int wid, int lane) {
    *(LAS u32x4*)(slot + wid * 1024 + lane * 16) = t.k;
    *(LAS u32x4*)(slot + 8192 + wid * 1024 + lane * 16) = t.v;
}
__device__ __forceinline__ void qkt(f32x16& p0, f32x16& p1, const LAS char* kslot, const bf16x8 (&qr)[4], int r32, int hi) {
    const LAS char* kb = kslot + hi * 1024 + r32 * 16;
    p0 = (f32x16){}; p1 = (f32x16){};
#pragma unroll
    for (int d0 = 0; d0 < 4; ++d0) { const bf16x8 b0 = *(const LAS bf16x8*)(kb + d0 * 2048), b1 = *(const LAS bf16x8*)(kb + d0 * 2048 + 512);
        p0 = __builtin_amdgcn_mfma_f32_32x32x16_bf16(b0, qr[d0], p0, 0, 0, 0); p1 = __builtin_amdgcn_mfma_f32_32x32x16_bf16(b1, qr[d0], p1, 0, 0, 0); }
}
__device__ __forceinline__ bf16x8 pack8(const f32x16& p, int base) {
    u32x4 w; w.x = cvt_pk_bf16(p[base], p[base + 1]); w.y = cvt_pk_bf16(p[base + 2], p[base + 3]); w.z = cvt_pk_bf16(p[base + 4], p[base + 5]); w.w = cvt_pk_bf16(p[base + 6], p[base + 7]);
    return __builtin_bit_cast(bf16x8, w);
}
__device__ __forceinline__ void pv(f32x16 (&o)[2], const LAS char* vslot, const f32x16& p0, const f32x16& p1, int lane, int hi) {
    const LAS char* vb = vslot + ((lane >> 4) & 1) * 32 + (lane & 3) * 8 + (4 * hi + ((lane & 15) >> 2)) * 64;
    bf16x8 pa[4]; pa[0] = pack8(p0, 0); pa[1] = pack8(p0, 8); pa[2] = pack8(p1, 0); pa[3] = pack8(p1, 8);
#pragma unroll
    for (int dh = 0; dh < 2; ++dh) {
#pragma unroll
        for (int ks = 0; ks < 4; ++ks) { const s16x4 lo = vtr(vb + dh * 4096 + ks * 1024), hh = vtr(vb + dh * 4096 + ks * 1024 + 512);
            const bf16x8 vf = (bf16x8){lo[0], lo[1], lo[2], lo[3], hh[0], hh[1], hh[2], hh[3]};
            o[dh] = __builtin_amdgcn_mfma_f32_32x32x16_bf16(pa[ks], vf, o[dh], 0, 0, 0); } }
}
__device__ __forceinline__ void kmask(f32x16& p0, f32x16& p1, int klo, int khi, int hi) {
#pragma unroll
    for (int r = 0; r < 16; ++r) { const int k0 = crow(r, hi); if (k0 < klo || k0 > khi) p0[r] = -INFINITY; if (k0 + 32 < klo || k0 + 32 > khi) p1[r] = -INFINITY; }
}
__device__ __forceinline__ void acc_scaled(f32x16 (&ofin)[2], const f32x16 (&o)[2], volatile LAS float* wsf, float scale, int r32, int hi) {
    if (hi == 0) wsf[r32] = scale;
    asm volatile("s_waitcnt lgkmcnt(0)" ::: "memory");
#pragma unroll
    for (int r = 0; r < 16; ++r) { const float f = wsf[crow(r, hi)]; ofin[0][r] += o[0][r] * f; ofin[1][r] += o[1][r] * f; }
    asm volatile("s_waitcnt lgkmcnt(0)" ::: "memory");
}
__device__ __forceinline__ void acc_scaled_lds(LAS float* stg, const f32x16 (&o)[2], volatile LAS float* wsf, float scale, int r32, int hi) {
    if (hi == 0) wsf[r32] = scale;
    asm volatile("s_waitcnt lgkmcnt(0)" ::: "memory");
#pragma unroll
    for (int r = 0; r < 16; ++r) { const int orow = crow(r, hi); const float f = wsf[orow]; stg[orow * 64 + r32] += o[0][r] * f; stg[orow * 64 + 32 + r32] += o[1][r] * f; }
    asm volatile("s_waitcnt lgkmcnt(0)" ::: "memory");
}
template <int MODE>
__device__ __forceinline__ void branch(LAS float* stg, const bf16_t* Kg, const bf16_t* Vg, int dj, u64 rest, int tj, u64 selmask, float gate, int qq,
                                       const bf16x8 (&qr)[4], LAS char* lds, int wid, int lane, int r32, int hi) {
    volatile LAS float* wsf = (volatile LAS float*)(lds + WSF) + wid * 64;
    f32x16 o[2]; o[0] = (f32x16){}; o[1] = (f32x16){};
    float m = 0.f, l = 0.f; bool first = true;
    TileRegs tr; tile_load(tr, Kg, Vg, dj * 64, wid, lane); tile_store(tr, lds + KV0, wid, lane);
    __syncthreads();
    int cj = dj, slot = 0;
    for (;;) {
        const bool has_next = rest != 0ull; int nj = 0;
        if (has_next) { nj = __builtin_ctzll(rest); rest &= rest - 1ull; tile_load(tr, Kg, Vg, nj * 64, wid, lane); }
        const LAS char* ks = lds + KV0 + slot * SLOTB;
        f32x16 p0, p1; qkt(p0, p1, ks, qr, r32, hi);
        int klo = 0, khi = 63;
        if (cj == dj) khi = qq;
        else if (MODE == 0) { if (!((selmask >> cj) & 1ull)) khi = -1; }
        else { if (cj == tj) klo = qq + 1; }
        kmask(p0, p1, klo, khi, hi);
        const float rm = rowmax32(p0, p1);
        if (first) { m = rm; first = false; }
        else { const float rel = rm - m;
            if (__any(rel > THR)) { const float dl = fmaxf(rel, 0.f), f = fast_exp2(-dl); m += dl; l *= f;
                if (hi == 0) wsf[r32] = f;
                asm volatile("s_waitcnt lgkmcnt(0)" ::: "memory");
#pragma unroll
                for (int r = 0; r < 16; ++r) { const float ff = wsf[crow(r, hi)]; o[0][r] *= ff; o[1][r] *= ff; }
                asm volatile("s_waitcnt lgkmcnt(0)" ::: "memory"); } }
        float s = 0.f;
#pragma unroll
        for (int r = 0; r < 16; ++r) { p0[r] = fast_exp2(p0[r] - m); p1[r] = fast_exp2(p1[r] - m); s += p0[r] + p1[r]; }
        l += s;
        pv(o, ks + 8192, p0, p1, lane, hi);
        if (has_next) tile_store(tr, lds + KV0 + (slot ^ 1) * SLOTB, wid, lane);
        __syncthreads();
        if (!has_next) break;
        cj = nj; slot ^= 1;
    }
    const float lt = swap_sum(l);
    acc_scaled_lds(stg, o, wsf, gate / lt, r32, hi);
}

__device__ __forceinline__ void unit(Frame& F, int b, int g, int qb) {
    LAS char* lds = (LAS char*)F.lds;
    const int lane = F.lane, wid = F.wave, r32 = lane & 31, hi = lane >> 5;
    const int hl = wid >> 1, h = g * 4 + hl, qq = (wid & 1) * 32 + r32, t = qb * 64 + qq;
    const bf16_t* Qp = WSP(bf16_t, WS_Q) + ((size_t)(b * NH + h) * SEQ + t) * HD;
    const size_t kvoff = (size_t)(b * NG + g) * SEQ * HD;
    bf16x8 qr[4];
#pragma unroll
    for (int d0 = 0; d0 < 4; ++d0) qr[d0] = *(const bf16x8*)(Qp + d0 * 16 + hi * 8);
    const float* gn = WSP(float, WS_GN) + (size_t)(b * SEQ + t) * 64;
    const float g0 = gn[h], g1 = gn[16 + h], g2 = gn[32 + h];
    volatile LAS float* wsf = (volatile LAS float*)(lds + WSF) + wid * 64;
    f32x16 ofin[2]; ofin[0] = (f32x16){}; ofin[1] = (f32x16){};

    {
        const bf16_t* Kc = WSP(bf16_t, WS_KCMP) + (size_t)(b * NG + g) * 256 * HD; const bf16_t* Vc = WSP(bf16_t, WS_VCMP) + (size_t)(b * NG + g) * 256 * HD;
        const int nct = (4 * qb + 2) / 64 + 1;
        const int cmax = (t >= 31) ? ((t - 31) >> 4) : -1;
        TileRegs tr; float m = -INFINITY;
        for (int T = 0; T < nct; ++T) {
            tile_load(tr, Kc, Vc, T * 64, wid, lane); tile_store(tr, lds + KV0 + (T & 1) * SLOTB, wid, lane);
            __syncthreads();
            f32x16 p0, p1; qkt(p0, p1, lds + KV0 + (T & 1) * SLOTB, qr, r32, hi);
            kmask(p0, p1, 0, cmax - T * 64, hi);
            m = fmaxf(m, rowmax32(p0, p1));
        }
        __syncthreads();
        if (m == -INFINITY) m = 0.f;
        f32x16 o[2]; o[0] = (f32x16){}; o[1] = (f32x16){}; float l = 0.f, prev_last = 0.f;
        LAS float* impl = (LAS float*)(lds + IMP) + (size_t)(hl * 64 + qq) * IMPLD;
#pragma unroll 1
        for (int T = 0; T < nct; ++T) {
            tile_load(tr, Kc, Vc, T * 64, wid, lane); tile_store(tr, lds + KV0 + (T & 1) * SLOTB, wid, lane);
            __syncthreads();
            f32x16 p0, p1; qkt(p0, p1, lds + KV0 + (T & 1) * SLOTB, qr, r32, hi);
            kmask(p0, p1, 0, cmax - T * 64, hi);
            float s = 0.f;
#pragma unroll
            for (int r = 0; r < 16; ++r) { p0[r] = fast_exp2(p0[r] - m); p1[r] = fast_exp2(p1[r] - m); s += p0[r] + p1[r]; }
            l += s;
            pv(o, lds + KV0 + (T & 1) * SLOTB + 8192, p0, p1, lane, hi);
#pragma unroll
            for (int hf = 0; hf < 2; ++hf)
#pragma unroll
                for (int a = 0; a < 4; ++a) { const float e0 = hf ? p1[4 * a] : p0[4 * a], e1 = hf ? p1[4 * a + 1] : p0[4 * a + 1], e2 = hf ? p1[4 * a + 2] : p0[4 * a + 2], e3 = hf ? p1[4 * a + 3] : p0[4 * a + 3];
                    const float send = hi ? prev_last : e3;
                    impl[2 * (8 * T + 4 * hf + a) + hi] = ((e0 + e1) + (e2 + e3)) + swap_other(send, hi);
                    prev_last = e3; }
        }
        const float lt = swap_sum(l), inv = lt > 0.f ? 1.f / lt : 0.f;
        if (hi == 0) ((LAS float*)(lds + IMPL))[hl * 64 + qq] = inv;
        acc_scaled(ofin, o, wsf, g0 * inv, r32, hi);
    }
    __syncthreads();
    {
        u64 un = 0ull; const LAS float* impb = (const LAS float*)(lds + IMP);
        for (int i = 0; i < 8; ++i) { const int q = wid * 8 + i;
            const LAS float* il = (const LAS float*)(lds + IMPL);
            float v = ((impb[(0 * 64 + q) * IMPLD + lane] * il[q] + impb[(1 * 64 + q) * IMPLD + lane] * il[64 + q]) + impb[(2 * 64 + q) * IMPLD + lane] * il[128 + q]) + impb[(3 * 64 + q) * IMPLD + lane] * il[192 + q];
            if (lane > qb) v = 0.f;
            unsigned key = (__float_as_uint(v) & ~63u) | (unsigned)(63 - lane);
            if (lane == 0 || lane == qb || lane == qb - 1) key = 0xFFFFFFC0u | (unsigned)(63 - lane); else if (lane > qb) key = (unsigned)(63 - lane);
            int rank = 0;
            for (int s = 0; s < 64; ++s) { const unsigned ks = (unsigned)__builtin_amdgcn_readlane((int)key, s); rank += (ks > key) ? 1 : 0; }
            const u64 mk = __ballot(rank < 16);
            if (lane == 0) *(LAS u64*)(lds + SEL + q * 8) = mk;
            un |= mk; }
        if (lane == 0) *(LAS u64*)(lds + UNI + wid * 8) = un;
    }
    __syncthreads();
    LAS float* stg = (LAS float*)(lds + OST) + wid * 2048;
#pragma unroll
    for (int r = 0; r < 16; ++r) { const int orow = crow(r, hi); stg[orow * 64 + r32] = ofin[0][r]; stg[orow * 64 + 32 + r32] = ofin[1][r]; }
    const u64 selmask = *(const LAS u64*)(lds + SEL + qq * 8);
    u64 uni = 0ull;
#pragma unroll
    for (int i = 0; i < 8; ++i) uni |= *(const LAS u64*)(lds + UNI + i * 8);
    uni = ((u64)(unsigned)__builtin_amdgcn_readfirstlane((int)(uni >> 32)) << 32) | (u64)(unsigned)__builtin_amdgcn_readfirstlane((int)(uni & 0xffffffffull));
    const u64 below = (qb == 0) ? 0ull : ((1ull << qb) - 1ull);
    branch<0>(stg, WSP(bf16_t, WS_KS) + kvoff, WSP(bf16_t, WS_VS) + kvoff, qb, uni & below, -1, selmask, g1, qq, qr, lds, wid, lane, r32, hi);
    { const int lo = qb >= 8 ? qb - 8 : 0; const u64 wrest = below & ~((lo == 0) ? 0ull : ((1ull << lo) - 1ull));
      branch<1>(stg, WSP(bf16_t, WS_KW) + kvoff, WSP(bf16_t, WS_VW) + kvoff, qb, wrest, qb >= 8 ? qb - 8 : -1, 0ull, g2, qq, qr, lds, wid, lane, r32, hi); }
    { asm volatile("s_waitcnt lgkmcnt(0)" ::: "memory");
      bf16_t* Ow = WSP(bf16_t, WS_O) + ((size_t)b * SEQ + qb * 64 + (wid & 1) * 32) * 1024 + h * 64;
#pragma unroll
      for (int i = 0; i < 4; ++i) { const int row = i * 8 + (lane >> 3), ch = lane & 7; const f32x4 v0 = *(const LAS f32x4*)(stg + row * 64 + ch * 8), v1 = *(const LAS f32x4*)(stg + row * 64 + ch * 8 + 4); store8(Ow + (size_t)row * 1024 + ch * 8, v0, v1); } }
    __syncthreads();
}
__device__ __forceinline__ void phase(Frame& F) {
    for (int L = F.vcu; L < 256; L += F.G) { const int bg = L >> 4, s = L & 15;
        for (int i = 0; i < 4; ++i) { const int qb = (i == 0) ? s : (i == 1) ? 31 - s : (i == 2) ? 32 + s : 63 - s; unit(F, bg >> 2, bg & 3, qb); } }
}
}

__device__ __forceinline__ void p7_router(Frame& F, unsigned* ctl) {
    constexpr int RLD = 2052;
    LAS float* rows = (LAS float*)F.lds;
    LAS float* red = (LAS float*)F.lds;
    LAS float* st = (LAS float*)(F.lds + TAB_OFF);
    const int tid = F.tid, lane = F.lane, wid = F.wave;
    const float* V1 = F.out; const float* g1 = F.in[13]; const float* b1 = F.in[14];
    bf16_t* H1B = WSP(bf16_t, WS_H1B); float* stats = WSP(float, WS_STATS);
    const bf16_t* WRH = WSP(bf16_t, WS_WRH); const bf16_t* WRL = WSP(bf16_t, WS_WRL);
    const f32x4 gv = *(const f32x4*)(g1 + tid * 4), bv = *(const f32x4*)(b1 + tid * 4);
    for (int ub = F.vcu; ub < NT / 16; ub += F.G) {
        const int m0 = ub * 16;
        f32x4 v[16];
#pragma unroll
        for (int i = 0; i < 16; ++i) v[i] = *(const f32x4*)(V1 + (size_t)(m0 + i) * DM + tid * 4);
#pragma unroll
        for (int i = 0; i < 16; ++i) *(LAS f32x4*)(rows + i * RLD + tid * 4) = v[i];
        __syncthreads();
#pragma unroll
        for (int rr = 0; rr < 2; ++rr) { const int r = wid * 2 + rr; float s = 0.f;
#pragma unroll
            for (int j = 0; j < 8; ++j) { const f32x4 x = *(const LAS f32x4*)(rows + r * RLD + j * 256 + lane * 4); s += (x[0] + x[1]) + (x[2] + x[3]); }
            const float mean = wave_sum(s) * (1.f / DM); float q = 0.f;
#pragma unroll
            for (int j = 0; j < 8; ++j) { const f32x4 x = *(const LAS f32x4*)(rows + r * RLD + j * 256 + lane * 4) - mean; q += (x[0] * x[0] + x[1] * x[1]) + (x[2] * x[2] + x[3] * x[3]); }
            const float rstd = 1.f / sqrtf(wave_sum(q) * (1.f / DM) + LN_EPS);
            if (lane == 0) { st[r * 2] = mean; st[r * 2 + 1] = rstd; stats[(size_t)(m0 + r) * 2] = mean; stats[(size_t)(m0 + r) * 2 + 1] = rstd; } }
        __syncthreads();
#pragma unroll
        for (int i = 0; i < 16; ++i) { const float mean = st[i * 2], rstd = st[i * 2 + 1]; const f32x4 hrow = (v[i] - mean) * rstd * gv + bv;
            *(LAS f32x4*)(rows + i * RLD + tid * 4) = hrow; u32x2 o; o.x = pk2(hrow[0], hrow[1]); o.y = pk2(hrow[2], hrow[3]); *(u32x2*)(H1B + (size_t)(m0 + i) * DM + tid * 4) = o; }
        __syncthreads();
        f32x4 acc[5];
#pragma unroll
        for (int nb = 0; nb < 5; ++nb) acc[nb] = (f32x4){0.f, 0.f, 0.f, 0.f};
        { const int fr = lane & 15, kg = lane >> 4;
#pragma unroll 1
          for (int s = 0; s < 8; ++s) { const int k0 = wid * 256 + s * 32 + kg * 8;
              const f32x4 a0 = *(const LAS f32x4*)(rows + fr * RLD + k0), a1 = *(const LAS f32x4*)(rows + fr * RLD + k0 + 4);
              u32x4 ah, al;
#pragma unroll
              for (int j = 0; j < 4; ++j) { const float x0 = j < 2 ? a0[2 * j] : a1[2 * j - 4], x1 = j < 2 ? a0[2 * j + 1] : a1[2 * j - 3];
                  const unsigned h0 = f2bf(x0), h1 = f2bf(x1); ah[j] = h0 | (h1 << 16); al[j] = pk2(x0 - __builtin_bit_cast(float, h0 << 16), x1 - __builtin_bit_cast(float, h1 << 16)); }
              const bf16x8 Ah = __builtin_bit_cast(bf16x8, ah), Al = __builtin_bit_cast(bf16x8, al);
#pragma unroll
              for (int nb = 0; nb < 5; ++nb) { const bf16x8 Bh = *(const bf16x8*)(WRH + (size_t)(nb * 16 + fr) * DM + k0), Bl = *(const bf16x8*)(WRL + (size_t)(nb * 16 + fr) * DM + k0);
                  acc[nb] = __builtin_amdgcn_mfma_f32_16x16x32_bf16(Ah, Bh, acc[nb], 0, 0, 0); acc[nb] = __builtin_amdgcn_mfma_f32_16x16x32_bf16(Al, Bh, acc[nb], 0, 0, 0); acc[nb] = __builtin_amdgcn_mfma_f32_16x16x32_bf16(Ah, Bl, acc[nb], 0, 0, 0); } } }
        __syncthreads();
        { const int fr = lane & 15, kg = lane >> 4;
#pragma unroll
          for (int nb = 0; nb < 5; ++nb)
#pragma unroll
              for (int r = 0; r < 4; ++r) red[(wid * 16 + 4 * kg + r) * 80 + nb * 16 + fr] = acc[nb][r]; }
        __syncthreads();
        if (tid < 16) { const int m = m0 + tid;
            const float* gb = F.in[16]; const float* eb = F.in[18];
            float gl[8]; int grp = 0; float gmax = -INFINITY;
#pragma unroll
            for (int i = 0; i < 8; ++i) { float s = 0.f;
#pragma unroll
                for (int w = 0; w < 8; ++w) s += red[(w * 16 + tid) * 80 + i];
                gl[i] = s + gb[i]; if (gl[i] > gmax) { gmax = gl[i]; grp = i; } }
            float gs = 0.f;
#pragma unroll
            for (int i = 0; i < 8; ++i) gs += __expf(gl[i] - gmax);
            const float ggate = 1.f / gs;
            float el[8];
#pragma unroll
            for (int i = 0; i < 8; ++i) { float s = 0.f;
#pragma unroll
                for (int w = 0; w < 8; ++w) s += red[(w * 16 + tid) * 80 + 8 + grp * 8 + i];
                el[i] = s + eb[grp * 8 + i]; }
            int i0 = 0; float v0 = -INFINITY;
#pragma unroll
            for (int i = 0; i < 8; ++i) if (el[i] > v0) { v0 = el[i]; i0 = i; }
            int i1 = 0; float v1 = -INFINITY;
#pragma unroll
            for (int i = 0; i < 8; ++i) if (i != i0 && el[i] > v1) { v1 = el[i]; i1 = i; }
            const float e1 = __expf(v1 - v0), w0 = ggate / (1.f + e1), w1 = ggate * e1 / (1.f + e1);
            const int ea = grp * 8 + i0, ebx = grp * 8 + i1;
            const unsigned pa = __hip_atomic_fetch_add(ctl + CW_CNT + 16 * ea, 1u, RLX_AGENT), pb = __hip_atomic_fetch_add(ctl + CW_CNT + 16 * ebx, 1u, RLX_AGENT);
            int* rte = WSP(int, WS_RTE); float* rtw = WSP(float, WS_RTW); int* rtp = WSP(int, WS_RTP);
            rte[m * 2] = ea; rte[m * 2 + 1] = ebx; rtw[m * 2] = w0; rtw[m * 2 + 1] = w1; rtp[m * 2] = (int)pa; rtp[m * 2 + 1] = (int)pb; }
        __syncthreads();
    }
}
__device__ __forceinline__ int expert_tables(Frame& F, unsigned* ctl) {
    LAS int* off = (LAS int*)(F.lds + TAB_OFF + 256); LAS int* texp = off + 68; LAS int* ntl = texp + 200;
    __syncthreads();
    if (F.tid < 64) { const int e = F.tid; const int c = (int)__hip_atomic_load(ctl + CW_CNT + 16 * e, RLX_AGENT); const int nt = (c + 255) >> 8;
        int pre = nt;
#pragma unroll
        for (int o = 1; o < 64; o <<= 1) { const int x = __shfl_up(pre, o); if (e >= o) pre += x; }
        const int base = pre - nt; off[e] = base * 256;
        for (int i = 0; i < nt; ++i) texp[base + i] = e;
        if (e == 63) ntl[0] = pre; }
    __syncthreads();
    return ntl[0];
}
__device__ __forceinline__ void p8_gather(Frame& F, unsigned* ctl) {
    (void)expert_tables(F, ctl);
    const LAS int* off = (const LAS int*)(F.lds + TAB_OFF + 256);
    const int gw = F.vcu * 8 + F.wave, NGW = F.G * 8, lane = F.lane;
    const int* rte = WSP(int, WS_RTE); const float* rtw = WSP(float, WS_RTW); const int* rtp = WSP(int, WS_RTP);
    int* rowmap = WSP(int, WS_ROWMAP); float* roww = WSP(float, WS_ROWW);
    const bf16_t* H1B = WSP(bf16_t, WS_H1B); bf16_t* XB = WSP(bf16_t, WS_XBUF);
    for (int s = gw; s < NT * 2; s += NGW) { const int e = rte[s], dest = off[e] + rtp[s]; const int m = s >> 1;
        const u32x4* src = (const u32x4*)(H1B + (size_t)m * DM); u32x4* dst = (u32x4*)(XB + (size_t)dest * DM);
        u32x4 r[4];
#pragma unroll
        for (int j = 0; j < 4; ++j) r[j] = src[j * 64 + lane];
#pragma unroll
        for (int j = 0; j < 4; ++j) dst[j * 64 + lane] = r[j];
        if (lane == 0) { rowmap[dest] = s; roww[dest] = rtw[s]; } }
    for (int e = gw; e < NE; e += NGW) { const int c = (int)__hip_atomic_load(ctl + CW_CNT + 16 * e, RLX_AGENT); const int pend = ((c + 255) >> 8) << 8;
        for (int i = c + lane; i < pend; i += 64) { rowmap[off[e] + i] = -1; roww[off[e] + i] = 0.f; } }
}
__device__ __forceinline__ void p11_final(Frame& F) {
    const int gw = F.vcu * 8 + F.wave, NGW = F.G * 8, lane = F.lane;
    const float* g1 = F.in[13]; const float* b1 = F.in[14]; const float* g2 = F.in[22]; const float* b2 = F.in[23];
    const float* stats = WSP(float, WS_STATS); const bf16_t* YB = WSP(bf16_t, WS_YB); float* out = F.out;
    for (int m = gw; m < NT; m += NGW) {
        const float mean = stats[(size_t)m * 2], rstd = stats[(size_t)m * 2 + 1];
        const float* vr = out + (size_t)m * DM; const bf16_t* y0 = YB + (size_t)(2 * m) * DM; const bf16_t* y1 = y0 + DM;
        f32x4 v[8]; float s = 0.f;
#pragma unroll
        for (int j = 0; j < 4; ++j) { const int c = j * 512 + lane * 8; f32x4 a0, a1, c0, c1; load8(y0 + c, a0, a1); load8(y1 + c, c0, c1);
            const f32x4 x0 = *(const f32x4*)(vr + c), x1 = *(const f32x4*)(vr + c + 4);
            const f32x4 h0 = (x0 - mean) * rstd * *(const f32x4*)(g1 + c) + *(const f32x4*)(b1 + c), h1 = (x1 - mean) * rstd * *(const f32x4*)(g1 + c + 4) + *(const f32x4*)(b1 + c + 4);
            v[2 * j] = h0 * DN_ALPHA + (a0 + c0); v[2 * j + 1] = h1 * DN_ALPHA + (a1 + c1);
            s += ((v[2 * j][0] + v[2 * j][1]) + (v[2 * j][2] + v[2 * j][3])) + ((v[2 * j + 1][0] + v[2 * j + 1][1]) + (v[2 * j + 1][2] + v[2 * j + 1][3])); }
        const float mu = wave_sum(s) * (1.f / DM); float q = 0.f;
#pragma unroll
        for (int j = 0; j < 8; ++j) { v[j] = v[j] - mu; q += (v[j][0] * v[j][0] + v[j][1] * v[j][1]) + (v[j][2] * v[j][2] + v[j][3] * v[j][3]); }
        const float rs = 1.f / sqrtf(wave_sum(q) * (1.f / DM) + LN_EPS);
#pragma unroll
        for (int j = 0; j < 4; ++j) { const int c = j * 512 + lane * 8;
            *(f32x4*)(out + (size_t)m * DM + c) = v[2 * j] * rs * *(const f32x4*)(g2 + c) + *(const f32x4*)(b2 + c);
            *(f32x4*)(out + (size_t)m * DM + c + 4) = v[2 * j + 1] * rs * *(const f32x4*)(g2 + c + 4) + *(const f32x4*)(b2 + c + 4); }
    }
}

__global__ void __launch_bounds__(512, 2) mk_fwd(Args args) {
    extern __shared__ __attribute__((aligned(16))) unsigned char lds_raw[];
    Frame F;
    F.lds = (LAS unsigned char*)lds_raw; F.ws = args.ws; F.in = args.in; F.out = args.out;
    F.tid = threadIdx.x; F.lane = F.tid & 63; F.wave = __builtin_amdgcn_readfirstlane(F.tid >> 6);
    F.G = gridDim.x; { const int bx = blockIdx.x; F.vcu = (F.G % 8 == 0) ? (bx % 8) * (F.G / 8) + bx / 8 : bx; }
    unsigned* ctl = (unsigned*)(args.ws + WS_CTL);
    volatile LAS unsigned* MISC = (volatile LAS unsigned*)(F.lds + MISC_OFF);
    if (F.tid < 32) MISC[F.tid] = 0u;
    __syncthreads();
    const int lo = args.ph_lo, hi = args.ph_hi;
    const bool multi = (hi - lo) > 1;
    __builtin_amdgcn_fence(__ATOMIC_ACQUIRE, "agent"); asm volatile("s_waitcnt vmcnt(0)" ::: "memory"); __syncthreads();
    XcdBarrier bar; bar.bar = ctl + CW_BAR; bar.x = 0; bar.st = MISC + 8;
    if (multi) bar = xcd_barrier_post(ctl + CW_BAR, MISC + 8);
    bool first_sync = true;
#ifndef PHASE_MASK
#define PHASE_MASK 0xFFF
#endif
#define IN(k) (((PHASE_MASK >> (k)) & 1) && lo <= (k) && (k) < hi)
#define SEAM(k) do { if (IN(k) && IN((k) + 1)) { if (first_sync) { first_sync = false; __threadfence(); cg::this_grid().sync(); } else xcd_barrier(bar); } } while (0)
    LAS unsigned char* ring = F.lds;

    if (IN(0)) { p0_prologue(F); SEAM(0); }
    if (IN(1)) {
        pg8::Gemm g{DM, DM * 2, DM * 2}; RectSched S; S.init(NT, IN_PAD, F.G, (int)blockIdx.x, WSP(bf16_t, WS_XB), DM * 2, WSP(bf16_t, WS_WIN), DM * 2);
        EpiInProj E; E.U = WSP(bf16_t, WS_U); E.Q = WSP(bf16_t, WS_Q); E.KVb = WSP(bf16_t, WS_KC);
        E.GM = WSP(bf16_t, WS_GM); E.GN = WSP(float, WS_GN); E.rope = WSP(const f32x4, WS_ROPE);
        pg8::gemm_phase<EpiInProj, RectSched, true>(ring, g, S, E);
        SEAM(1);
    }
    if (IN(2)) {
        p2_pool(F);
        __syncthreads();
        pg8::Gemm g{2048, 2048, 4096}; CmpSched S; S.vcu = F.vcu; S.A0 = (const char*)WSP(bf16_t, WS_KC); S.A1 = (const char*)WSP(bf16_t, WS_VC); S.B0 = (const char*)WSP(bf16_t, WS_CW1K); S.B1 = (const char*)WSP(bf16_t, WS_CW1V);
        EpiCmp1 E; E.H0 = WSP(bf16_t, WS_HK); E.H1 = WSP(bf16_t, WS_HV); E.bias = WSP(float, WS_CBIAS);
        pg8::gemm_phase<EpiCmp1, CmpSched, false>(ring, g, S, E);
        SEAM(2);
    }
    if (IN(3)) {
        pg8::Gemm g{256, 2048, 512}; MixSched S; S.vcu = F.vcu; S.G = F.G; S.A = (const char*)WSP(bf16_t, WS_POOLED); S.B = (const char*)WSP(bf16_t, WS_PM);
        EpiMix E; E.out = WSP(bf16_t, WS_MIXED); E.scale = F.in[3];
#ifndef NO_G4
        pg8::gemm_phase<EpiMix, MixSched, true>(ring, g, S, E);
#endif
#ifndef NO_ATT
        p3_cmp2(F);
#endif
        SEAM(3);
    }
    if (IN(4)) {
        pg8::Gemm g{1024, 2048, 2048}; RectSched S; S.init(NT, DM, F.G, (int)blockIdx.x, WSP(bf16_t, WS_MIXED), 2048, WSP(bf16_t, WS_WPP), 2048);
        EpiZP E; E.ZP = WSP(bf16_t, WS_ZP); E.GM = WSP(bf16_t, WS_GM);
#ifndef NO_G4
        pg8::gemm_phase<EpiZP, RectSched, true>(ring, g, S, E);
#endif
        __syncthreads();
#ifndef NO_ATT
        att::phase(F);
#endif
        SEAM(4);
    }
    if (IN(5)) {
        pg8::Gemm g{1024, 2048, 2048}; RectSched S; S.init(NT, DM, F.G, (int)blockIdx.x, WSP(bf16_t, WS_O), 2048, WSP(bf16_t, WS_WNP), 2048);
        EpiZ E; E.Z = WSP(bf16_t, WS_Z); E.ZP = WSP(bf16_t, WS_ZP); E.GM = WSP(bf16_t, WS_GM);
        pg8::gemm_phase<EpiZ, RectSched, true>(ring, g, S, E);
        SEAM(5);
    }
    if (IN(6)) {
        pg8::Gemm g{DM, DM * 2, DM * 2}; RectSched S; S.init(NT, DM, F.G, (int)blockIdx.x, WSP(bf16_t, WS_Z), DM * 2, WSP(bf16_t, WS_WO), DM * 2);
        EpiV1 E; E.V1 = F.out; E.x = F.in[0];
        pg8::gemm_phase<EpiV1, RectSched, true>(ring, g, S, E);
        SEAM(6);
    }
    if (IN(7)) { p7_router(F, ctl); SEAM(7); }
    if (IN(8)) { p8_gather(F, ctl); SEAM(8); }
    if (IN(9)) {
        const int ntile = expert_tables(F, ctl);
        pg8::Gemm g{DM, DM * 2, DM * 2}; MoeSched<4, 1024> S; S.vcu = F.vcu; S.G = F.G; S.ntile = ntile; S.A = (const char*)WSP(bf16_t, WS_XBUF); S.B = (const char*)WSP(bf16_t, WS_WGU); S.lda = DM * 2; S.ldb = DM * 2; S.texp = (const LAS int*)(F.lds + TAB_OFF + 256) + 68;
        EpiUp E; E.HID = WSP(bf16_t, WS_HID);
        pg8::gemm_phase<EpiUp, MoeSched<4, 1024>, true>(ring, g, S, E);
        SEAM(9);
    }
    if (IN(10)) {
        const int ntile = expert_tables(F, ctl);
        pg8::Gemm g{EH, EH * 2, EH * 2}; MoeSched<8, 2048> S; S.vcu = F.vcu; S.G = F.G; S.ntile = ntile; S.A = (const char*)WSP(bf16_t, WS_HID); S.B = (const char*)WSP(bf16_t, WS_WD); S.lda = EH * 2; S.ldb = EH * 2; S.texp = (const LAS int*)(F.lds + TAB_OFF + 256) + 68;
        EpiDown E; E.YB = WSP(bf16_t, WS_YB); E.rowmap = WSP(int, WS_ROWMAP); E.roww = WSP(float, WS_ROWW);
        pg8::gemm_phase<EpiDown, MoeSched<8, 2048>, true>(ring, g, S, E);
        SEAM(10);
    }
    if (IN(11)) { p11_final(F); }
    asm volatile("s_waitcnt vmcnt(0)" ::: "memory"); __syncthreads(); __builtin_amdgcn_fence(__ATOMIC_RELEASE, "agent"); asm volatile("s_waitcnt vmcnt(0)" ::: "memory");
#undef IN
#undef SEAM
}


#ifdef DBG_DUMP
__global__ void __launch_bounds__(512) dbg_dump(const unsigned char* ws, float* out) {
    const bf16_t* src = (const bf16_t*)(ws + (size_t)DBG_OFF);
    for (size_t i = (size_t)blockIdx.x * 512 + threadIdx.x; i < (size_t)NT * DM; i += (size_t)gridDim.x * 512) { const size_t m = i / DM, c = i % DM; out[i] = bf2f(src[(m % DBG_ROWS) * DBG_LD + (c % DBG_COLS)]); }
}
#endif

#ifdef DBG_CHECK
__global__ void __launch_bounds__(256) dbg_check(const float* x, const float* w_in, const unsigned char* ws, unsigned* errbits) {
    const int s = blockIdx.x * 256 + threadIdx.x;
    unsigned h = (unsigned)s * 2654435761u; h ^= h >> 15; h *= 2246822519u; h ^= h >> 13;
    const int m = h % NT; const int c = (h >> 14) % 4096;
    float acc = 0.f, accu = 0.f; const int cu = c % 1024;
    for (int k = 0; k < DM; ++k) { const float xv = x[(size_t)m * DM + k]; acc += xv * w_in[(size_t)k * IN_COLS + 3632 + c]; accu += xv * w_in[(size_t)k * IN_COLS + cu]; }
    const float ref = 1.f / (1.f + __expf(-acc));
    const float got = bf2f(((const bf16_t*)(ws + WS_GM))[(size_t)m * 4096 + c]);
    const float gotu = bf2f(((const bf16_t*)(ws + WS_U))[(size_t)m * PW + cu]);
    const float e = fabsf(got - ref), eu = fabsf(gotu - accu);
#if DBG_CHECK == 1
    if (!(eu < 0.06f)) atomicAdd(errbits, 1u);
#elif DBG_CHECK == 3
    { const int n = 3632 + c, k = (h >> 3) % DM; const float wv = w_in[(size_t)k * IN_COLS + n]; const float gw_ = bf2f(((const bf16_t*)(ws + WS_WIN))[(size_t)in_map(n) * DM + k]);
      if (!(fabsf(gw_ - wv) <= 0.01f * fabsf(wv) + 1e-6f)) atomicAdd(errbits, 1u); }
#else
    if (!(e < 0.02f)) atomicAdd(errbits, 1u);
#endif
}
__global__ void __launch_bounds__(512) dbg_fill(float* out, const unsigned* errbits) {
    const float v = 1.f + (float)(*errbits);
    for (size_t i = (size_t)blockIdx.x * 512 + threadIdx.x; i < (size_t)NT * DM; i += (size_t)gridDim.x * 512) out[i] = v;
}
#endif
extern "C" void kernel_launch(void* const* d_in, const int* in_sizes, int n_in, void* d_out, int out_size, void* d_ws, size_t ws_size, hipStream_t stream) {
    static int grid = 0;
    if (grid == 0) {
        if (n_in != 24 || out_size != NT * DM || ws_size < WS_END) { fprintf(stderr, "kernel_launch: unexpected problem (n_in %d, out %d, ws %zu < %zu)\n", n_in, out_size, ws_size, (size_t)WS_END); grid = -1; return; }
        int dev = 0, cus = 0, per_cu = 0;
        hipGetDevice(&dev); hipDeviceGetAttribute(&cus, hipDeviceAttributeMultiprocessorCount, dev);
        if (hipFuncSetAttribute((const void*)mk_fwd, hipFuncAttributeMaxDynamicSharedMemorySize, LDS_BYTES) != hipSuccess) { fprintf(stderr, "kernel_launch: hipFuncSetAttribute failed\n"); grid = -1; return; }
        if (hipOccupancyMaxActiveBlocksPerMultiprocessor(&per_cu, (const void*)mk_fwd, 512, LDS_BYTES) != hipSuccess || per_cu < 1) { fprintf(stderr, "kernel_launch: occupancy query says %d blocks per CU\n", per_cu); grid = -1; (void)hipGetLastError(); return; }
        grid = cus;
    }
    if (grid < 0) return;
    hipMemsetAsync((char*)d_ws + WS_CTL, 0, CTL_ZERO_BYTES, stream);
    Args a{};
    for (int i = 0; i < 24; ++i) a.in[i] = (const float*)d_in[i];
    a.out = (float*)d_out; a.ws = (unsigned char*)d_ws;
#if MK_PER_PHASE_LAUNCH
    for (int p = 0; p < DBG_NPH; ++p) { a.ph_lo = p; a.ph_hi = p + 1; hipLaunchKernelGGL(mk_fwd, dim3(grid), dim3(512), LDS_BYTES, stream, a); }
#ifdef DBG_CHECK
    hipMemsetAsync((char*)d_ws + 65536, 0, 4, stream);
    hipLaunchKernelGGL(dbg_check, dim3(16), dim3(256), 0, stream, (const float*)d_in[0], (const float*)d_in[1], (const unsigned char*)d_ws, (unsigned*)((char*)d_ws + 65536));
    hipLaunchKernelGGL(dbg_fill, dim3(1024), dim3(512), 0, stream, (float*)d_out, (const unsigned*)((char*)d_ws + 65536));
#endif
#ifdef DBG_DUMP
    hipLaunchKernelGGL(dbg_dump, dim3(1024), dim3(512), 0, stream, (const unsigned char*)d_ws, (float*)d_out);
#endif
#else
    a.ph_lo = 0; a.ph_hi = NPHASE;
    void* kargs[] = {&a};
    hipError_t e = hipLaunchCooperativeKernel((const void*)mk_fwd, dim3(grid), dim3(512), kargs, LDS_BYTES, stream);
    if (e != hipSuccess) fprintf(stderr, "kernel_launch: cooperative launch failed: %s (grid %d)\n", hipGetErrorString(e), grid);
#endif
}
```

```cpp
#include <hip/hip_runtime.h>
#include <hip/hip_cooperative_groups.h>
#include <cstdio>
#include <cstdint>
namespace cg = cooperative_groups;

#ifndef MK_PER_PHASE_LAUNCH
#define MK_PER_PHASE_LAUNCH 0
#endif

#define GAS __attribute__((address_space(1)))
#define LAS __attribute__((address_space(3)))
typedef unsigned short bf16_t;
typedef short bf16x8 __attribute__((ext_vector_type(8)));
typedef short s16x4 __attribute__((ext_vector_type(4)));
typedef float f32x2 __attribute__((ext_vector_type(2)));
typedef float f32x4 __attribute__((ext_vector_type(4)));
typedef float f32x16 __attribute__((ext_vector_type(16)));
typedef unsigned u32x2 __attribute__((ext_vector_type(2)));
typedef unsigned u32x4 __attribute__((ext_vector_type(4)));
typedef unsigned long long u64;

constexpr int NB = 4, SEQ = 4096, DM = 2048, NT = NB * SEQ;
constexpr int NH = 16, HD = 64, NG = 4;
constexpr int PW = 1024;
constexpr int IN_COLS = 7728, IN_PAD = 7936;
constexpr int NE = 64, EH = 512;
constexpr int MPAD = 49152;
constexpr float DN_ALPHA = 1.18920711500272f;
constexpr float LN_EPS = 1e-5f;
constexpr float C2 = 0.125f * 1.4426950408889634f;
constexpr int NPHASE = 12;
#ifndef DBG_NPH
#define DBG_NPH NPHASE
#endif
#define DBG_OFF (504ull << 20)
#define DBG_LD 4096
#define DBG_COLS 2048
#define DBG_ROWS 16384

constexpr size_t MiB = 1u << 20;
constexpr size_t WS_CTL = 0, CTL_ZERO_BYTES = 96 * 1024;
constexpr size_t WS_WGU = 1 * MiB, WS_WD = 257 * MiB, WS_WIN = 385 * MiB, WS_WPP = 416 * MiB, WS_WNP = 420 * MiB, WS_WO = 424 * MiB, WS_PM = 432 * MiB;
constexpr size_t WS_CW1K = 433 * MiB, WS_CW1V = 434 * MiB, WS_CW2K = 435 * MiB, WS_CW2V = 435 * MiB + 65536, WS_WRH = 436 * MiB, WS_WRL = 436 * MiB + 512 * 1024;
constexpr size_t WS_ROPE = 437 * MiB, WS_CBIAS = 438 * MiB;
constexpr size_t WS_XB = 440 * MiB, WS_POOLED = 868 * MiB  , WS_MIXED = 472 * MiB, WS_H1B = 440 * MiB;
constexpr size_t WS_GM = 504 * MiB, WS_U = 632 * MiB, WS_Q = 664 * MiB;
constexpr size_t WS_KC = 696 * MiB, WS_VC = 705 * MiB, WS_KS = 714 * MiB, WS_VS = 722 * MiB, WS_KW = 730 * MiB, WS_VW = 738 * MiB;
constexpr size_t WS_GN = 746 * MiB, WS_KCMP = 750 * MiB, WS_VCMP = 750 * MiB + 512 * 1024, WS_HK = 751 * MiB, WS_HV = 753 * MiB, WS_CMPP = 852 * MiB, WS_V1B = 632 * MiB, WS_PS = 917 * MiB;
constexpr size_t WS_AO = 756 * MiB;
constexpr size_t WS_ZP = 756 * MiB, WS_O = 820 * MiB, WS_Z = 852 * MiB;
constexpr size_t WS_STATS = 916 * MiB, WS_RTE = 917 * MiB, WS_RTW = 917 * MiB + 256 * 1024, WS_RTP = 917 * MiB + 512 * 1024, WS_ROWMAP = 919 * MiB, WS_ROWW = 920 * MiB;
constexpr size_t WS_XBUF = 504 * MiB, WS_HID = 696 * MiB, WS_YB = 756 * MiB;
constexpr size_t WS_ELIST = 921 * MiB, WS_EWT = 925 * MiB;
constexpr size_t WS_END = 929 * MiB;
constexpr int CW_BAR = 4096, CW_CNT = 8192, CW_GRP = 12288, CW_ATQ = 12288 + 256, CW_GX = 16384;

constexpr int RING_BYTES = 131072;
constexpr int MISC_OFF = 132096;
constexpr int TAB_OFF = MISC_OFF + 256;
constexpr int LDS_BYTES = 163840;

#define RLX_AGENT __ATOMIC_RELAXED, __HIP_MEMORY_SCOPE_AGENT
__device__ __forceinline__ unsigned f2bf(float f) { unsigned u = __builtin_bit_cast(unsigned, f); return (u + 0x7fffu + ((u >> 16) & 1u)) >> 16; }
__device__ __forceinline__ unsigned pk2(float lo, float hi) { return f2bf(lo) | (f2bf(hi) << 16); }
__device__ __forceinline__ float bf2f(unsigned short b) { return __builtin_bit_cast(float, (unsigned)b << 16); }
__device__ __forceinline__ float bflo(unsigned w) { return __builtin_bit_cast(float, w << 16); }
__device__ __forceinline__ float bfhi(unsigned w) { return __builtin_bit_cast(float, w & 0xffff0000u); }
typedef __bf16 bf16x2_t __attribute__((ext_vector_type(2)));
__device__ __forceinline__ unsigned cvt_pk_bf16(float lo, float hi) { const f32x2 v = {lo, hi}; const bf16x2_t b = __builtin_convertvector(v, bf16x2_t); return __builtin_bit_cast(unsigned, b); }
__device__ __forceinline__ void store8(bf16_t* p, f32x4 a, f32x4 b) { u32x4 w; w.x = cvt_pk_bf16(a[0], a[1]); w.y = cvt_pk_bf16(a[2], a[3]); w.z = cvt_pk_bf16(b[0], b[1]); w.w = cvt_pk_bf16(b[2], b[3]); *(u32x4*)p = w; }
__device__ __forceinline__ void load8(const bf16_t* p, f32x4& a, f32x4& b) { const u32x4 w = *(const u32x4*)p; a = (f32x4){bflo(w.x), bfhi(w.x), bflo(w.y), bfhi(w.y)}; b = (f32x4){bflo(w.z), bfhi(w.z), bflo(w.w), bfhi(w.w)}; }
__device__ __forceinline__ float fast_exp2(float x) { return __builtin_amdgcn_exp2f(x); }
__device__ __forceinline__ float sigmoidf_(float x) { return __builtin_amdgcn_rcpf(1.f + fast_exp2(-1.4426950408889634f * x)); }
__device__ __forceinline__ f32x4 sigmoid4(f32x4 v) { return (f32x4){sigmoidf_(v[0]), sigmoidf_(v[1]), sigmoidf_(v[2]), sigmoidf_(v[3])}; }
__device__ __forceinline__ float gelu_tanh(float x) { const float y = 0.7978845608028654f * (x + 0.044715f * x * x * x); const float e = fast_exp2(2.f * 1.4426950408889634f * y); const float th = 1.f - 2.f * __builtin_amdgcn_rcpf(e + 1.f); return 0.5f * x * (1.f + th); }
__device__ __forceinline__ float wave_sum(float v) {
#pragma unroll
    for (int o = 1; o < 64; o <<= 1) v += __shfl_xor(v, o);
    return v;
}

namespace pg8 {
constexpr int BM = 256, BK = 64, HALF = 128, HTB = HALF * BK * 2, STAGE_BYTES = 8 * HTB;
__host__ __device__ __forceinline__ int lds_byte(int r, int c) { const int st = (r >> 4) * 2 + (c >> 5), rr = r & 15, cc = c & 31, ob = rr * 64 + cc * 2; return st * 1024 + (ob ^ (((ob >> 9) & 1) << 5)); }
__host__ __device__ __forceinline__ void stage_rc(int b, int& R, int& C) { const int st = b / 1024, sb = b % 1024, swz = sb ^ (((sb >> 9) & 1) << 5); R = (st >> 1) * 16 + swz / 64; C = (st & 1) * 32 + (swz % 64) / 2; }
__host__ __device__ __forceinline__ int perm32(int rho) { const int n = rho >> 4, i = rho & 15; return 8 * (i >> 2) + 4 * n + (i & 3); }

struct Unit { int pm, pn; const char* a; const char* b; };
struct Gemm { int K; unsigned lda, ldb; };

template <class Epi, class Sched, bool ALIGN_EPI, bool GATHER = false>
__device__ __forceinline__ void gemm_phase(LAS unsigned char* lds, const Gemm g, const Sched& S, const Epi& E) {
    const int tid = threadIdx.x, wid = __builtin_amdgcn_readfirstlane(tid >> 6), lane = tid & 63, wr = wid >> 2, wc = wid & 3, fr = lane & 15, fq = lane >> 4;
    const int K = g.K, nt = K / BK;
    unsigned voffA[2], voffB[2];
#pragma unroll
    for (int i = 0; i < 2; ++i) { int R, C; stage_rc(tid * 16 + i * 8192, R, C); const int Rb = Epi::PERM ? ((R & ~31) + perm32(R & 31)) : R;
        voffA[i] = (unsigned)R * g.lda + (unsigned)C * 2u; voffB[i] = (unsigned)Rb * g.ldb + (unsigned)C * 2u; }
    int rowA[2];
#pragma unroll
    for (int i = 0; i < 2; ++i) { int R, C; stage_rc(tid * 16 + i * 8192, R, C); rowA[i] = R; }
    unsigned vA[2][2], nvA[2][2];
    const size_t kstep = (size_t)(BK * 2);
    const size_t hstepA = (size_t)HALF * g.lda, hstepB = (size_t)HALF * g.ldb;
    const unsigned ldsw = (unsigned)wid * 1024u;
    const int aoff = lds_byte(wr * 64 + fr, fq * 8), boff = lds_byte(wc * 32 + fr, fq * 8);
#define PG8_SA(b, h) (((b) * 2 + (h)) * HTB)
#define PG8_SB(b, h) ((4 + (b) * 2 + (h)) * HTB)
#define PG8_STAGE(bufoff, gbase, voff) do { _Pragma("unroll") for (int _i = 0; _i < 2; ++_i) \
        __builtin_amdgcn_global_load_lds((const unsigned*)((const char*)(gbase) + (voff)[_i]), (LAS unsigned*)(lds + (bufoff) + ldsw + _i * 8192), 16, 0, 0); } while (0)
#define PG8_STAGE_A(bufoff, h, kptr, nx) do { if constexpr (GATHER) { unsigned o_[2] = {(nx) ? nvA[h][0] : vA[h][0], (nx) ? nvA[h][1] : vA[h][1]}; PG8_STAGE(bufoff, kptr, o_); } else { PG8_STAGE(bufoff, (kptr) + (h) * hstepA, voffA); } } while (0)
#define PG8_LDA(dst, b, h) do { _Pragma("unroll") for (int m = 0; m < 4; ++m) _Pragma("unroll") for (int k = 0; k < 2; ++k) dst[m][k] = *(const LAS bf16x8*)(lds + PG8_SA(b, h) + aoff + m * 2048 + k * 1024); } while (0)
#define PG8_LDB(dst, b, h) do { _Pragma("unroll") for (int n = 0; n < 2; ++n) _Pragma("unroll") for (int k = 0; k < 2; ++k) dst[n][k] = *(const LAS bf16x8*)(lds + PG8_SB(b, h) + boff + n * 2048 + k * 1024); } while (0)
#define PG8_MMA(ai, bj, At, Bt) do { __builtin_amdgcn_s_setprio(1); _Pragma("unroll") for (int m = 0; m < 4; ++m) _Pragma("unroll") for (int n = 0; n < 2; ++n) _Pragma("unroll") for (int k = 0; k < 2; ++k) \
        acc[ai][bj][m][n] = __builtin_amdgcn_mfma_f32_16x16x32_bf16(Bt[n][k], At[m][k], acc[ai][bj][m][n], 0, 0, 0); __builtin_amdgcn_s_setprio(0); } while (0)
#define PG8_WAIT_V(n) asm volatile("s_waitcnt vmcnt(" #n ")" ::: "memory")
#define PG8_WAIT_L(n) asm volatile("s_waitcnt lgkmcnt(" #n ")" ::: "memory")
#define PG8_BAR __builtin_amdgcn_s_barrier()
#define PG8_SCHED __builtin_amdgcn_sched_barrier(0)
    Unit cur, nxt; int ui = 0;
    if (!S.next(0, cur)) return;
    f32x4 acc[2][2][4][2];
#pragma unroll
    for (int a = 0; a < 2; ++a)
#pragma unroll
        for (int b = 0; b < 2; ++b)
#pragma unroll
            for (int m = 0; m < 4; ++m)
#pragma unroll
                for (int n = 0; n < 2; ++n) acc[a][b][m][n] = (f32x4){0.f, 0.f, 0.f, 0.f};
    bf16x8 At[4][2], B0[2][2], B1[2][2];
    const char* cA = cur.a; const char* cB = cur.b;
    if constexpr (GATHER) {
#pragma unroll
        for (int h = 0; h < 2; ++h)
#pragma unroll
            for (int i = 0; i < 2; ++i) { int R, C; stage_rc(tid * 16 + i * 8192, R, C); vA[h][i] = S.row_off(cur, rowA[i] + 128 * h) + (unsigned)C * 2u; nvA[h][i] = vA[h][i]; } }
    PG8_STAGE(PG8_SB(0, 0), cB, voffB); PG8_STAGE(PG8_SB(0, 1), cB + hstepB, voffB); PG8_STAGE_A(PG8_SA(0, 0), 0, cA, false); PG8_STAGE_A(PG8_SA(0, 1), 1, cA, false);
    if (wr == 1) PG8_BAR;
    PG8_WAIT_V(2); PG8_BAR;
    PG8_STAGE(PG8_SB(1, 0), cB + kstep, voffB); PG8_STAGE_A(PG8_SA(1, 0), 0, cA + kstep, false); PG8_STAGE(PG8_SB(1, 1), cB + hstepB + kstep, voffB);
    PG8_WAIT_V(6); PG8_BAR;
    for (;;) {
        const bool has_next = S.next(ui + 1, nxt);
        if constexpr (GATHER) { if (has_next) {
#pragma unroll
            for (int h = 0; h < 2; ++h)
#pragma unroll
                for (int i = 0; i < 2; ++i) { int R, C; stage_rc(tid * 16 + i * 8192, R, C); nvA[h][i] = S.row_off(nxt, rowA[i] + 128 * h) + (unsigned)C * 2u; } } }
        const char* nA = has_next ? nxt.a : cA; const char* nB = has_next ? nxt.b : cB;
#pragma unroll 1
        for (int t = 0; t < nt; t += 2) {
            const bool last = (t == nt - 2);
            const char* a1 = cA + (size_t)(t + 1) * kstep;
            const char* a2 = last ? nA : cA + (size_t)(t + 2) * kstep; const char* b2 = last ? nB : cB + (size_t)(t + 2) * kstep;
            const char* a3 = a2 + kstep; const char* b3 = b2 + kstep;
            PG8_LDB(B0, 0, 0); PG8_LDB(B1, 0, 1); PG8_SCHED; PG8_LDA(At, 0, 0); PG8_STAGE_A(PG8_SA(1, 1), 1, a1, false);
            PG8_WAIT_V(8); PG8_WAIT_L(0); PG8_BAR; PG8_MMA(0, 0, At, B0); PG8_MMA(0, 1, At, B1); PG8_BAR; PG8_SCHED;
            PG8_LDA(At, 0, 1); PG8_STAGE(PG8_SB(0, 0), b2, voffB); PG8_STAGE(PG8_SB(0, 1), b2 + hstepB, voffB); PG8_STAGE_A(PG8_SA(0, 0), 0, a2, last);
            PG8_WAIT_V(8); PG8_WAIT_L(0); PG8_BAR; PG8_MMA(1, 0, At, B0); PG8_MMA(1, 1, At, B1); PG8_BAR; PG8_SCHED;
            PG8_LDB(B0, 1, 0); PG8_LDB(B1, 1, 1); PG8_SCHED; PG8_LDA(At, 1, 0); PG8_STAGE_A(PG8_SA(0, 1), 1, a2, last);
            PG8_WAIT_V(8); PG8_WAIT_L(0); PG8_BAR; PG8_MMA(0, 0, At, B0); PG8_MMA(0, 1, At, B1); PG8_BAR; PG8_SCHED;
            PG8_LDA(At, 1, 1); PG8_STAGE(PG8_SB(1, 0), b3, voffB); PG8_STAGE(PG8_SB(1, 1), b3 + hstepB, voffB); PG8_STAGE_A(PG8_SA(1, 0), 0, a3, last);
            PG8_WAIT_V(8); PG8_WAIT_L(0); PG8_BAR; PG8_MMA(1, 0, At, B0); PG8_MMA(1, 1, At, B1); PG8_BAR; PG8_SCHED;
            if constexpr (Epi::HAS_MID) { if (t == Epi::MID_T) E.mid(acc, cur, wr, wc, fr, fq); }
        }
        if constexpr (ALIGN_EPI) { if (wr == 0) PG8_BAR; }
        E(acc, cur, wr, wc, fr, fq);
        if (!has_next) break;
#pragma unroll
        for (int a = 0; a < 2; ++a)
#pragma unroll
            for (int b = 0; b < 2; ++b)
#pragma unroll
                for (int m = 0; m < 4; ++m)
#pragma unroll
                    for (int n = 0; n < 2; ++n) acc[a][b][m][n] = (f32x4){0.f, 0.f, 0.f, 0.f};
        cur = nxt; cA = nA; cB = nB; ++ui;
        if constexpr (GATHER) {
#pragma unroll
            for (int h = 0; h < 2; ++h) { vA[h][0] = nvA[h][0]; vA[h][1] = nvA[h][1]; } }
        if constexpr (ALIGN_EPI) { if (wr == 1) PG8_BAR; }
    }
    PG8_WAIT_V(0);
    if constexpr (!ALIGN_EPI) { if (wr == 0) PG8_BAR; }
    PG8_BAR;
#undef PG8_SA
#undef PG8_SB
#undef PG8_STAGE
#undef PG8_STAGE_A
#undef PG8_LDA
#undef PG8_LDB
#undef PG8_MMA
#undef PG8_WAIT_V
#undef PG8_WAIT_L
#undef PG8_BAR
#undef PG8_SCHED
}
}
using pg8::Unit;

struct RectSched {
    int nM, nN, nwg, G, c; const char* A; const char* B; size_t tA, tB;
    __device__ void init(int M, int N, int G_, int c_, const void* A_, unsigned lda, const void* B_, unsigned ldb) { nM = M / 256; nN = N / 256; nwg = nM * nN; G = G_; c = c_; A = (const char*)A_; B = (const char*)B_; tA = (size_t)256 * lda; tB = (size_t)256 * ldb; }
    __device__ bool next(int i, Unit& u) const {
        const long L = (long)i * G + c; if (L >= nwg) return false;
        int wgid = (int)L; { const int q = nwg / 8, r = nwg % 8, xcd = wgid % 8, off = wgid / 8; wgid = (xcd < r ? xcd * (q + 1) : r * (q + 1) + (xcd - r) * q) + off; }
        const int nig = 8 * nN, gid = wgid / nig, fm = gid * 8, gsz = (nM - fm) < 8 ? (nM - fm) : 8;
        u.pm = fm + ((wgid % nig) % gsz); u.pn = (wgid % nig) / gsz; u.a = A + (size_t)u.pm * tA; u.b = B + (size_t)u.pn * tB; return true;
    }
};
struct CmpSched {
    int vcu, G; const char* A0; const char* A1; const char* B0; const char* B1;
    __device__ bool next(int i, Unit& u) const { int c; if (G == 256) { if (i > 0 || (vcu & 3) != 0) return false; c = vcu >> 2; } else { c = vcu + i * G; if (c >= 64) return false; }
        u.pm = c & 15; u.pn = c >> 4; const int side = u.pn >> 1, kh = u.pn & 1;
        u.a = (side ? A1 : A0) + (size_t)u.pm * 256 * 2048 + kh * 2048; u.b = (side ? B1 : B0) + kh * 2048; return true; }
};
struct MixSched {
    int vcu, G; const char* A; const char* B;
    __device__ bool next(int i, Unit& u) const { if (vcu < 0) return false; const int L = i * G + vcu; if (L >= 256) return false; u.pm = L >> 2; u.pn = L & 3; u.a = A + (size_t)u.pm * 256 * 2048 + u.pn * 512; u.b = B + (size_t)u.pn * 256 * 512; return true; }
};
struct MoeTab { const LAS int* texp; const LAS int* tb; const LAS int* cn; const int* elist; const float* ewt; };
template <int NCT, int NEXP_ROWS  > struct MoeSched {
    int v, Gp, L0, L1; const char* A; const char* B; unsigned lda, ldb; MoeTab T;
    __device__ bool next(int i, Unit& u) const { if (v < 0 || v >= Gp) return false; const int L = L0 + i * Gp + v; if (L >= L1) return false; u.pm = L / NCT; u.pn = L % NCT; const int e = T.texp[u.pm];
        u.a = A + (size_t)u.pm * 256 * lda; u.b = B + ((size_t)e * NEXP_ROWS + (size_t)u.pn * 256) * ldb; return true; }
};
template <int NCT, int NEXP_ROWS> struct MoeGatherSched {
    int v, Gp, L0, L1; const char* A; const char* B; unsigned lda, ldb; MoeTab T;
    __device__ bool next(int i, Unit& u) const { if (v < 0 || v >= Gp) return false; const int L = L0 + i * Gp + v; if (L >= L1) return false; u.pm = L / NCT; u.pn = L % NCT; const int e = T.texp[u.pm];
        u.a = A; u.b = B + ((size_t)e * NEXP_ROWS + (size_t)u.pn * 256) * ldb; return true; }
    __device__ unsigned row_off(const Unit& u, int R) const { const int e = T.texp[u.pm]; const int pos = (u.pm - T.tb[e]) * 256 + R; const int tok = pos < T.cn[e] ? (T.elist[(size_t)e * NT + pos] >> 1) : 0; return (unsigned)tok * lda; }
};

struct EpiInProj {
    static constexpr bool PERM = true, HAS_MID = false;
    bf16_t* U; bf16_t* Q; bf16_t* KVb; bf16_t* GM; float* GN; const f32x4* rope;
    __device__ __forceinline__ void operator()(const f32x4 (&acc)[2][2][4][2], const Unit& u, int wr, int wc, int fr, int fq) const {
        const int pn = u.pn, row0 = u.pm * 256 + wr * 64 + fr, cit = wc * 32 + 8 * fq;
        if (pn < 4) {
#pragma unroll
            for (int ai = 0; ai < 2; ++ai)
#pragma unroll
                for (int m = 0; m < 4; ++m) { bf16_t* rp = U + (size_t)(row0 + ai * 128 + m * 16) * PW + pn * 256 + cit;
#pragma unroll
                    for (int bj = 0; bj < 2; ++bj) store8(rp + bj * 128, acc[ai][bj][m][0], acc[ai][bj][m][1]); }
        } else if (pn < 14) {
            const bool isq = pn < 8; const int kind = pn - 8; const bool dorope = isq || kind == 2 || kind == 4;
            const int p0 = 32 * (wc & 1) + 8 * fq, gI = 4 * (wc & 1) + fq;
            const size_t kvo = kind == 1 ? (WS_VC - WS_KC) : kind == 2 ? (WS_KS - WS_KC) : kind == 3 ? (WS_VS - WS_KC) : kind == 4 ? (WS_KW - WS_KC) : kind == 5 ? (WS_VW - WS_KC) : 0;
            bf16_t* base = isq ? Q : (bf16_t*)((char*)KVb + kvo);
            const float sc = isq ? C2 : 1.f;
#pragma unroll
            for (int ai = 0; ai < 2; ++ai) {
                f32x4 c0[4], c1[4];
#pragma unroll
                for (int m = 0; m < 4; ++m) { c0[m] = (f32x4){1.f, 0.f, 1.f, 0.f}; c1[m] = c0[m]; }
                if (dorope) {
#pragma unroll
                    for (int m = 0; m < 4; ++m) { const int t = (row0 + ai * 128 + m * 16) & 4095; c0[m] = rope[t * 16 + gI * 2]; c1[m] = rope[t * 16 + gI * 2 + 1]; } }
                asm volatile("" ::: "memory");
#pragma unroll
                for (int m = 0; m < 4; ++m) { const int row = row0 + ai * 128 + m * 16, b = row >> 12, t = row & 4095;
                    const f32x4 cs0 = c0[m], cs1 = c1[m];
#pragma unroll
                    for (int bj = 0; bj < 2; ++bj) { const int hit = 2 * bj + (wc >> 1);
                        const f32x4 x1 = acc[ai][bj][m][0], x2 = acc[ai][bj][m][1];
                        const f32x4 c = (f32x4){cs0[0], cs0[2], cs1[0], cs1[2]}, s = (f32x4){cs0[1], cs0[3], cs1[1], cs1[3]};
                        const f32x4 y1 = (x1 * c - x2 * s) * sc, y2 = (x2 * c + x1 * s) * sc;
                        const size_t hrow = isq ? ((size_t)(b * NH + (pn - 4) * 4 + hit) * SEQ + t) : ((size_t)(b * NG + hit) * SEQ + t);
                        store8(base + hrow * HD + p0, y1, y2); } } }
        } else if (pn < 30) {
#pragma unroll
            for (int ai = 0; ai < 2; ++ai)
#pragma unroll
                for (int m = 0; m < 4; ++m) { bf16_t* rp = GM + (size_t)(row0 + ai * 128 + m * 16) * 4096 + (pn - 14) * 256 + cit;
#pragma unroll
                    for (int bj = 0; bj < 2; ++bj) store8(rp + bj * 128, sigmoid4(acc[ai][bj][m][0]), sigmoid4(acc[ai][bj][m][1])); }
        } else {
            if (wc < 2) {
#pragma unroll
                for (int ai = 0; ai < 2; ++ai)
#pragma unroll
                    for (int m = 0; m < 4; ++m) { float* rp = GN + (size_t)(row0 + ai * 128 + m * 16) * 64;
#pragma unroll
                        for (int n = 0; n < 2; ++n) { const int col = cit + 4 * n; if (col < 48) *(f32x4*)(rp + col) = sigmoid4(acc[ai][0][m][n]); } }
            }
        }
    }
};
struct EpiCmp1 {
    static constexpr bool PERM = true, HAS_MID = false;
    float* P; const float* bias;
    __device__ __forceinline__ void operator()(const f32x4 (&acc)[2][2][4][2], const Unit& u, int wr, int wc, int fr, int fq) const {
        const int row0 = u.pm * 256 + wr * 64 + fr, cit = wc * 32 + 8 * fq; float* out = P + (size_t)u.pn * 4096 * 256; const float* bs = bias + (u.pn >> 1) * 256;
        const float bsc = (u.pn & 1) ? 0.f : 1.f;
#pragma unroll
        for (int bj = 0; bj < 2; ++bj) { const f32x4 b0 = *(const f32x4*)(bs + bj * 128 + cit) * bsc, b1 = *(const f32x4*)(bs + bj * 128 + cit + 4) * bsc;
#pragma unroll
            for (int ai = 0; ai < 2; ++ai)
#pragma unroll
                for (int m = 0; m < 4; ++m) { float* o = out + (size_t)(row0 + ai * 128 + m * 16) * 256 + bj * 128 + cit;
                    *(f32x4*)o = acc[ai][bj][m][0] + b0; *(f32x4*)(o + 4) = acc[ai][bj][m][1] + b1; } }
    }
};
struct EpiMix {
    static constexpr bool PERM = true, HAS_MID = false;
    bf16_t* out; const float* scale;
    __device__ __forceinline__ void operator()(const f32x4 (&acc)[2][2][4][2], const Unit& u, int wr, int wc, int fr, int fq) const {
        const int row0 = u.pm * 256 + wr * 64 + fr, cit = wc * 32 + 8 * fq, cb = u.pn * 256;
#pragma unroll
        for (int bj = 0; bj < 2; ++bj) { const f32x4 s0 = *(const f32x4*)(scale + cb + bj * 128 + cit), s1 = *(const f32x4*)(scale + cb + bj * 128 + cit + 4);
#pragma unroll
            for (int ai = 0; ai < 2; ++ai)
#pragma unroll
                for (int m = 0; m < 4; ++m) store8(out + (size_t)(row0 + ai * 128 + m * 16) * DM + cb + bj * 128 + cit, acc[ai][bj][m][0] * s0, acc[ai][bj][m][1] * s1); }
    }
};
struct EpiZ2 {
    static constexpr bool PERM = true, HAS_MID = true; static constexpr int MID_T = 14;
    bf16_t* Z; const bf16_t* GM;
    __device__ __forceinline__ void mid(f32x4 (&acc)[2][2][4][2], const Unit& u, int wr, int wc, int fr, int fq) const {
        int row0 = u.pm * 256 + wr * 64 + fr, col0 = u.pn * 256 + wc * 32 + 8 * fq;
        asm volatile("" : "+v"(row0), "+v"(col0));
#pragma unroll
        for (int ai = 0; ai < 2; ++ai) {
            u32x4 gp[4][2], ga[4][2];
#pragma unroll
            for (int m = 0; m < 4; ++m) { const size_t row = row0 + ai * 128 + m * 16;
#pragma unroll
                for (int bj = 0; bj < 2; ++bj) { gp[m][bj] = *(const u32x4*)(GM + row * 4096 + col0 + bj * 128); ga[m][bj] = *(const u32x4*)(GM + row * 4096 + 2048 + col0 + bj * 128); } }
            asm volatile("" ::: "memory");
#pragma unroll
            for (int m = 0; m < 4; ++m)
#pragma unroll
                for (int bj = 0; bj < 2; ++bj) { const u32x4 wp = gp[m][bj], wa = ga[m][bj];
                    const f32x4 p0 = (f32x4){bflo(wp.x), bfhi(wp.x), bflo(wp.y), bfhi(wp.y)}, p1 = (f32x4){bflo(wp.z), bfhi(wp.z), bflo(wp.w), bfhi(wp.w)};
                    const f32x4 a0 = (f32x4){bflo(wa.x), bfhi(wa.x), bflo(wa.y), bfhi(wa.y)}, a1 = (f32x4){bflo(wa.z), bfhi(wa.z), bflo(wa.w), bfhi(wa.w)};
#pragma unroll
                    for (int j = 0; j < 4; ++j) { acc[ai][bj][m][0][j] *= p0[j] * __builtin_amdgcn_rcpf(fmaxf(a0[j], 1e-20f)); acc[ai][bj][m][1][j] *= p1[j] * __builtin_amdgcn_rcpf(fmaxf(a1[j], 1e-20f)); } }
            asm volatile("" ::: "memory"); }
    }
    __device__ __forceinline__ void operator()(const f32x4 (&acc)[2][2][4][2], const Unit& u, int wr, int wc, int fr, int fq) const {
        const int row0 = u.pm * 256 + wr * 64 + fr, col0 = u.pn * 256 + wc * 32 + 8 * fq;
#pragma unroll
        for (int ai = 0; ai < 2; ++ai) {
            u32x4 ga[4][2];
#pragma unroll
            for (int m = 0; m < 4; ++m) { const size_t row = row0 + ai * 128 + m * 16;
#pragma unroll
                for (int bj = 0; bj < 2; ++bj) ga[m][bj] = *(const u32x4*)(GM + row * 4096 + 2048 + col0 + bj * 128); }
            asm volatile("" ::: "memory");
#pragma unroll
            for (int m = 0; m < 4; ++m) { const size_t row = row0 + ai * 128 + m * 16;
#pragma unroll
                for (int bj = 0; bj < 2; ++bj) { const u32x4 wa = ga[m][bj];
                    f32x4 a0 = (f32x4){bflo(wa.x), bfhi(wa.x), bflo(wa.y), bfhi(wa.y)}, a1 = (f32x4){bflo(wa.z), bfhi(wa.z), bflo(wa.w), bfhi(wa.w)};
#pragma unroll
                    for (int j = 0; j < 4; ++j) { a0[j] = fmaxf(a0[j], 1e-20f); a1[j] = fmaxf(a1[j], 1e-20f); }
                    store8(Z + row * DM + col0 + bj * 128, acc[ai][bj][m][0] * a0, acc[ai][bj][m][1] * a1); } }
        }
    }
};
struct EpiV1 {
    static constexpr bool PERM = true, HAS_MID = false;
    bf16_t* V1B; const bf16_t* x; float* PS;
    __device__ __forceinline__ void operator()(const f32x4 (&acc)[2][2][4][2], const Unit& u, int wr, int wc, int fr, int fq) const {
        const int row0 = u.pm * 256 + wr * 64 + fr, col0 = u.pn * 256 + wc * 32 + 8 * fq;
#pragma unroll
        for (int ai = 0; ai < 2; ++ai) {
            u32x4 xv[4][2];
#pragma unroll
            for (int m = 0; m < 4; ++m) { const size_t off = (size_t)(row0 + ai * 128 + m * 16) * DM + col0;
#pragma unroll
                for (int bj = 0; bj < 2; ++bj) xv[m][bj] = *(const u32x4*)(x + off + bj * 128); }
            asm volatile("" ::: "memory");
#pragma unroll
            for (int m = 0; m < 4; ++m) { const size_t row = (size_t)(row0 + ai * 128 + m * 16); float sv = 0.f, qv = 0.f;
#pragma unroll
                for (int bj = 0; bj < 2; ++bj) { const u32x4 q = xv[m][bj];
                    const f32x4 v0 = (f32x4){bflo(q.x), bfhi(q.x), bflo(q.y), bfhi(q.y)} * DN_ALPHA + acc[ai][bj][m][0], v1 = (f32x4){bflo(q.z), bfhi(q.z), bflo(q.w), bfhi(q.w)} * DN_ALPHA + acc[ai][bj][m][1];
                    sv += ((v0[0] + v0[1]) + (v0[2] + v0[3])) + ((v1[0] + v1[1]) + (v1[2] + v1[3]));
                    qv += ((v0[0] * v0[0] + v0[1] * v0[1]) + (v0[2] * v0[2] + v0[3] * v0[3])) + ((v1[0] * v1[0] + v1[1] * v1[1]) + (v1[2] * v1[2] + v1[3] * v1[3]));
                    store8(V1B + row * DM + col0 + bj * 128, v0, v1); }
                sv += __shfl_xor(sv, 16); qv += __shfl_xor(qv, 16); sv += __shfl_xor(sv, 32); qv += __shfl_xor(qv, 32);
                if (fq == 0) *(f32x2*)(PS + row * 64 + (u.pn * 4 + wc) * 2) = (f32x2){sv, qv}; }
        }
    }
};
struct EpiUp {
    static constexpr bool PERM = true, HAS_MID = false;
    bf16_t* HID;
    __device__ __forceinline__ void operator()(const f32x4 (&acc)[2][2][4][2], const Unit& u, int wr, int wc, int fr, int fq) const {
        const int row0 = u.pm * 256 + wr * 64 + fr, col0 = u.pn * 128 + wc * 32 + 8 * fq;
#pragma unroll
        for (int ai = 0; ai < 2; ++ai)
#pragma unroll
            for (int m = 0; m < 4; ++m) { f32x4 h0, h1;
#pragma unroll
                for (int j = 0; j < 4; ++j) { const float g0 = acc[ai][0][m][0][j], g1 = acc[ai][0][m][1][j]; h0[j] = g0 * sigmoidf_(g0) * acc[ai][1][m][0][j]; h1[j] = g1 * sigmoidf_(g1) * acc[ai][1][m][1][j]; }
                store8(HID + (size_t)(row0 + ai * 128 + m * 16) * EH + col0, h0, h1); }
    }
};
struct EpiDown {
    static constexpr bool PERM = true, HAS_MID = false;
    bf16_t* YB; MoeTab T;
    __device__ __forceinline__ void operator()(const f32x4 (&acc)[2][2][4][2], const Unit& u, int wr, int wc, int fr, int fq) const {
        const int col0 = u.pn * 256 + wc * 32 + 8 * fq; const int e = T.texp[u.pm], pos0 = (u.pm - T.tb[e]) * 256 + wr * 64 + fr, cn = T.cn[e];
        int slot[2][4]; float w[2][4];
#pragma unroll
        for (int ai = 0; ai < 2; ++ai)
#pragma unroll
            for (int m = 0; m < 4; ++m) { const int pos = pos0 + ai * 128 + m * 16, pc = pos < cn ? pos : cn - 1;
                slot[ai][m] = T.elist[(size_t)e * NT + pc]; w[ai][m] = T.ewt[(size_t)e * NT + pc]; }
        asm volatile("" ::: "memory");
#pragma unroll
        for (int ai = 0; ai < 2; ++ai)
#pragma unroll
            for (int m = 0; m < 4; ++m) { const int pos = pos0 + ai * 128 + m * 16;
                if (pos < cn) {
#pragma unroll
                    for (int bj = 0; bj < 2; ++bj) store8(YB + (size_t)slot[ai][m] * DM + col0 + bj * 128, acc[ai][bj][m][0] * w[ai][m], acc[ai][bj][m][1] * w[ai][m]); } }
    }
};

#define XB_TMO      128
#define XB_XCNT(j)  (256  + 64 * (j))
#define XB_XSUB(j)  (1280 + 64 * (j))
#define XB_XGEN(j)  (2304 + 64 * (j))
#define XB_TOP      3328
#define XB_TOPGEN   3392
#define XCD_BAR_WORDS 3456
#define XB_SPIN_CAP (1u << 20)
__device__ __forceinline__ unsigned xb_ld(unsigned* p)              { return __hip_atomic_load(p, __ATOMIC_RELAXED, __HIP_MEMORY_SCOPE_AGENT); }
__device__ __forceinline__ unsigned xb_add(unsigned* p, unsigned v) { return __hip_atomic_fetch_add(p, v, __ATOMIC_RELAXED, __HIP_MEMORY_SCOPE_AGENT); }
__device__ __forceinline__ unsigned xb_xcc_id() { return (unsigned)__builtin_amdgcn_s_getreg((3 << 11) | 20) & 0xFu; }
#define XB_SPIN(cond, bar) do { unsigned _sp = 0; while (cond) { __builtin_amdgcn_s_sleep(1); \
    if ((++_sp & 255u) == 0u) { if (xb_ld(&(bar)[XB_TMO])) break; if (_sp > XB_SPIN_CAP) { atomicAdd(&(bar)[XB_TMO], 1u); break; } } } } while (0)
struct XcdBarrier { unsigned* bar; unsigned x; volatile LAS unsigned* st; };
__device__ __forceinline__ XcdBarrier xcd_barrier_post(unsigned* bar, volatile LAS unsigned* st) {
    XcdBarrier b; b.bar = bar; b.x = xb_xcc_id(); b.st = st;
    if (threadIdx.x == 0) (void)xb_add(&bar[XB_XCNT(b.x)], 1u);
    return b;
}
__device__ __forceinline__ void xcd_barrier_complete(unsigned* bar, unsigned x, unsigned& nloc, unsigned& nx) {
    const unsigned G = gridDim.x * gridDim.y * gridDim.z;
    unsigned sum, cnt, mine, sp = 0u;
    for (;;) {
        sum = 0u; cnt = 0u; mine = 0u;
#pragma unroll
        for (unsigned j = 0; j < 16; ++j) { const unsigned c = xb_ld(&bar[XB_XCNT(j)]); sum += c; cnt += (c > 0u) ? 1u : 0u; mine = (j == x) ? c : mine; }
        if (sum == G) break;
        __builtin_amdgcn_s_sleep(1);
        if ((++sp & 255u) == 0u) { if (xb_ld(&bar[XB_TMO])) break; if (sp > XB_SPIN_CAP) { atomicAdd(&bar[XB_TMO], 1u); break; } }
    }
    nloc = mine > 0u ? mine : 1u; nx = cnt > 0u ? cnt : 1u;
}
__device__ __forceinline__ void xcd_barrier(const XcdBarrier& b) {
    asm volatile("s_waitcnt vmcnt(0)" ::: "memory");
    __syncthreads();
    if (threadIdx.x == 0) {
        unsigned* bar = b.bar;
        __builtin_amdgcn_s_waitcnt(0);
        unsigned nloc = b.st[0], nx = b.st[1];
        if (nloc == 0u) { xcd_barrier_complete(bar, b.x, nloc, nx); b.st[0] = nloc; b.st[1] = nx; }
        const unsigned old = xb_add(&bar[XB_XSUB(b.x)], 1u);
        const unsigned gen = old / nloc;
        if (old + 1u == (gen + 1u) * nloc) {
            __builtin_amdgcn_fence(__ATOMIC_RELEASE, "agent");
            asm volatile("s_waitcnt vmcnt(0)" ::: "memory");
            (void)xb_add(&bar[XB_TOP], 1u);
            asm volatile("buffer_inv sc1" ::: "memory");
            XB_SPIN(xb_ld(&bar[XB_TOP]) < (gen + 1u) * nx, bar);
            asm volatile("s_waitcnt vmcnt(0)" ::: "memory");
        } else {
            asm volatile("buffer_inv sc1" ::: "memory");
            XB_SPIN(xb_ld(&bar[XB_TOP]) < (gen + 1u) * nx, bar);
            asm volatile("s_waitcnt vmcnt(0)" ::: "memory");
        }
    }
    __syncthreads();
}


__device__ __forceinline__ void group_barrier(unsigned* cnt, unsigned n, unsigned* tmo, bool leader) {
    asm volatile("s_waitcnt vmcnt(0)" ::: "memory");
    __syncthreads();
    if (leader) {
        __builtin_amdgcn_fence(__ATOMIC_RELEASE, "agent");
        asm volatile("s_waitcnt vmcnt(0)" ::: "memory");
        (void)xb_add(cnt, 1u);
        unsigned sp = 0u;
        while (xb_ld(cnt) < n) { __builtin_amdgcn_s_sleep(1); if ((++sp & 255u) == 0u) { if (xb_ld(tmo)) break; if (sp > XB_SPIN_CAP) { atomicAdd(tmo, 1u); break; } } }
        __builtin_amdgcn_fence(__ATOMIC_ACQUIRE, "agent");
        asm volatile("s_waitcnt vmcnt(0)" ::: "memory");
    }
    __syncthreads();
}

__device__ __forceinline__ void group_barrier_x(unsigned* ctl, int k, int c, unsigned x, unsigned nmem, bool leader) {
    asm volatile("s_waitcnt vmcnt(0)" ::: "memory");
    __syncthreads();
    if (leader) {
        unsigned* gx = ctl + CW_GX; unsigned* tmo = ctl + CW_BAR + XB_TMO;
        const unsigned ngx = xb_ld(gx + 16 * c + (int)x);
        unsigned* tot = gx + 256 + 16 * k;
        const unsigned old = xb_add(gx + 1024 + 16 * (16 * k + (int)x), 1u);
        if (old + 1u == ngx) { __builtin_amdgcn_fence(__ATOMIC_RELEASE, "agent"); asm volatile("s_waitcnt vmcnt(0)" ::: "memory"); (void)xb_add(tot, ngx); }
        asm volatile("buffer_inv sc1" ::: "memory");
        unsigned sp = 0u;
        while (xb_ld(tot) < nmem) { __builtin_amdgcn_s_sleep(1); if ((++sp & 255u) == 0u) { if (xb_ld(tmo)) break; if (sp > XB_SPIN_CAP) { atomicAdd(tmo, 1u); break; } } }
        asm volatile("s_waitcnt vmcnt(0)" ::: "memory");
    }
    __syncthreads();
}

struct Args { const float* in[24]; float* out; unsigned char* ws; int ph_lo, ph_hi; };
struct Frame {
    LAS unsigned char* lds; unsigned char* ws; const float* const* in; float* out;
    int tid, lane, wave, vcu, G;
};
#define WSP(T, off) ((T*)(F.ws + (off)))

__device__ __forceinline__ int ropepos(int d) { return d < 32 ? 8 * (d >> 2) + (d & 3) : 8 * ((d - 32) >> 2) + 4 + (d & 3); }
__device__ __forceinline__ int in_map(int n) {
    if (n < 1024) return n;
    if (n < 2048) { const int r = n - 1024; return 1024 + (r & ~63) + ropepos(r & 63); }
    if (n < 3584) { const int seg = (n - 2048) >> 8; if (seg == 2 || seg == 4) { const int r = n - 2048; return 2048 + (r & ~63) + ropepos(r & 63); } return n; }
    if (n < 3632) return 7680 + (n - 3584);
    return 3584 + (n - 3632);
}
struct TrItem { const float* W; bf16_t* WT; int N, ldt, map, item; };
__device__ __forceinline__ void tr_load(const TrItem& d, float (&r)[32], int lane) {
    const int nblk = (d.N + 31) / 32, kb = d.item / nblk, nb = d.item % nblk, k0 = 64 * kb, n0 = 32 * nb;
    int ncol = n0 + (lane & 31); ncol = ncol < d.N ? ncol : d.N - 1;
    const float* p = d.W + (size_t)(k0 + (lane >> 5)) * d.N + ncol; const size_t st2 = (size_t)2 * d.N;
#pragma unroll
    for (int i = 0; i < 32; ++i) r[i] = p[i * st2];
}
__device__ __forceinline__ void tr_store(const TrItem& d, const float (&r)[32], LAS float* scr, int lane) {
    const int nblk = (d.N + 31) / 32, kb = d.item / nblk, nb = d.item % nblk, k0 = 64 * kb, n0 = 32 * nb;
#pragma unroll
    for (int i = 0; i < 32; ++i) scr[(2 * i + (lane >> 5)) * 33 + (lane & 31)] = r[i];
    asm volatile("s_waitcnt lgkmcnt(0)" ::: "memory");
    const int c = lane & 7;
#pragma unroll
    for (int j = 0; j < 4; ++j) { const int nl = (lane >> 3) + 8 * j, n = n0 + nl; const LAS float* s = scr + (8 * c) * 33 + nl;
        u32x4 o; o.x = pk2(s[0 * 33], s[1 * 33]); o.y = pk2(s[2 * 33], s[3 * 33]); o.z = pk2(s[4 * 33], s[5 * 33]); o.w = pk2(s[6 * 33], s[7 * 33]);
        int dr = n; if (d.map == 1) dr = in_map(n); else if (d.map == 2) dr = (n >> 7) * 256 + (n & 127); else if (d.map == 3) dr = (n >> 7) * 256 + 128 + (n & 127);
        if (n < d.N) *(u32x4*)(d.WT + (size_t)dr * d.ldt + k0 + 8 * c) = o; }
    asm volatile("s_waitcnt lgkmcnt(0)" ::: "memory");
}
namespace p0c {
constexpr int I_IN = 32 * 242, I_PP = 16 * 64, I_NP = 16 * 64, I_WO = 32 * 64, I_PM = 4 * 4 * 8, I_C1 = 32 * 8, I_C2 = 4 * 2, I_G = 32 * 16, I_D = 8 * 64;
constexpr int NSMALL = I_IN + I_PP + I_NP + I_WO + I_PM + 2 * I_C1 + 2 * I_C2;
constexpr int NITEMS = NSMALL + NE * (2 * I_G + I_D);
}
__device__ __forceinline__ void p0_transposes(Frame& F, int it0, int it1, int gw, int NGW) {
    using namespace p0c;
    LAS float* scr = (LAS float*)(F.lds + F.wave * 16384);
    const int lane = F.lane;
    const float* const* in = F.in;
    auto decode = [&](int it) -> TrItem {
        int r = it; TrItem d;
        if (r < NSMALL) {
            if (r < I_IN) { d = TrItem{in[1], WSP(bf16_t, WS_WIN), IN_COLS, DM, 1, r}; return d; } r -= I_IN;
            if (r < I_PP) { d = TrItem{in[4], WSP(bf16_t, WS_WPP), DM, DM, 0, r}; return d; } r -= I_PP;
            if (r < I_NP) { d = TrItem{in[5], WSP(bf16_t, WS_WPP) + 1024, DM, DM, 0, r}; return d; } r -= I_NP;
            if (r < I_WO) { d = TrItem{in[12], WSP(bf16_t, WS_WO), DM, DM, 0, r}; return d; } r -= I_WO;
            if (r < I_PM) { const int g = r / 32; d = TrItem{in[2] + (size_t)g * 65536, WSP(bf16_t, WS_PM) + (size_t)g * 65536, 256, 256, 0, r % 32}; return d; } r -= I_PM;
            if (r < I_C1) { d = TrItem{in[8], WSP(bf16_t, WS_CW1K), 256, 2048, 0, r}; return d; } r -= I_C1;
            if (r < I_C1) { d = TrItem{in[10], WSP(bf16_t, WS_CW1V), 256, 2048, 0, r}; return d; } r -= I_C1;
            if (r < I_C2) { d = TrItem{in[9], WSP(bf16_t, WS_CW2K), 64, 256, 0, r}; return d; } r -= I_C2;
            d = TrItem{in[11], WSP(bf16_t, WS_CW2V), 64, 256, 0, r}; return d;
        }
        r -= NSMALL;
        const int e = r / (2 * I_G + I_D); r -= e * (2 * I_G + I_D);
        if (r < I_G) { d = TrItem{in[19] + (size_t)e * DM * EH, WSP(bf16_t, WS_WGU) + (size_t)e * 1024 * DM, EH, DM, 2, r}; return d; } r -= I_G;
        if (r < I_G) { d = TrItem{in[20] + (size_t)e * DM * EH, WSP(bf16_t, WS_WGU) + (size_t)e * 1024 * DM, EH, DM, 3, r}; return d; } r -= I_G;
        d = TrItem{in[21] + (size_t)e * EH * DM, WSP(bf16_t, WS_WD) + (size_t)e * DM * EH, DM, EH, 0, r}; return d;
    };
    if (it0 + gw < it1) {
        const int last = it0 + gw + ((it1 - 1 - it0 - gw) / NGW) * NGW;
        TrItem c0 = decode(it0 + gw); float r0[32]; tr_load(c0, r0, lane);
        TrItem c1 = decode(min(it0 + gw + NGW, last)); float r1[32]; tr_load(c1, r1, lane);
#pragma unroll 1
        for (int it = it0 + gw; it < it1; it += NGW) {
            TrItem c2 = decode(min(it + 2 * NGW, last)); float r2[32]; tr_load(c2, r2, lane);
            tr_store(c0, r0, scr, lane);
#pragma unroll
            for (int i = 0; i < 32; ++i) { r0[i] = r1[i]; r1[i] = r2[i]; }
            c0 = c1; c1 = c2;
        }
    }
}
__device__ __forceinline__ void p0_prologue(Frame& F, bool moe_weights) {
    const int lane = F.lane; const float* const* in = F.in;
    if (F.wave < 4) { p0_transposes(F, 0, moe_weights ? p0c::NITEMS : p0c::NSMALL, F.vcu * 4 + F.wave, F.G * 4);
      float* cb = WSP(float, WS_CBIAS);
      for (int o = F.vcu * 4 + F.wave; o < 512; o += F.G * 4) { const int side = o >> 8, col = o & 255; const float* pos = in[side ? 7 : 6]; const float* w1 = in[side ? 10 : 8]; float s = 0.f;
          for (int k = lane; k < 2048; k += 64) s += pos[k] * w1[(size_t)k * 256 + col];
          s = wave_sum(s); if (lane == 0) cb[o] = s; }
      return; }
    const size_t gt = (size_t)F.vcu * 256 + (F.tid - 256), TT = (size_t)F.G * 256;
    { const float* x = in[0]; bf16_t* xb = WSP(bf16_t, WS_XB);
      for (size_t i = gt; i < (size_t)NT * DM / 8; i += TT) { const f32x4 a = *(const f32x4*)(x + i * 8), b = *(const f32x4*)(x + i * 8 + 4); u32x4 o; o.x = pk2(a[0], a[1]); o.y = pk2(a[2], a[3]); o.z = pk2(b[0], b[1]); o.w = pk2(b[2], b[3]); *(u32x4*)(xb + i * 8) = o; } }
    {
      const float invf[32] = {1.f, 0.749894261f, 0.562341332f, 0.421696514f, 0.316227764f, 0.237137377f, 0.177827939f, 0.133352131f, 0.100000001f, 0.0749894157f, 0.0562341325f, 0.0421696529f, 0.0316227749f, 0.0237137377f, 0.0177827943f, 0.0133352149f, 0.00999999978f, 0.00749894185f, 0.00562341325f, 0.00421696482f, 0.00316227763f, 0.00237137359f, 0.00177827943f, 0.00133352145f, 0.00100000005f, 0.000749894243f, 0.000562341302f, 0.000421696517f, 0.000316227757f, 0.00023713737f, 0.00017782794f, 0.00013335215f};
      f32x2* rt = WSP(f32x2, WS_ROPE);
      for (size_t i = gt; i < (size_t)SEQ * 32; i += TT) { const int t = (int)(i >> 5), k = (int)(i & 31);
          float fr = 1.f;
#pragma unroll
          for (int q = 0; q < 32; ++q) fr = (k == q) ? invf[q] : fr;
          const float ang = (float)t * fr; double rev = (double)ang * 0.15915494309189535; rev -= __builtin_rint(rev); const float r = (float)rev;
          rt[i] = (f32x2){__builtin_amdgcn_cosf(r), __builtin_amdgcn_sinf(r)}; } }
    {
      bf16_t* wh = WSP(bf16_t, WS_WRH); bf16_t* wl = WSP(bf16_t, WS_WRL);
      for (size_t i = gt; i < (size_t)80 * DM; i += TT) { const int r = (int)(i / DM), k = (int)(i % DM); float v = 0.f;
          if (r < 8) v = in[15][(size_t)k * 8 + r]; else if (r < 72) { const int g = (r - 8) >> 3, e = (r - 8) & 7; v = in[17][((size_t)g * DM + k) * 8 + e]; }
          const unsigned h = f2bf(v); const float hv = __builtin_bit_cast(float, h << 16);
          const size_t d = ((size_t)((k >> 5) * 5 + (r >> 4)) * 64 + ((k >> 3) & 3) * 16 + (r & 15)) * 8 + (k & 7);
          wh[d] = (bf16_t)h; wl[d] = (bf16_t)f2bf(v - hv); } }
}

__device__ __forceinline__ void p2_pool(Frame& F) {
    const bf16_t* U = WSP(bf16_t, WS_U); bf16_t* P = WSP(bf16_t, WS_POOLED);
    const bool spread = F.G == 256;
    if (spread && (F.vcu & 3) == 0) return;
    const int pv_ = spread ? F.vcu - (F.vcu >> 2) - 1 : F.vcu, pg_ = spread ? 192 : F.G; const int gt = pv_ * 512 + F.tid, TT = pg_ * 512;
    for (int it = gt; it < (NT / 16) * 128; it += TT) {
        const int cc = it & 127, rb = it >> 7, m0 = rb * 16, t0 = m0 & 4095, g = cc >> 5, w = 2 << g;
        const bf16_t* up = U + (size_t)m0 * PW + cc * 8;
        const bool hist = t0 != 0;
        u32x4 h[15], c[16];
#pragma unroll
        for (int j = 1; j <= 15; ++j) h[j - 1] = *(const u32x4*)(up - (size_t)(hist ? j : 0) * PW);
#pragma unroll
        for (int i = 0; i < 16; ++i) c[i] = *(const u32x4*)(up + (size_t)i * PW);
#pragma unroll
        for (int j = 1; j <= 15; ++j) if (!(hist && j < w)) h[j - 1] = (u32x4){0u, 0u, 0u, 0u};
        f32x4 s0 = (f32x4){0.f, 0.f, 0.f, 0.f}, s1 = s0;
#pragma unroll
        for (int j = 1; j <= 15; ++j) { const u32x4 q = h[j - 1]; s0 += (f32x4){bflo(q.x), bfhi(q.x), bflo(q.y), bfhi(q.y)}; s1 += (f32x4){bflo(q.z), bfhi(q.z), bflo(q.w), bfhi(q.w)}; }
#pragma unroll
        for (int i = 0; i < 16; ++i) { const int t = t0 + i; const u32x4 q = c[i];
            const f32x4 a = (f32x4){bflo(q.x), bfhi(q.x), bflo(q.y), bfhi(q.y)}, b = (f32x4){bflo(q.z), bfhi(q.z), bflo(q.w), bfhi(q.w)};
            s0 += a; s1 += b;
            const float inv = 1.f / (float)((t + 1 < w) ? (t + 1) : w);
            store8(P + (size_t)(m0 + i) * PW + cc * 8, s0 * inv - a, s1 * inv - b);
            const int k2 = i - 1, k4 = i - 3, k8 = i - 7, k16 = i - 15;
            const u32x4 l2 = k2 >= 0 ? c[k2 >= 0 ? k2 : 0] : h[k2 < 0 ? -k2 - 1 : 0], l4 = k4 >= 0 ? c[k4 >= 0 ? k4 : 0] : h[k4 < 0 ? -k4 - 1 : 0];
            const u32x4 l8 = k8 >= 0 ? c[k8 >= 0 ? k8 : 0] : h[k8 < 0 ? -k8 - 1 : 0], l16 = k16 >= 0 ? c[k16 >= 0 ? k16 : 0] : h[k16 < 0 ? -k16 - 1 : 0];
            const u32x4 lv = g == 0 ? l2 : g == 1 ? l4 : g == 2 ? l8 : l16;
            s0 -= (f32x4){bflo(lv.x), bfhi(lv.x), bflo(lv.y), bfhi(lv.y)}; s1 -= (f32x4){bflo(lv.z), bfhi(lv.z), bflo(lv.w), bfhi(lv.w)}; }
    }
}

__device__ __forceinline__ void p3_cmp2(Frame& F, int wg_index, int wg_count) {
    const int gw = wg_index * 8 + F.wave, NGW = wg_count * 8, lane = F.lane, fr = lane & 15, kg = lane >> 4;
    const f32x2* rope = WSP(f32x2, WS_ROPE);
    for (int it = gw; it < 512; it += NGW) {
        const int side = it >> 8, rb = it & 255, r0 = rb * 16;
        const float* P0 = WSP(float, WS_CMPP) + ((size_t)(side * 2) * 4096 + r0 + fr) * 256 + kg * 8; const float* P1 = P0 + (size_t)4096 * 256;
        const bf16_t* W = WSP(bf16_t, side ? WS_CW2V : WS_CW2K) + (size_t)fr * 256 + kg * 8;
        f32x4 acc[4];
#pragma unroll
        for (int nb = 0; nb < 4; ++nb) acc[nb] = (f32x4){0.f, 0.f, 0.f, 0.f};
#pragma unroll
        for (int sh = 0; sh < 2; ++sh) {
            f32x4 pa[4][2], pb[4][2]; bf16x8 wf[4][4];
#pragma unroll
            for (int s4 = 0; s4 < 4; ++s4) { const int s = sh * 4 + s4; pa[s4][0] = *(const f32x4*)(P0 + s * 32); pa[s4][1] = *(const f32x4*)(P0 + s * 32 + 4); pb[s4][0] = *(const f32x4*)(P1 + s * 32); pb[s4][1] = *(const f32x4*)(P1 + s * 32 + 4);
#pragma unroll
                for (int nb = 0; nb < 4; ++nb) wf[s4][nb] = *(const bf16x8*)(W + (size_t)nb * 16 * 256 + s * 32); }
            asm volatile("" ::: "memory");
#pragma unroll
            for (int s4 = 0; s4 < 4; ++s4) { f32x4 v0 = pa[s4][0] + pb[s4][0], v1 = pa[s4][1] + pb[s4][1];
#pragma unroll
                for (int j = 0; j < 4; ++j) { v0[j] = gelu_tanh(v0[j]); v1[j] = gelu_tanh(v1[j]); }
                u32x4 aw; aw.x = cvt_pk_bf16(v0[0], v0[1]); aw.y = cvt_pk_bf16(v0[2], v0[3]); aw.z = cvt_pk_bf16(v1[0], v1[1]); aw.w = cvt_pk_bf16(v1[2], v1[3]);
                const bf16x8 a = __builtin_bit_cast(bf16x8, aw);
#pragma unroll
                for (int nb = 0; nb < 4; ++nb) acc[nb] = __builtin_amdgcn_mfma_f32_16x16x32_bf16(a, wf[s4][nb], acc[nb], 0, 0, 0); } }
        bf16_t* out = WSP(bf16_t, side ? WS_VCMP : WS_KCMP);
#pragma unroll
        for (int r = 0; r < 4; ++r) { const int row = r0 + 4 * kg + r, c = row & 255;
            if (side == 0) { const int pos = c * 16 + 31;
#pragma unroll
                for (int nb = 0; nb < 2; ++nb) { const int i = nb * 16 + fr; const f32x2 cs = rope[(size_t)(pos & 4095) * 32 + i]; const float x1 = acc[nb][r], x2 = acc[nb + 2][r];
                    out[(size_t)row * 64 + ropepos(i)] = (bf16_t)f2bf(x1 * cs.x - x2 * cs.y); out[(size_t)row * 64 + ropepos(i + 32)] = (bf16_t)f2bf(x2 * cs.x + x1 * cs.y); }
            } else {
#pragma unroll
                for (int nb = 0; nb < 4; ++nb) out[(size_t)row * 64 + nb * 16 + fr] = (bf16_t)f2bf(acc[nb][r]); } }
    }
}

#ifdef DBG_TIME
#define PSTAMP(k) do { if (F.vcu == 0 && F.tid == 0) ((unsigned long long*)(F.ws + 131072))[k] = __builtin_amdgcn_s_memrealtime(); } while (0)
#define PSTAMP1(k) do { if (F.vcu == 1 && F.tid == 0) ((unsigned long long*)(F.ws + 131072))[k] = __builtin_amdgcn_s_memrealtime(); } while (0)
#else
#define PSTAMP(k) do {} while (0)
#define PSTAMP1(k) do {} while (0)
#endif
namespace att {
constexpr int XSLOT = 143360;
constexpr int KV0 = 0, SLOTB = 16384, NSLOT = 4, IMP = 65536, IMPLD = 65, OST = 65536, WSF = 135168, SEL = 137216, UNI = 137728, IMPL = 137792;
constexpr float THR = 8.f;
__device__ __forceinline__ int crow(int r, int hi) { return (r & 3) + 8 * (r >> 2) + 4 * hi; }
__device__ __forceinline__ s16x4 vtr(const LAS char* p) { return __builtin_bit_cast(s16x4, __builtin_amdgcn_ds_read_tr16_b64_v4i16((LAS s16x4*)p)); }
__device__ __forceinline__ float swap_max(float m) { auto rr = __builtin_amdgcn_permlane32_swap(__float_as_uint(m), __float_as_uint(m), false, false); return fmaxf(__uint_as_float(rr[0]), __uint_as_float(rr[1])); }
__device__ __forceinline__ float swap_sum(float m) { auto rr = __builtin_amdgcn_permlane32_swap(__float_as_uint(m), __float_as_uint(m), false, false); return __uint_as_float(rr[0]) + __uint_as_float(rr[1]); }
__device__ __forceinline__ float swap_other(float m, int hi) { auto rr = __builtin_amdgcn_permlane32_swap(__float_as_uint(m), __float_as_uint(m), false, false); return __uint_as_float(hi ? rr[0] : rr[1]); }
__device__ __forceinline__ float rowmax32(const f32x16& p0, const f32x16& p1) {
    float a = fmaxf(p0[0], p1[0]);
#pragma unroll
    for (int r = 1; r < 16; ++r) a = fmaxf(a, fmaxf(p0[r], p1[r]));
    return swap_max(a);
}
__device__ __forceinline__ void tile_dma(const bf16_t* Kg, const bf16_t* Vg, int row0, LAS char* slot, int wid, int lane) {
    unsigned koff = (unsigned)(lane * 64 + wid * 8) * 2u;
    unsigned voff = (unsigned)((16 * (wid & 3) + (lane >> 2)) * 64 + (wid >> 2) * 32 + (lane & 3) * 8) * 2u;
    asm volatile("" : "+v"(koff), "+v"(voff));
    const char* kbase = (const char*)Kg + (size_t)row0 * 128; const char* vbase = (const char*)Vg + (size_t)row0 * 128;
    __builtin_amdgcn_global_load_lds((const unsigned*)(kbase + koff), (LAS unsigned*)(slot + wid * 1024), 16, 0, 0);
    __builtin_amdgcn_global_load_lds((const unsigned*)(vbase + voff), (LAS unsigned*)(slot + 8192 + wid * 1024), 16, 0, 0);
}
#define ATT_WAIT_V(n) asm volatile("s_waitcnt vmcnt(" #n ")" ::: "memory")
__device__ __forceinline__ void qkt(f32x16& p0, f32x16& p1, const LAS char* kslot, const bf16x8 (&qr)[4], int r32, int hi, const f32x16& cinit) {
    const LAS char* kb = kslot + hi * 1024 + r32 * 16;
    p0 = cinit; p1 = cinit;
#pragma unroll
    for (int d0 = 0; d0 < 4; ++d0) { const bf16x8 b0 = *(const LAS bf16x8*)(kb + d0 * 2048), b1 = *(const LAS bf16x8*)(kb + d0 * 2048 + 512);
        p0 = __builtin_amdgcn_mfma_f32_32x32x16_bf16(b0, qr[d0], p0, 0, 0, 0); p1 = __builtin_amdgcn_mfma_f32_32x32x16_bf16(b1, qr[d0], p1, 0, 0, 0); }
}
__device__ __forceinline__ bf16x8 pack8(const f32x16& p, int base) {
    u32x4 w; w.x = cvt_pk_bf16(p[base], p[base + 1]); w.y = cvt_pk_bf16(p[base + 2], p[base + 3]); w.z = cvt_pk_bf16(p[base + 4], p[base + 5]); w.w = cvt_pk_bf16(p[base + 6], p[base + 7]);
    return __builtin_bit_cast(bf16x8, w);
}
__device__ __forceinline__ void pv(f32x16 (&o)[2], const LAS char* vslot, const bf16x8 (&pa)[4], int lane, int hi) {
    const LAS char* vb = vslot + ((lane >> 4) & 1) * 32 + (lane & 3) * 8 + (4 * hi + ((lane & 15) >> 2)) * 64;
#pragma unroll
    for (int dh = 0; dh < 2; ++dh) {
#pragma unroll
        for (int ks = 0; ks < 4; ++ks) { const s16x4 lo = vtr(vb + dh * 4096 + ks * 1024), hh = vtr(vb + dh * 4096 + ks * 1024 + 512);
            const bf16x8 vf = (bf16x8){lo[0], lo[1], lo[2], lo[3], hh[0], hh[1], hh[2], hh[3]};
            o[dh] = __builtin_amdgcn_mfma_f32_32x32x16_bf16(pa[ks], vf, o[dh], 0, 0, 0); } }
}
__device__ __forceinline__ void kmask(f32x16& p0, f32x16& p1, int klo, int khi, int hi) {
#pragma unroll
    for (int r = 0; r < 16; ++r) { const int k0 = crow(r, hi); if (k0 < klo || k0 > khi) p0[r] = -INFINITY; if (k0 + 32 < klo || k0 + 32 > khi) p1[r] = -INFINITY; }
}
__device__ __forceinline__ void acc_scaled(f32x16 (&ofin)[2], const f32x16 (&o)[2], volatile LAS float* wsf, float scale, int r32, int hi) {
    if (hi == 0) wsf[r32] = scale;
    asm volatile("s_waitcnt lgkmcnt(0)" ::: "memory");
#pragma unroll
    for (int r = 0; r < 16; ++r) { const float f = wsf[crow(r, hi)]; ofin[0][r] += o[0][r] * f; ofin[1][r] += o[1][r] * f; }
    asm volatile("s_waitcnt lgkmcnt(0)" ::: "memory");
}
__device__ __forceinline__ void acc_scaled_lds(LAS float* stg, const f32x16 (&o)[2], volatile LAS float* wsf, float scale, int r32, int hi) {
    if (hi == 0) wsf[r32] = scale;
    asm volatile("s_waitcnt lgkmcnt(0)" ::: "memory");
#pragma unroll
    for (int r = 0; r < 16; ++r) { const int orow = crow(r, hi); const float f = wsf[orow]; stg[orow * 64 + r32] += o[0][r] * f; stg[orow * 64 + 32 + r32] += o[1][r] * f; }
    asm volatile("s_waitcnt lgkmcnt(0)" ::: "memory");
}
__device__ __forceinline__ void qk_half(f32x16& p, const LAS char* kb, const bf16x8 (&qr)[4], const bf16x8& kone, const bf16x8& qa) {
    p = __builtin_amdgcn_mfma_f32_32x32x16_bf16(kone, qa, (f32x16){}, 0, 0, 0);
#pragma unroll
    for (int d0 = 0; d0 < 4; ++d0) p = __builtin_amdgcn_mfma_f32_32x32x16_bf16(*(const LAS bf16x8*)(kb + d0 * 2048), qr[d0], p, 0, 0, 0);
}
__device__ __forceinline__ float rowmax16(const f32x16& p) {
    float a = fmaxf(p[0], p[1]);
#pragma unroll
    for (int r = 2; r < 16; r += 2) a = fmaxf(a, fmaxf(p[r], p[r + 1]));
    return swap_max(a);
}
#define ATT_TR(dst, off) asm volatile("ds_read_b64_tr_b16 %0, %1 offset:%2" : "=&v"(dst) : "v"(vb), "i"(off) : "memory")
template <int HF>
__device__ __forceinline__ void pv_half(f32x16 (&o)[2], const LAS char* vb, const bf16x8& pa0, const bf16x8& pa1) {
    s16x4 l0, h0, l1, h1, l2, h2, l3, h3;
    ATT_TR(l0, (2 * HF) * 1024); ATT_TR(h0, (2 * HF) * 1024 + 512); ATT_TR(l1, (2 * HF + 1) * 1024); ATT_TR(h1, (2 * HF + 1) * 1024 + 512);
    ATT_TR(l2, 4096 + (2 * HF) * 1024); ATT_TR(h2, 4096 + (2 * HF) * 1024 + 512); ATT_TR(l3, 4096 + (2 * HF + 1) * 1024); ATT_TR(h3, 4096 + (2 * HF + 1) * 1024 + 512);
    asm volatile("s_waitcnt lgkmcnt(4)" : "+v"(l0), "+v"(h0), "+v"(l1), "+v"(h1) :: "memory");
    o[0] = __builtin_amdgcn_mfma_f32_32x32x16_bf16(pa0, (bf16x8){l0[0], l0[1], l0[2], l0[3], h0[0], h0[1], h0[2], h0[3]}, o[0], 0, 0, 0);
    o[0] = __builtin_amdgcn_mfma_f32_32x32x16_bf16(pa1, (bf16x8){l1[0], l1[1], l1[2], l1[3], h1[0], h1[1], h1[2], h1[3]}, o[0], 0, 0, 0);
    asm volatile("s_waitcnt lgkmcnt(0)" : "+v"(l2), "+v"(h2), "+v"(l3), "+v"(h3) :: "memory");
    o[1] = __builtin_amdgcn_mfma_f32_32x32x16_bf16(pa0, (bf16x8){l2[0], l2[1], l2[2], l2[3], h2[0], h2[1], h2[2], h2[3]}, o[1], 0, 0, 0);
    o[1] = __builtin_amdgcn_mfma_f32_32x32x16_bf16(pa1, (bf16x8){l3[0], l3[1], l3[2], l3[3], h3[0], h3[1], h3[2], h3[3]}, o[1], 0, 0, 0);
}
template <int MODE>
__device__ __forceinline__ void branch(LAS float* stg, const bf16_t* Kg, const bf16_t* Vg, int dj, u64 rest, int tj, u64 selmask, float gate, int qq,
                                       const bf16x8 (&qr)[4], LAS char* lds, int wid, int lane, int r32, int hi, LAS char* slot0) {
    volatile LAS float* wsf = (volatile LAS float*)(lds + WSF) + wid * 64;
    f32x16 o[2]; o[0] = (f32x16){}; o[1] = (f32x16){};
    float m = 0.f, l = 0.f;
    const int total = 1 + __builtin_popcountll(rest);
    const unsigned onem = hi == 0 ? 0x3F803F80u : 0u;
    const bf16x8 kone = __builtin_bit_cast(bf16x8, (u32x4){onem, onem & 0xffffu, 0u, 0u});
    u32x4 qaw = (u32x4){0u, 0u, 0u, 0u};
    int j0 = dj, j1 = 0, j2 = 0;
    if (total > 1) { j1 = __builtin_ctzll(rest); rest &= rest - 1ull; tile_dma(Kg, Vg, j1 * 64, lds + KV0 + SLOTB, wid, lane); }
#pragma unroll 1
    for (int i = 0; i < total; ++i) {
        if (i + 2 < total) { j2 = __builtin_ctzll(rest); rest &= rest - 1ull; tile_dma(Kg, Vg, j2 * 64, lds + KV0 + ((i + 2) & 3) * SLOTB, wid, lane); }
        const int ahead = (total - 1 - i) < 2 ? (total - 1 - i) : 2;
        if (ahead == 2) ATT_WAIT_V(4); else if (ahead == 1) ATT_WAIT_V(2); else ATT_WAIT_V(0);
        __builtin_amdgcn_s_barrier(); asm volatile("" ::: "memory");
        const int cj = j0;
        const LAS char* ks = i == 0 ? slot0 : lds + KV0 + (i & 3) * SLOTB;
        const LAS char* kb = ks + hi * 1024 + r32 * 16;
        const LAS char* vb = ks + 8192 + ((lane >> 4) & 1) * 32 + (lane & 3) * 8 + (4 * hi + ((lane & 15) >> 2)) * 64;
        if (MODE == 0 && i > 0) qaw[1] = (hi == 0 && !((selmask >> cj) & 1ull)) ? 0x0000C6EAu : 0u;
        const bf16x8 qa = __builtin_bit_cast(bf16x8, qaw);
        f32x16 p0, p1; qk_half(p0, kb, qr, kone, qa); __builtin_amdgcn_sched_barrier(0); qk_half(p1, kb + 512, qr, kone, qa);
        if (i == 0) {
            kmask(p0, p1, 0, qq, hi);
            const float rm = rowmax32(p0, p1);
            const unsigned mh = f2bf(-rm); const float mhf = __builtin_bit_cast(float, mh << 16); const unsigned ml = f2bf(-rm - mhf);
            m = -(mhf + __builtin_bit_cast(float, ml << 16));
            qaw[0] = hi == 0 ? (mh | (ml << 16)) : 0u;
#pragma unroll
            for (int r = 0; r < 16; ++r) { p0[r] -= m; p1[r] -= m; }
        } else if (MODE == 1 && cj == tj) kmask(p0, p1, qq + 1, 63, hi);
        {
            const float rm = rowmax32(p0, p1);
            if (i > 0 && __any(rm > THR)) {
                const float mt = m + fmaxf(rm, 0.f);
                const unsigned mh = f2bf(-mt); const float mhf = __builtin_bit_cast(float, mh << 16); const unsigned ml = f2bf(-mt - mhf);
                const float mn = -(mhf + __builtin_bit_cast(float, ml << 16)), dl = mn - m, f = fast_exp2(-dl);
                m = mn; l *= f; qaw[0] = hi == 0 ? (mh | (ml << 16)) : 0u;
                if (hi == 0) wsf[r32] = f;
                asm volatile("s_waitcnt lgkmcnt(0)" ::: "memory");
#pragma unroll
                for (int r = 0; r < 16; ++r) { const float ff = wsf[crow(r, hi)]; o[0][r] *= ff; o[1][r] *= ff; p0[r] -= dl; p1[r] -= dl; }
                asm volatile("s_waitcnt lgkmcnt(0)" ::: "memory"); }
#pragma unroll
            for (int r = 0; r < 16; ++r) p0[r] = fast_exp2(p0[r]);
            { const bf16x8 pa0 = pack8(p0, 0), pa1 = pack8(p0, 8); pv_half<0>(o, vb, pa0, pa1); }
#pragma unroll
            for (int r = 0; r < 16; ++r) p1[r] = fast_exp2(p1[r]);
            { const bf16x8 pa2 = pack8(p1, 0), pa3 = pack8(p1, 8); pv_half<1>(o, vb, pa2, pa3); }
            float s0 = (p0[0] + p0[1]) + (p0[2] + p0[3]), s1 = (p0[4] + p0[5]) + (p0[6] + p0[7]), s2 = (p0[8] + p0[9]) + (p0[10] + p0[11]), s3 = (p0[12] + p0[13]) + (p0[14] + p0[15]);
            s0 += (p1[0] + p1[1]) + (p1[2] + p1[3]); s1 += (p1[4] + p1[5]) + (p1[6] + p1[7]); s2 += (p1[8] + p1[9]) + (p1[10] + p1[11]); s3 += (p1[12] + p1[13]) + (p1[14] + p1[15]);
            l += (s0 + s1) + (s2 + s3);
        }
        j0 = j1; j1 = j2;
    }
    asm volatile("s_waitcnt lgkmcnt(0)" ::: "memory");
    __builtin_amdgcn_s_barrier(); asm volatile("" ::: "memory");
    const float lt = swap_sum(l);
    acc_scaled_lds(stg, o, wsf, gate / lt, r32, hi);
}

__device__ __forceinline__ void unit(Frame& F, int b, int g, int qb) {
    LAS char* lds = (LAS char*)F.lds;
    const int lane = F.lane, wid = F.wave, r32 = lane & 31, hi = lane >> 5;
    const int hl = wid >> 1, h = g * 4 + hl, qq = (wid & 1) * 32 + r32, t = qb * 64 + qq;
    const size_t kvoff = (size_t)(b * NG + g) * SEQ * HD;
    bf16x8 qr[4];
    { const char* qbase = (const char*)(WSP(bf16_t, WS_Q) + ((size_t)(b * NH + h) * SEQ + qb * 64) * HD);
      unsigned qoff = (unsigned)(qq * HD + hi * 8) * 2u; asm volatile("" : "+v"(qoff));
#pragma unroll
      for (int d0 = 0; d0 < 4; ++d0) qr[d0] = *(const bf16x8*)(qbase + qoff + d0 * 32); }
    float g0, g1, g2;
    { const char* gbase = (const char*)(WSP(float, WS_GN) + ((size_t)b * SEQ + qb * 64) * 64 + h); unsigned goff = (unsigned)qq * 256u; asm volatile("" : "+v"(goff));
      g0 = *(const float*)(gbase + goff); g1 = *(const float*)(gbase + goff + 64); g2 = *(const float*)(gbase + goff + 128); }
    volatile LAS float* wsf = (volatile LAS float*)(lds + WSF) + wid * 64;
    f32x16 ofin[2]; ofin[0] = (f32x16){}; ofin[1] = (f32x16){};

    {
        const bf16_t* Kc = WSP(bf16_t, WS_KCMP) + (size_t)(b * NG + g) * 256 * HD; const bf16_t* Vc = WSP(bf16_t, WS_VCMP) + (size_t)(b * NG + g) * 256 * HD;
        const int nct = (4 * qb + 2) / 64 + 1;
        const int cmax = (t >= 31) ? ((t - 31) >> 4) : -1;
        float m = -INFINITY; const f32x16 zero16 = (f32x16){};
        for (int T = 0; T < nct; ++T) tile_dma(Kc, Vc, T * 64, lds + KV0 + T * SLOTB, wid, lane);
        ATT_WAIT_V(0);
        __builtin_amdgcn_s_barrier(); asm volatile("" ::: "memory");
        for (int T = 0; T < nct; ++T) {
            f32x16 p0, p1; qkt(p0, p1, lds + KV0 + T * SLOTB, qr, r32, hi, zero16);
            if (!__all(cmax - T * 64 >= 63)) kmask(p0, p1, 0, cmax - T * 64, hi);
            m = fmaxf(m, rowmax32(p0, p1));
        }
        if (m == -INFINITY) m = 0.f;
        f32x16 o[2]; o[0] = (f32x16){}; o[1] = (f32x16){}; float l = 0.f, prev_last = 0.f;
        LAS float* impl = (LAS float*)(lds + IMP) + (size_t)(hl * 64 + qq) * IMPLD;
#pragma unroll 1
        for (int T = 0; T < nct; ++T) {
            f32x16 p0, p1; qkt(p0, p1, lds + KV0 + T * SLOTB, qr, r32, hi, zero16);
            if (!__all(cmax - T * 64 >= 63)) kmask(p0, p1, 0, cmax - T * 64, hi);
            float s = 0.f;
#pragma unroll
            for (int r = 0; r < 16; ++r) { p0[r] = fast_exp2(p0[r] - m); p1[r] = fast_exp2(p1[r] - m); s += p0[r] + p1[r]; }
            l += s;
            { bf16x8 pa[4]; pa[0] = pack8(p0, 0); pa[1] = pack8(p0, 8); pa[2] = pack8(p1, 0); pa[3] = pack8(p1, 8); pv(o, lds + KV0 + T * SLOTB + 8192, pa, lane, hi); }
#pragma unroll
            for (int hf = 0; hf < 2; ++hf)
#pragma unroll
                for (int a = 0; a < 4; ++a) { const float e0 = hf ? p1[4 * a] : p0[4 * a], e1 = hf ? p1[4 * a + 1] : p0[4 * a + 1], e2 = hf ? p1[4 * a + 2] : p0[4 * a + 2], e3 = hf ? p1[4 * a + 3] : p0[4 * a + 3];
                    const float send = hi ? prev_last : e3;
                    impl[2 * (8 * T + 4 * hf + a) + hi] = ((e0 + e1) + (e2 + e3)) + swap_other(send, hi);
                    prev_last = e3; }
        }
        const float lt = swap_sum(l), inv = lt > 0.f ? 1.f / lt : 0.f;
        if (hi == 0) ((LAS float*)(lds + IMPL))[hl * 64 + qq] = inv;
        acc_scaled(ofin, o, wsf, g0 * inv, r32, hi);
    }
    __syncthreads();
    tile_dma(WSP(bf16_t, WS_KW) + kvoff, WSP(bf16_t, WS_VW) + kvoff, qb * 64, lds + XSLOT, wid, lane);
    tile_dma(WSP(bf16_t, WS_KS) + kvoff, WSP(bf16_t, WS_VS) + kvoff, qb * 64, lds + KV0, wid, lane);
    {
        u64 un = 0ull; const LAS float* impb = (const LAS float*)(lds + IMP);
        for (int i = 0; i < 8; ++i) { const int q = wid * 8 + i;
            const LAS float* il = (const LAS float*)(lds + IMPL);
            float v = ((impb[(0 * 64 + q) * IMPLD + lane] * il[q] + impb[(1 * 64 + q) * IMPLD + lane] * il[64 + q]) + impb[(2 * 64 + q) * IMPLD + lane] * il[128 + q]) + impb[(3 * 64 + q) * IMPLD + lane] * il[192 + q];
            if (lane > qb) v = 0.f;
            unsigned key = (__float_as_uint(v) & ~63u) | (unsigned)(63 - lane);
            if (lane == 0 || lane == qb || lane == qb - 1) key = 0xFFFFFFC0u | (unsigned)(63 - lane); else if (lane > qb) key = (unsigned)(63 - lane);
            volatile LAS unsigned* kq = (volatile LAS unsigned*)(lds + WSF) + wid * 64;
            kq[lane] = key;
            asm volatile("s_waitcnt lgkmcnt(0)" ::: "memory");
            int rank = 0;
#pragma unroll
            for (int c = 0; c < 16; ++c) { const u32x4 kk = *(const LAS u32x4*)((const LAS unsigned*)(lds + WSF) + wid * 64 + 4 * c); rank += (kk.x > key ? 1 : 0) + (kk.y > key ? 1 : 0) + (kk.z > key ? 1 : 0) + (kk.w > key ? 1 : 0); }
            asm volatile("s_waitcnt lgkmcnt(0)" ::: "memory");
            const u64 mk = __ballot(rank < 16);
            if (lane == 0) *(LAS u64*)(lds + SEL + q * 8) = mk;
            un |= mk; }
        if (lane == 0) *(LAS u64*)(lds + UNI + wid * 8) = un;
    }
    __syncthreads();
    LAS float* stg = (LAS float*)(lds + OST) + wid * 2048;
#pragma unroll
    for (int r = 0; r < 16; ++r) { const int orow = crow(r, hi); stg[orow * 64 + r32] = ofin[0][r]; stg[orow * 64 + 32 + r32] = ofin[1][r]; }
    const u64 selmask = *(const LAS u64*)(lds + SEL + qq * 8);
    u64 uni = 0ull;
#pragma unroll
    for (int i = 0; i < 8; ++i) uni |= *(const LAS u64*)(lds + UNI + i * 8);
    uni = ((u64)(unsigned)__builtin_amdgcn_readfirstlane((int)(uni >> 32)) << 32) | (u64)(unsigned)__builtin_amdgcn_readfirstlane((int)(uni & 0xffffffffull));
    const u64 below = (qb == 0) ? 0ull : ((1ull << qb) - 1ull);
    branch<0>(stg, WSP(bf16_t, WS_KS) + kvoff, WSP(bf16_t, WS_VS) + kvoff, qb, uni & below, -1, selmask, g1, qq, qr, lds, wid, lane, r32, hi, lds + KV0);
    { const int lo = qb >= 8 ? qb - 8 : 0; const u64 wrest = below & ~((lo == 0) ? 0ull : ((1ull << lo) - 1ull));
      branch<1>(stg, WSP(bf16_t, WS_KW) + kvoff, WSP(bf16_t, WS_VW) + kvoff, qb, wrest, qb >= 8 ? qb - 8 : -1, 0ull, g2, qq, qr, lds, wid, lane, r32, hi, lds + XSLOT); }
    { asm volatile("s_waitcnt lgkmcnt(0)" ::: "memory");
      char* obase = (char*)(WSP(bf16_t, WS_AO) + ((size_t)b * SEQ + qb * 64 + (wid & 1) * 32) * DM + 1024 + h * 64);
#pragma unroll
      for (int i = 0; i < 4; ++i) { const int row = i * 8 + (lane >> 3), ch = lane & 7; const f32x4 v0 = *(const LAS f32x4*)(stg + row * 64 + ch * 8), v1 = *(const LAS f32x4*)(stg + row * 64 + ch * 8 + 4); unsigned ooff = (unsigned)(row * DM + ch * 8) * 2u; asm volatile("" : "+v"(ooff)); store8((bf16_t*)(obase + ooff), v0, v1); } }
    __syncthreads();
}
__device__ __forceinline__ void phase(Frame& F) {
    for (int L = F.vcu; L < 256; L += F.G) { const int bg = L >> 4, s = L & 15;
        for (int i = 0; i < 4; ++i) { const int qb = (i == 0) ? s : (i == 1) ? 31 - s : (i == 2) ? 32 + s : 63 - s; unit(F, bg >> 2, bg & 3, qb); } }
}
#ifndef CONV_P1_ITEMS
#define CONV_P1_ITEMS (64 * 8 * 14)
#endif
#ifndef CONV_P2_ITEMS
#define CONV_P2_ITEMS (192 * 8 * 3)
#endif
#ifndef CONV_EVERY
#define CONV_EVERY 2
#endif
__device__ __forceinline__ void phase_dyn(Frame& F, unsigned* ctl) {
    if ((F.vcu & 1) && (F.vcu & 7) != 7) { p0_transposes(F, p0c::NSMALL + CONV_P1_ITEMS + CONV_P2_ITEMS, p0c::NITEMS, ((F.vcu >> 3) * 3 + ((F.vcu & 7) >> 1)) * 8 + F.wave, 96 * 8); __syncthreads();
#ifdef DBG_TIME
        if (F.vcu == CONV_EVERY - 1 && F.tid == 0) ((unsigned long long*)(F.ws + 131072))[13] = __builtin_amdgcn_s_memrealtime();
#endif
    }
    volatile LAS unsigned* slot = (volatile LAS unsigned*)(F.lds + MISC_OFF) + 24;
    const int q0 = F.vcu >> 5;
#pragma unroll 1
    for (int qi = 0; qi < 8; ++qi) { const int q = (q0 + qi) & 7;
#pragma unroll 1
        for (;;) {
            if (F.tid == 0) { unsigned u = 128u; if (qi == 0 || xb_ld(ctl + CW_ATQ + q) < 128u) u = xb_add(ctl + CW_ATQ + q, 1u); *slot = u; }
            __syncthreads();
            const int u = __builtin_amdgcn_readfirstlane((int)*slot);
            __syncthreads();
            if (u >= 128) break;
            const int bg = 2 * q + (u & 1), qb = 63 - (u >> 1);
            unit(F, bg >> 2, bg & 3, qb);
        }
    }
}
}

__device__ __forceinline__ void p7_router(Frame& F, unsigned* ctl) {
    constexpr int CLD = 260;
    LAS float* chunk = (LAS float*)F.lds;
    LAS float* slab = (LAS float*)F.lds;
    LAS float* lgs = (LAS float*)(F.lds + 81920);
    LAS float* st = (LAS float*)(F.lds + 110592);
    const int tid = F.tid, lane = F.lane, wid = F.wave, fr = lane & 15, kg = lane >> 4;
    const bf16_t* V1B = WSP(bf16_t, WS_V1B); const float* g1 = F.in[13]; const float* b1 = F.in[14];
    bf16_t* H1B = WSP(bf16_t, WS_H1B); const float* PS = WSP(float, WS_PS);
    const bf16_t* WRH = WSP(bf16_t, WS_WRH); const bf16_t* WRL = WSP(bf16_t, WS_WRL);
    for (int ub = F.vcu; ub < NT / 64; ub += F.G) {
        const int m0 = ub * 64;
        if (tid < 64) { const float* pr = PS + (size_t)(m0 + tid) * 64; float sv = 0.f, qv = 0.f;
#pragma unroll
            for (int j = 0; j < 16; ++j) { const f32x4 t4 = *(const f32x4*)(pr + j * 4); sv += t4[0] + t4[2]; qv += t4[1] + t4[3]; }
            const float mean = sv * (1.f / DM), var = fmaxf(qv * (1.f / DM) - mean * mean, 0.f);
            st[tid * 2] = mean; st[tid * 2 + 1] = 1.f / sqrtf(var + LN_EPS); }
        __syncthreads();
        PSTAMP(14);
        float mu[4], rsd[4];
#pragma unroll
        for (int rg = 0; rg < 4; ++rg) { mu[rg] = st[(rg * 16 + fr) * 2]; rsd[rg] = st[(rg * 16 + fr) * 2 + 1]; }
        f32x4 acc[4][5];
#pragma unroll
        for (int rg = 0; rg < 4; ++rg)
#pragma unroll
            for (int nb = 0; nb < 5; ++nb) acc[rg][nb] = (f32x4){0.f, 0.f, 0.f, 0.f};
        const bf16_t* xl = V1B + (size_t)(m0 + fr) * DM + wid * 32 + kg * 8;
        bf16_t* hl = H1B + (size_t)(m0 + fr) * DM + wid * 32 + kg * 8;
        u32x4 xv[4];
#pragma unroll
        for (int rg = 0; rg < 4; ++rg) xv[rg] = *(const u32x4*)(xl + (size_t)rg * 16 * DM);
#pragma unroll 1
        for (int c = 0; c < 8; ++c) {
            const int k0 = c * 256, kn = (c < 7 ? c + 1 : 7) * 256, kk = k0 + wid * 32 + kg * 8;
            bf16x8 Bh[5], Bl[5];
#pragma unroll
            for (int nb = 0; nb < 5; ++nb) { const size_t fo = ((size_t)((c * 8 + wid) * 5 + nb) * 64 + lane) * 8; Bh[nb] = *(const bf16x8*)(WRH + fo); Bl[nb] = *(const bf16x8*)(WRL + fo); }
            const f32x4 ga0 = *(const f32x4*)(g1 + kk), ga1 = *(const f32x4*)(g1 + kk + 4), be0 = *(const f32x4*)(b1 + kk), be1 = *(const f32x4*)(b1 + kk + 4);
            u32x4 xn[4];
#pragma unroll
            for (int rg = 0; rg < 4; ++rg) xn[rg] = *(const u32x4*)(xl + (size_t)rg * 16 * DM + kn);
#pragma unroll
            for (int rg = 0; rg < 4; ++rg) { const u32x4 q = xv[rg];
                const f32x4 x0 = (f32x4){bflo(q.x), bfhi(q.x), bflo(q.y), bfhi(q.y)}, x1 = (f32x4){bflo(q.z), bfhi(q.z), bflo(q.w), bfhi(q.w)};
                const f32x4 h0 = (x0 - mu[rg]) * rsd[rg] * ga0 + be0, h1 = (x1 - mu[rg]) * rsd[rg] * ga1 + be1;
                u32x4 ah, al;
                ah.x = cvt_pk_bf16(h0[0], h0[1]); ah.y = cvt_pk_bf16(h0[2], h0[3]); ah.z = cvt_pk_bf16(h1[0], h1[1]); ah.w = cvt_pk_bf16(h1[2], h1[3]);
                *(u32x4*)(hl + (size_t)rg * 16 * DM + k0) = ah;
                al.x = cvt_pk_bf16(h0[0] - bflo(ah.x), h0[1] - bfhi(ah.x)); al.y = cvt_pk_bf16(h0[2] - bflo(ah.y), h0[3] - bfhi(ah.y));
                al.z = cvt_pk_bf16(h1[0] - bflo(ah.z), h1[1] - bfhi(ah.z)); al.w = cvt_pk_bf16(h1[2] - bflo(ah.w), h1[3] - bfhi(ah.w));
                const bf16x8 Ah = __builtin_bit_cast(bf16x8, ah), Al = __builtin_bit_cast(bf16x8, al);
#pragma unroll
                for (int nb = 0; nb < 5; ++nb) { acc[rg][nb] = __builtin_amdgcn_mfma_f32_16x16x32_bf16(Ah, Bh[nb], acc[rg][nb], 0, 0, 0); acc[rg][nb] = __builtin_amdgcn_mfma_f32_16x16x32_bf16(Al, Bh[nb], acc[rg][nb], 0, 0, 0); acc[rg][nb] = __builtin_amdgcn_mfma_f32_16x16x32_bf16(Ah, Bl[nb], acc[rg][nb], 0, 0, 0); } }
#pragma unroll
            for (int rg = 0; rg < 4; ++rg) xv[rg] = xn[rg];
        }
        PSTAMP(15);
        if (wid < 4) {
#pragma unroll
            for (int rg = 0; rg < 4; ++rg)
#pragma unroll
                for (int nb = 0; nb < 5; ++nb)
#pragma unroll
                    for (int r = 0; r < 4; ++r) slab[(wid * 64 + rg * 16 + 4 * kg + r) * 80 + nb * 16 + fr] = acc[rg][nb][r]; }
        __syncthreads();
        if (wid >= 4) {
#pragma unroll
            for (int rg = 0; rg < 4; ++rg)
#pragma unroll
                for (int nb = 0; nb < 5; ++nb)
#pragma unroll
                    for (int r = 0; r < 4; ++r) slab[((wid - 4) * 64 + rg * 16 + 4 * kg + r) * 80 + nb * 16 + fr] += acc[rg][nb][r]; }
        __syncthreads();
        for (int idx = tid; idx < 64 * 80; idx += 512) lgs[idx] = (slab[idx] + slab[64 * 80 + idx]) + (slab[2 * 64 * 80 + idx] + slab[3 * 64 * 80 + idx]);
        __syncthreads();
        if (tid < 64) { const int m = m0 + tid;
            const float* gb = F.in[16]; const float* eb = F.in[18];
            float gl[8]; int grp = 0; float gmax = -INFINITY;
#pragma unroll
            for (int i = 0; i < 8; ++i) { gl[i] = lgs[tid * 80 + i] + gb[i]; if (gl[i] > gmax) { gmax = gl[i]; grp = i; } }
            float gs = 0.f;
#pragma unroll
            for (int i = 0; i < 8; ++i) gs += __expf(gl[i] - gmax);
            const float ggate = 1.f / gs;
            float el[8];
#pragma unroll
            for (int i = 0; i < 8; ++i) el[i] = lgs[tid * 80 + 8 + grp * 8 + i] + eb[grp * 8 + i];
            int i0 = 0; float v0 = -INFINITY;
#pragma unroll
            for (int i = 0; i < 8; ++i) if (el[i] > v0) { v0 = el[i]; i0 = i; }
            int i1 = 0; float v1 = -INFINITY;
#pragma unroll
            for (int i = 0; i < 8; ++i) if (i != i0 && el[i] > v1) { v1 = el[i]; i1 = i; }
            const float e1 = __expf(v1 - v0), w0 = ggate / (1.f + e1), w1 = ggate * e1 / (1.f + e1);
            const int ea = grp * 8 + i0, ebx = grp * 8 + i1;
            const unsigned pa = __hip_atomic_fetch_add(ctl + CW_CNT + 16 * ea, 1u, RLX_AGENT), pb = __hip_atomic_fetch_add(ctl + CW_CNT + 16 * ebx, 1u, RLX_AGENT);
            int* elist = WSP(int, WS_ELIST); float* ewt = WSP(float, WS_EWT);
            elist[(size_t)ea * NT + pa] = m * 2; ewt[(size_t)ea * NT + pa] = w0; elist[(size_t)ebx * NT + pb] = m * 2 + 1; ewt[(size_t)ebx * NT + pb] = w1; }
        __syncthreads();
        PSTAMP(16);
    }
}
__device__ __forceinline__ int expert_tables(Frame& F, unsigned* ctl, MoeTab& T) {
    LAS int* tb = (LAS int*)(F.lds + TAB_OFF + 256); LAS int* cn = tb + 64; LAS int* texp = cn + 64; LAS int* ntl = texp + 200;
    __syncthreads();
    if (F.tid < 64) { const int e = F.tid; const int c = (int)__hip_atomic_load(ctl + CW_CNT + 16 * e, RLX_AGENT); const int nt = (c + 255) >> 8;
        int pre = nt;
#pragma unroll
        for (int o = 1; o < 64; o <<= 1) { const int x = __shfl_up(pre, o); if (e >= o) pre += x; }
        const int base = pre - nt; tb[e] = base; cn[e] = c;
        for (int i = 0; i < nt; ++i) texp[base + i] = e;
        if (e == 63) ntl[0] = pre; }
    __syncthreads();
    T.texp = texp; T.tb = tb; T.cn = cn; T.elist = WSP(const int, WS_ELIST); T.ewt = WSP(const float, WS_EWT);
    return ntl[0];
}
__device__ __forceinline__ void p11_final(Frame& F) {
    const int gw = F.vcu * 8 + F.wave, NGW = F.G * 8, lane = F.lane;
    const float* g2 = F.in[22]; const float* b2 = F.in[23];
    const bf16_t* H1B = WSP(bf16_t, WS_H1B); const bf16_t* YB = WSP(bf16_t, WS_YB); float* out = F.out;
    for (int mp = gw * 2; mp < NT; mp += NGW * 2) {
        f32x4 v[2][8]; float mu[2], rs[2];
#pragma unroll
        for (int rr = 0; rr < 2; ++rr) { const int m = mp + rr;
            const bf16_t* hr = H1B + (size_t)m * DM; const bf16_t* y0 = YB + (size_t)(2 * m) * DM; const bf16_t* y1 = y0 + DM;
#pragma unroll
            for (int j = 0; j < 4; ++j) { const int c = j * 512 + lane * 8; f32x4 a0, a1, c0, c1, h0, h1; load8(y0 + c, a0, a1); load8(y1 + c, c0, c1); load8(hr + c, h0, h1);
                v[rr][2 * j] = h0 * DN_ALPHA + (a0 + c0); v[rr][2 * j + 1] = h1 * DN_ALPHA + (a1 + c1); } }
#pragma unroll
        for (int rr = 0; rr < 2; ++rr) { float s = 0.f;
#pragma unroll
            for (int j = 0; j < 8; ++j) s += (v[rr][j][0] + v[rr][j][1]) + (v[rr][j][2] + v[rr][j][3]);
            mu[rr] = wave_sum(s) * (1.f / DM); float q = 0.f;
#pragma unroll
            for (int j = 0; j < 8; ++j) { v[rr][j] = v[rr][j] - mu[rr]; q += (v[rr][j][0] * v[rr][j][0] + v[rr][j][1] * v[rr][j][1]) + (v[rr][j][2] * v[rr][j][2] + v[rr][j][3] * v[rr][j][3]); }
            rs[rr] = 1.f / sqrtf(wave_sum(q) * (1.f / DM) + LN_EPS); }
#pragma unroll
        for (int rr = 0; rr < 2; ++rr) { const int m = mp + rr;
#pragma unroll
            for (int j = 0; j < 4; ++j) { const int c = j * 512 + lane * 8;
                *(f32x4*)(out + (size_t)m * DM + c) = v[rr][2 * j] * rs[rr] * *(const f32x4*)(g2 + c) + *(const f32x4*)(b2 + c);
                *(f32x4*)(out + (size_t)m * DM + c + 4) = v[rr][2 * j + 1] * rs[rr] * *(const f32x4*)(g2 + c + 4) + *(const f32x4*)(b2 + c + 4); } }
    }
}

__global__ void __launch_bounds__(512, 2) mk_fwd(Args args) {
    extern __shared__ __attribute__((aligned(16))) unsigned char lds_raw[];
    Frame F;
    F.lds = (LAS unsigned char*)lds_raw; F.ws = args.ws; F.in = args.in; F.out = args.out;
    F.tid = threadIdx.x; F.lane = F.tid & 63; F.wave = __builtin_amdgcn_readfirstlane(F.tid >> 6);
    F.G = gridDim.x; { const int bx = blockIdx.x; F.vcu = (F.G % 8 == 0) ? (bx % 8) * (F.G / 8) + bx / 8 : bx; }
    unsigned* ctl = (unsigned*)(args.ws + WS_CTL);
    volatile LAS unsigned* MISC = (volatile LAS unsigned*)(F.lds + MISC_OFF);
    if (F.tid < 32) MISC[F.tid] = 0u;
    __syncthreads();
    const int lo = args.ph_lo, hi = args.ph_hi;
    const bool multi = (hi - lo) > 1;
    XcdBarrier bar; bar.bar = ctl + CW_BAR; bar.x = 0; bar.st = MISC + 8;
    if (multi) { bar = xcd_barrier_post(ctl + CW_BAR, MISC + 8); if (F.tid == 0) { (void)xb_add(ctl + CW_GX + 16 * (F.vcu >> 5 & 7) + (int)bar.x, 1u); (void)xb_add(ctl + CW_GX + 16 * ((F.vcu & 3) == 0 ? 8 : 9) + (int)bar.x, 1u); } }
#ifndef PHASE_MASK
#define PHASE_MASK 0xFFF
#endif
#define IN(k) (((PHASE_MASK >> (k)) & 1) && lo <= (k) && (k) < hi)
#ifdef DBG_TIME
#ifndef DBG_TIME_B
#define DBG_TIME_B (DBG_TIME_A + 1)
#endif
#define STAMP(k) do { if (blockIdx.x == 0 && F.tid == 0) ((unsigned long long*)(args.ws + 131072))[k] = __builtin_amdgcn_s_memrealtime(); } while (0)
#else
#define STAMP(k) do {} while (0)
#endif
#ifndef MK_CG_FIRST
#define MK_CG_FIRST 0
#endif
#define SEAM(k) do { if (IN(k) && IN((k) + 1)) { if (MK_CG_FIRST && (k) == 0) { __threadfence(); cg::this_grid().sync(); } else xcd_barrier(bar); } STAMP((k) + 1); } while (0)
    LAS unsigned char* ring = F.lds;
#ifndef REPEAT_PHASE
#define REPEAT_PHASE -1
#endif
#define REPS(k) ((REPEAT_PHASE == (k)) ? 2 : 1)

    STAMP(0);
    if (IN(0)) { _Pragma("unroll 1") for (int rep_ = 0; rep_ < REPS(0); ++rep_) p0_prologue(F, !(multi && F.G == 256)); SEAM(0); }
    if (IN(1)) {
        pg8::Gemm g{DM, DM * 2, DM * 2}; RectSched S; S.init(NT, IN_PAD, F.G, (int)blockIdx.x, WSP(bf16_t, WS_XB), DM * 2, WSP(bf16_t, WS_WIN), DM * 2);
        EpiInProj E; E.U = WSP(bf16_t, WS_U); E.Q = WSP(bf16_t, WS_Q); E.KVb = WSP(bf16_t, WS_KC);
        E.GM = WSP(bf16_t, WS_GM); E.GN = WSP(float, WS_GN); E.rope = WSP(const f32x4, WS_ROPE);
        pg8::gemm_phase<EpiInProj, RectSched, true>(ring, g, S, E);
        if (REPS(1) == 2) { pg8::gemm_phase<EpiInProj, RectSched, true>(ring, g, S, E); }
        if (multi && F.G == 256 && (int)blockIdx.x >= 192) { __syncthreads(); p0_transposes(F, p0c::NSMALL, p0c::NSMALL + CONV_P1_ITEMS, ((int)blockIdx.x - 192) * 8 + F.wave, 64 * 8); }
        SEAM(1);
    }
    if (IN(2)) {
        const bool spread = multi && F.G == 256;
        const bool cmpwg = spread ? ((F.vcu & 3) == 0) : true;
        if (!spread || !cmpwg) p2_pool(F);
        __syncthreads(); PSTAMP1(17);
        if (cmpwg) {
            pg8::Gemm g{1024, 2048, 4096}; CmpSched S; S.vcu = F.vcu; S.G = F.G; S.A0 = (const char*)WSP(bf16_t, WS_KC); S.A1 = (const char*)WSP(bf16_t, WS_VC); S.B0 = (const char*)WSP(bf16_t, WS_CW1K); S.B1 = (const char*)WSP(bf16_t, WS_CW1V);
            EpiCmp1 E; E.P = WSP(float, WS_CMPP); E.bias = WSP(float, WS_CBIAS);
            pg8::gemm_phase<EpiCmp1, CmpSched, false>(ring, g, S, E); PSTAMP(20);
        }
        if (spread) {
            const bool leader = F.wave == 0 && F.lane == 0;
            if (cmpwg) { group_barrier_x(ctl, 16, 8, bar.x, 64u, leader); PSTAMP(21); p3_cmp2(F, F.vcu >> 2, 64); PSTAMP(22); }
            else { group_barrier_x(ctl, 17, 9, bar.x, 192u, leader); PSTAMP1(18);
                pg8::Gemm g{256, 2048, 512}; MixSched S; S.vcu = F.vcu - (F.vcu >> 2) - 1; S.G = 192; S.A = (const char*)WSP(bf16_t, WS_POOLED); S.B = (const char*)WSP(bf16_t, WS_PM);
                EpiMix E; E.out = WSP(bf16_t, WS_AO); E.scale = F.in[3];
                pg8::gemm_phase<EpiMix, MixSched, true>(ring, g, S, E); PSTAMP1(19);
                __syncthreads(); p0_transposes(F, p0c::NSMALL + CONV_P1_ITEMS, p0c::NSMALL + CONV_P1_ITEMS + CONV_P2_ITEMS, (F.vcu - (F.vcu >> 2) - 1) * 8 + F.wave, 192 * 8); }
            if (IN(4)) { xcd_barrier(bar); STAMP(3); STAMP(4); }
        } else SEAM(2);
    }
    if (IN(3) && !(multi && F.G == 256)) {
        pg8::Gemm g{256, 2048, 512}; MixSched S; S.vcu = F.vcu; S.G = F.G; S.A = (const char*)WSP(bf16_t, WS_POOLED); S.B = (const char*)WSP(bf16_t, WS_PM);
        EpiMix E; E.out = WSP(bf16_t, WS_AO); E.scale = F.in[3];
        pg8::gemm_phase<EpiMix, MixSched, true>(ring, g, S, E);
        p3_cmp2(F, F.vcu, F.G);
        SEAM(3);
    }
    if (IN(4)) {
        if (multi && F.G == 256) att::phase_dyn(F, ctl); else att::phase(F);
        SEAM(4);
    }
    if (IN(5)) {
        pg8::Gemm g{DM, DM * 2, DM * 2}; RectSched S; S.init(NT, DM, F.G, (int)blockIdx.x, WSP(bf16_t, WS_AO), DM * 2, WSP(bf16_t, WS_WPP), DM * 2);
        EpiZ2 E; E.Z = WSP(bf16_t, WS_Z); E.GM = WSP(bf16_t, WS_GM);
        pg8::gemm_phase<EpiZ2, RectSched, true>(ring, g, S, E);
        if (REPS(5) == 2) { pg8::gemm_phase<EpiZ2, RectSched, true>(ring, g, S, E); }
        if (multi && F.G == 256 && IN(6)) { group_barrier_x(ctl, F.vcu >> 5, F.vcu >> 5, bar.x, 32u, F.wave == 0 && F.lane == 0); STAMP(6); } else SEAM(5);
    }
    if (IN(6)) {
        pg8::Gemm g{DM, DM * 2, DM * 2}; RectSched S; S.init(NT, DM, F.G, (int)blockIdx.x, WSP(bf16_t, WS_Z), DM * 2, WSP(bf16_t, WS_WO), DM * 2);
        EpiV1 E; E.V1B = WSP(bf16_t, WS_V1B); E.x = WSP(const bf16_t, WS_XB); E.PS = WSP(float, WS_PS);
        _Pragma("unroll 1") for (int rep_ = 0; rep_ < REPS(6); ++rep_) pg8::gemm_phase<EpiV1, RectSched, true>(ring, g, S, E);
        if (multi && F.G == 256 && IN(7)) { group_barrier_x(ctl, 8 + (F.vcu >> 5), F.vcu >> 5, bar.x, 32u, F.wave == 0 && F.lane == 0); STAMP(7); } else SEAM(6);
    }
    if (IN(7)) { p7_router(F, ctl); if (IN(9)) { xcd_barrier(bar); STAMP(8); STAMP(9); } }
#ifndef KD9B
#define KD9B 3
#endif
    if (IN(9)) {
        MoeTab T; const int ntile = expert_tables(F, ctl, T);
        const int nU = 4 * ntile, nD = 8 * ntile, RA = multi ? ((nU + F.G - 1) / F.G - 1) : (nU + F.G - 1) / F.G, nA = RA * F.G < nU ? RA * F.G : nU;
        pg8::Gemm gu{DM, DM * 2, DM * 2}, gd{EH, EH * 2, EH * 2};
        MoeGatherSched<4, 1024> S; S.A = (const char*)WSP(bf16_t, WS_H1B); S.B = (const char*)WSP(bf16_t, WS_WGU); S.lda = DM * 2; S.ldb = DM * 2; S.T = T;
        EpiUp E; E.HID = WSP(bf16_t, WS_HID);
        S.v = F.vcu; S.Gp = F.G; S.L0 = 0; S.L1 = nA;
        pg8::gemm_phase<EpiUp, MoeGatherSched<4, 1024>, true, true>(ring, gu, S, E);
        if (REPS(9) == 2) { pg8::gemm_phase<EpiUp, MoeGatherSched<4, 1024>, true, true>(ring, gu, S, E); }
        if (multi && nA < nU) {
            xcd_barrier(bar);
            const int nrem = nU - nA, Gp2 = F.G - nrem, cap = (8 * (nA / 4) < nD) ? 8 * (nA / 4) : nD; int nB1 = KD9B * Gp2; if (nB1 > cap) nB1 = cap; if (nB1 < 0) nB1 = 0; int nB = nB1 + nrem; if (nB > cap) nB = cap;
            S.v = F.vcu; S.Gp = F.G; S.L0 = nA; S.L1 = nU;
            pg8::gemm_phase<EpiUp, MoeGatherSched<4, 1024>, true, true>(ring, gu, S, E);
            MoeSched<8, 2048> D; D.A = (const char*)WSP(bf16_t, WS_HID); D.B = (const char*)WSP(bf16_t, WS_WD); D.lda = EH * 2; D.ldb = EH * 2; D.T = T;
            if (F.vcu >= nrem) { D.v = F.vcu - nrem; D.Gp = Gp2; D.L0 = 0; D.L1 = nB1; } else { D.v = F.vcu; D.Gp = nrem; D.L0 = nB1; D.L1 = nB; }
            EpiDown ED; ED.YB = WSP(bf16_t, WS_YB); ED.T = T;
            pg8::gemm_phase<EpiDown, MoeSched<8, 2048>, true>(ring, gd, D, ED);
        }
        SEAM(9);
    }
    if (IN(10)) {
        MoeTab T; const int ntile = expert_tables(F, ctl, T);
        const int nU = 4 * ntile, nD = 8 * ntile, RA = multi ? ((nU + F.G - 1) / F.G - 1) : (nU + F.G - 1) / F.G, nA = RA * F.G < nU ? RA * F.G : nU;
        int nB = 0; if (multi && nA < nU) { const int nrem = nU - nA, Gp2 = F.G - nrem, cap = (8 * (nA / 4) < nD) ? 8 * (nA / 4) : nD; int nB1 = KD9B * Gp2; if (nB1 > cap) nB1 = cap; if (nB1 < 0) nB1 = 0; nB = nB1 + nrem; if (nB > cap) nB = cap; }
        pg8::Gemm g{EH, EH * 2, EH * 2}; MoeSched<8, 2048> S; S.v = F.vcu; S.Gp = F.G; S.L0 = nB; S.L1 = nD; S.A = (const char*)WSP(bf16_t, WS_HID); S.B = (const char*)WSP(bf16_t, WS_WD); S.lda = EH * 2; S.ldb = EH * 2; S.T = T;
        EpiDown E; E.YB = WSP(bf16_t, WS_YB); E.T = T;
        pg8::gemm_phase<EpiDown, MoeSched<8, 2048>, true>(ring, g, S, E);
        if (REPS(10) == 2) { pg8::gemm_phase<EpiDown, MoeSched<8, 2048>, true>(ring, g, S, E); }
        SEAM(10);
    }
    if (IN(11)) { p11_final(F); }
#ifdef DBG_TIME
    xcd_barrier(bar); STAMP(12);
    xcd_barrier(bar);
    { unsigned* mark = (unsigned*)(args.ws + WS_END + 4096);
      const bool fresh = __hip_atomic_load(mark, RLX_AGENT) == 0xAAAAAAAAu;
      const unsigned long long* st_ = (const unsigned long long*)(args.ws + 131072);
      const float ta = (float)(__hip_atomic_load(st_ + DBG_TIME_B, RLX_AGENT) - __hip_atomic_load(st_ + DBG_TIME_A, RLX_AGENT)) * 0.01f;
      const float v = fresh ? ta : 1.0f;
      for (size_t i = (size_t)blockIdx.x * 512 + F.tid; i < (size_t)NT * DM; i += (size_t)F.G * 512) F.out[i] = v;
      xcd_barrier(bar);
      if (blockIdx.x == 0 && F.tid == 0) __hip_atomic_store(mark, 0x12345678u, RLX_AGENT); }
#endif
#undef IN
#undef SEAM
}


#ifdef DBG_DUMP
__global__ void __launch_bounds__(512) dbg_dump(const unsigned char* ws, float* out) {
    const bf16_t* src = (const bf16_t*)(ws + (size_t)DBG_OFF);
    for (size_t i = (size_t)blockIdx.x * 512 + threadIdx.x; i < (size_t)NT * DM; i += (size_t)gridDim.x * 512) { const size_t m = i / DM, c = i % DM; out[i] = bf2f(src[(m % DBG_ROWS) * DBG_LD + (c % DBG_COLS)]); }
}
#endif

#ifdef DBG_CHECK
__global__ void __launch_bounds__(256) dbg_check(const float* x, const float* w_in, const unsigned char* ws, unsigned* errbits) {
    const int s = blockIdx.x * 256 + threadIdx.x;
    unsigned h = (unsigned)s * 2654435761u; h ^= h >> 15; h *= 2246822519u; h ^= h >> 13;
    const int m = h % NT; const int c = (h >> 14) % 4096;
    float acc = 0.f, accu = 0.f; const int cu = c % 1024;
    for (int k = 0; k < DM; ++k) { const float xv = x[(size_t)m * DM + k]; acc += xv * w_in[(size_t)k * IN_COLS + 3632 + c]; accu += xv * w_in[(size_t)k * IN_COLS + cu]; }
    const float ref = 1.f / (1.f + __expf(-acc));
    const float got = bf2f(((const bf16_t*)(ws + WS_GM))[(size_t)m * 4096 + c]);
    const float gotu = bf2f(((const bf16_t*)(ws + WS_U))[(size_t)m * PW + cu]);
    const float e = fabsf(got - ref), eu = fabsf(gotu - accu);
#if DBG_CHECK == 1
    if (!(eu < 0.06f)) atomicAdd(errbits, 1u);
#elif DBG_CHECK == 3
    { const int n = 3632 + c, k = (h >> 3) % DM; const float wv = w_in[(size_t)k * IN_COLS + n]; const float gw_ = bf2f(((const bf16_t*)(ws + WS_WIN))[(size_t)in_map(n) * DM + k]);
      if (!(fabsf(gw_ - wv) <= 0.01f * fabsf(wv) + 1e-6f)) atomicAdd(errbits, 1u); }
#else
    if (!(e < 0.02f)) atomicAdd(errbits, 1u);
#endif
}
__global__ void __launch_bounds__(512) dbg_fill(float* out, const unsigned* errbits) {
    const float v = 1.f + (float)(*errbits);
    for (size_t i = (size_t)blockIdx.x * 512 + threadIdx.x; i < (size_t)NT * DM; i += (size_t)gridDim.x * 512) out[i] = v;
}
#endif
extern "C" void kernel_launch(void* const* d_in, const int* in_sizes, int n_in, void* d_out, int out_size, void* d_ws, size_t ws_size, hipStream_t stream) {
    static int grid = 0;
    if (grid == 0) {
        if (n_in != 24 || out_size != NT * DM || ws_size < WS_END) { fprintf(stderr, "kernel_launch: unexpected problem (n_in %d, out %d, ws %zu < %zu)\n", n_in, out_size, ws_size, (size_t)WS_END); grid = -1; return; }
        int dev = 0, cus = 0, per_cu = 0;
        hipGetDevice(&dev); hipDeviceGetAttribute(&cus, hipDeviceAttributeMultiprocessorCount, dev);
        if (hipFuncSetAttribute((const void*)mk_fwd, hipFuncAttributeMaxDynamicSharedMemorySize, LDS_BYTES) != hipSuccess) { fprintf(stderr, "kernel_launch: hipFuncSetAttribute failed\n"); grid = -1; return; }
        if (hipOccupancyMaxActiveBlocksPerMultiprocessor(&per_cu, (const void*)mk_fwd, 512, LDS_BYTES) != hipSuccess || per_cu < 1) { fprintf(stderr, "kernel_launch: occupancy query says %d blocks per CU\n", per_cu); grid = -1; (void)hipGetLastError(); return; }
        grid = cus;
    }
    if (grid < 0) return;
    hipMemsetAsync((char*)d_ws + WS_CTL, 0, CTL_ZERO_BYTES, stream);
    Args a{};
    for (int i = 0; i < 24; ++i) a.in[i] = (const float*)d_in[i];
    a.out = (float*)d_out; a.ws = (unsigned char*)d_ws;
#if MK_PER_PHASE_LAUNCH
    for (int p = 0; p < DBG_NPH; ++p) { a.ph_lo = p; a.ph_hi = p + 1; hipLaunchKernelGGL(mk_fwd, dim3(grid), dim3(512), LDS_BYTES, stream, a); }
#ifdef DBG_CHECK
    hipMemsetAsync((char*)d_ws + 65536, 0, 4, stream);
    hipLaunchKernelGGL(dbg_check, dim3(16), dim3(256), 0, stream, (const float*)d_in[0], (const float*)d_in[1], (const unsigned char*)d_ws, (unsigned*)((char*)d_ws + 65536));
    hipLaunchKernelGGL(dbg_fill, dim3(1024), dim3(512), 0, stream, (float*)d_out, (const unsigned*)((char*)d_ws + 65536));
#endif
#ifdef DBG_DUMP
    hipLaunchKernelGGL(dbg_dump, dim3(1024), dim3(512), 0, stream, (const unsigned char*)d_ws, (float*)d_out);
#endif
#else
    a.ph_lo = 0; a.ph_hi = NPHASE;
    void* kargs[] = {&a};
    hipError_t e = hipLaunchCooperativeKernel((const void*)mk_fwd, dim3(grid), dim3(512), kargs, LDS_BYTES, stream);
    if (e != hipSuccess) fprintf(stderr, "kernel_launch: cooperative launch failed: %s (grid %d)\n", hipGetErrorString(e), grid);
#endif
}
```

```cpp
#include <hip/hip_runtime.h>
#include <hip/hip_cooperative_groups.h>
#include <cstdio>
#include <cstdint>
namespace cg = cooperative_groups;

#ifndef MK_PER_PHASE_LAUNCH
#define MK_PER_PHASE_LAUNCH 0
#endif

#define GAS __attribute__((address_space(1)))
#define LAS __attribute__((address_space(3)))
typedef unsigned short bf16_t;
typedef short bf16x8 __attribute__((ext_vector_type(8)));
typedef short s16x4 __attribute__((ext_vector_type(4)));
typedef float f32x2 __attribute__((ext_vector_type(2)));
typedef float f32x4 __attribute__((ext_vector_type(4)));
typedef float f32x16 __attribute__((ext_vector_type(16)));
typedef unsigned u32x2 __attribute__((ext_vector_type(2)));
typedef unsigned u32x4 __attribute__((ext_vector_type(4)));
typedef unsigned long long u64;

constexpr int NB = 4, SEQ = 4096, DM = 2048, NT = NB * SEQ;
constexpr int NH = 16, HD = 64, NG = 4;
constexpr int PW = 1024;
constexpr int IN_COLS = 7728, IN_PAD = 7936;
constexpr int NE = 64, EH = 512;
constexpr int MPAD = 49152;
constexpr float DN_ALPHA = 1.18920711500272f;
constexpr float LN_EPS = 1e-5f;
constexpr float C2 = 0.125f * 1.4426950408889634f;
constexpr int NPHASE = 12;
#ifndef DBG_NPH
#define DBG_NPH NPHASE
#endif
#define DBG_OFF (504ull << 20)
#define DBG_LD 4096
#define DBG_COLS 2048
#define DBG_ROWS 16384

constexpr size_t MiB = 1u << 20;
constexpr size_t WS_CTL = 0, CTL_ZERO_BYTES = 96 * 1024;
constexpr size_t WS_WGU = 1 * MiB, WS_WD = 257 * MiB, WS_WIN = 385 * MiB, WS_WPP = 416 * MiB, WS_WNP = 420 * MiB, WS_WO = 424 * MiB, WS_PM = 432 * MiB;
constexpr size_t WS_CW1K = 433 * MiB, WS_CW1V = 434 * MiB, WS_CW2K = 435 * MiB, WS_CW2V = 435 * MiB + 65536, WS_WRH = 436 * MiB, WS_WRL = 436 * MiB + 512 * 1024;
constexpr size_t WS_ROPE = 437 * MiB, WS_CBIAS = 438 * MiB;
constexpr size_t WS_XB = 440 * MiB, WS_POOLED = 868 * MiB  , WS_MIXED = 472 * MiB, WS_H1B = 440 * MiB;
constexpr size_t WS_GM = 504 * MiB, WS_U = 632 * MiB, WS_Q = 664 * MiB;
constexpr size_t WS_KC = 696 * MiB, WS_VC = 705 * MiB, WS_KS = 714 * MiB, WS_VS = 722 * MiB, WS_KW = 730 * MiB, WS_VW = 738 * MiB;
constexpr size_t WS_GN = 746 * MiB, WS_KCMP = 750 * MiB, WS_VCMP = 750 * MiB + 512 * 1024, WS_HK = 751 * MiB, WS_HV = 753 * MiB, WS_CMPP = 852 * MiB, WS_V1B = 632 * MiB, WS_PS = 917 * MiB;
constexpr size_t WS_AO = 756 * MiB;
constexpr size_t WS_ZP = 756 * MiB, WS_O = 820 * MiB, WS_Z = 852 * MiB;
constexpr size_t WS_STATS = 916 * MiB, WS_RTE = 917 * MiB, WS_RTW = 917 * MiB + 256 * 1024, WS_RTP = 917 * MiB + 512 * 1024, WS_ROWMAP = 919 * MiB, WS_ROWW = 920 * MiB;
constexpr size_t WS_XBUF = 504 * MiB, WS_HID = 696 * MiB, WS_YB = 756 * MiB;
constexpr size_t WS_ELIST = 921 * MiB, WS_EWT = 925 * MiB;
constexpr size_t WS_END = 929 * MiB;
constexpr int CW_BAR = 4096, CW_CNT = 8192, CW_GRP = 12288, CW_ATQ = 12288 + 256, CW_GX = 16384;

constexpr int RING_BYTES = 131072;
constexpr int MISC_OFF = 132096;
constexpr int TAB_OFF = MISC_OFF + 256;
constexpr int LDS_BYTES = 163840;

#define RLX_AGENT __ATOMIC_RELAXED, __HIP_MEMORY_SCOPE_AGENT
__device__ __forceinline__ unsigned f2bf(float f) { unsigned u = __builtin_bit_cast(unsigned, f); return (u + 0x7fffu + ((u >> 16) & 1u)) >> 16; }
__device__ __forceinline__ unsigned pk2(float lo, float hi) { return f2bf(lo) | (f2bf(hi) << 16); }
__device__ __forceinline__ float bf2f(unsigned short b) { return __builtin_bit_cast(float, (unsigned)b << 16); }
__device__ __forceinline__ float bflo(unsigned w) { return __builtin_bit_cast(float, w << 16); }
__device__ __forceinline__ float bfhi(unsigned w) { return __builtin_bit_cast(float, w & 0xffff0000u); }
typedef __bf16 bf16x2_t __attribute__((ext_vector_type(2)));
__device__ __forceinline__ unsigned cvt_pk_bf16(float lo, float hi) { const f32x2 v = {lo, hi}; const bf16x2_t b = __builtin_convertvector(v, bf16x2_t); return __builtin_bit_cast(unsigned, b); }
__device__ __forceinline__ void store8(bf16_t* p, f32x4 a, f32x4 b) { u32x4 w; w.x = cvt_pk_bf16(a[0], a[1]); w.y = cvt_pk_bf16(a[2], a[3]); w.z = cvt_pk_bf16(b[0], b[1]); w.w = cvt_pk_bf16(b[2], b[3]); *(u32x4*)p = w; }
__device__ __forceinline__ void load8(const bf16_t* p, f32x4& a, f32x4& b) { const u32x4 w = *(const u32x4*)p; a = (f32x4){bflo(w.x), bfhi(w.x), bflo(w.y), bfhi(w.y)}; b = (f32x4){bflo(w.z), bfhi(w.z), bflo(w.w), bfhi(w.w)}; }
__device__ __forceinline__ float fast_exp2(float x) { return __builtin_amdgcn_exp2f(x); }
__device__ __forceinline__ float sigmoidf_(float x) { return __builtin_amdgcn_rcpf(1.f + fast_exp2(-1.4426950408889634f * x)); }
__device__ __forceinline__ f32x4 sigmoid4(f32x4 v) { return (f32x4){sigmoidf_(v[0]), sigmoidf_(v[1]), sigmoidf_(v[2]), sigmoidf_(v[3])}; }
__device__ __forceinline__ float gelu_tanh(float x) { const float y = 0.7978845608028654f * (x + 0.044715f * x * x * x); const float e = fast_exp2(2.f * 1.4426950408889634f * y); const float th = 1.f - 2.f * __builtin_amdgcn_rcpf(e + 1.f); return 0.5f * x * (1.f + th); }
__device__ __forceinline__ float wave_sum(float v) {
#pragma unroll
    for (int o = 1; o < 64; o <<= 1) v += __shfl_xor(v, o);
    return v;
}

namespace pg8 {
constexpr int BM = 256, BK = 64, HALF = 128, HTB = HALF * BK * 2, STAGE_BYTES = 8 * HTB;
__host__ __device__ __forceinline__ int lds_byte(int r, int c) { const int st = (r >> 4) * 2 + (c >> 5), rr = r & 15, cc = c & 31, ob = rr * 64 + cc * 2; return st * 1024 + (ob ^ (((ob >> 9) & 1) << 5)); }
__host__ __device__ __forceinline__ void stage_rc(int b, int& R, int& C) { const int st = b / 1024, sb = b % 1024, swz = sb ^ (((sb >> 9) & 1) << 5); R = (st >> 1) * 16 + swz / 64; C = (st & 1) * 32 + (swz % 64) / 2; }
__host__ __device__ __forceinline__ int perm32(int rho) { const int n = rho >> 4, i = rho & 15; return 8 * (i >> 2) + 4 * n + (i & 3); }

struct Unit { int pm, pn; const char* a; const char* b; };
struct Gemm { int K; unsigned lda, ldb; };

template <class Epi, class Sched, bool ALIGN_EPI, bool GATHER = false>
__device__ __forceinline__ void gemm_phase(LAS unsigned char* lds, const Gemm g, const Sched& S, const Epi& E) {
    const int tid = threadIdx.x, wid = __builtin_amdgcn_readfirstlane(tid >> 6), lane = tid & 63, wr = wid >> 2, wc = wid & 3, fr = lane & 15, fq = lane >> 4;
    const int K = g.K, nt = K / BK;
    unsigned voffA[2], voffB[2];
#pragma unroll
    for (int i = 0; i < 2; ++i) { int R, C; stage_rc(tid * 16 + i * 8192, R, C); const int Rb = Epi::PERM ? ((R & ~31) + perm32(R & 31)) : R;
        voffA[i] = (unsigned)R * g.lda + (unsigned)C * 2u; voffB[i] = (unsigned)Rb * g.ldb + (unsigned)C * 2u; }
    int rowA[2];
#pragma unroll
    for (int i = 0; i < 2; ++i) { int R, C; stage_rc(tid * 16 + i * 8192, R, C); rowA[i] = R; }
    unsigned vA[2][2], nvA[2][2];
    const size_t kstep = (size_t)(BK * 2);
    const size_t hstepA = (size_t)HALF * g.lda, hstepB = (size_t)HALF * g.ldb;
    const unsigned ldsw = (unsigned)wid * 1024u;
    const int aoff = lds_byte(wr * 64 + fr, fq * 8), boff = lds_byte(wc * 32 + fr, fq * 8);
#define PG8_SA(b, h) (((b) * 2 + (h)) * HTB)
#define PG8_SB(b, h) ((4 + (b) * 2 + (h)) * HTB)
#define PG8_STAGE(bufoff, gbase, voff) do { _Pragma("unroll") for (int _i = 0; _i < 2; ++_i) \
        __builtin_amdgcn_global_load_lds((const unsigned*)((const char*)(gbase) + (voff)[_i]), (LAS unsigned*)(lds + (bufoff) + ldsw + _i * 8192), 16, 0, 0); } while (0)
#define PG8_STAGE_A(bufoff, h, kptr, nx) do { if constexpr (GATHER) { unsigned o_[2] = {(nx) ? nvA[h][0] : vA[h][0], (nx) ? nvA[h][1] : vA[h][1]}; PG8_STAGE(bufoff, kptr, o_); } else { PG8_STAGE(bufoff, (kptr) + (h) * hstepA, voffA); } } while (0)
#define PG8_LDA(dst, b, h) do { _Pragma("unroll") for (int m = 0; m < 4; ++m) _Pragma("unroll") for (int k = 0; k < 2; ++k) dst[m][k] = *(const LAS bf16x8*)(lds + PG8_SA(b, h) + aoff + m * 2048 + k * 1024); } while (0)
#define PG8_LDB(dst, b, h) do { _Pragma("unroll") for (int n = 0; n < 2; ++n) _Pragma("unroll") for (int k = 0; k < 2; ++k) dst[n][k] = *(const LAS bf16x8*)(lds + PG8_SB(b, h) + boff + n * 2048 + k * 1024); } while (0)
#define PG8_MMA(ai, bj, At, Bt) do { __builtin_amdgcn_s_setprio(1); _Pragma("unroll") for (int m = 0; m < 4; ++m) _Pragma("unroll") for (int n = 0; n < 2; ++n) _Pragma("unroll") for (int k = 0; k < 2; ++k) \
        acc[ai][bj][m][n] = __builtin_amdgcn_mfma_f32_16x16x32_bf16(Bt[n][k], At[m][k], acc[ai][bj][m][n], 0, 0, 0); __builtin_amdgcn_s_setprio(0); } while (0)
#define PG8_WAIT_V(n) asm volatile("s_waitcnt vmcnt(" #n ")" ::: "memory")
#define PG8_WAIT_L(n) asm volatile("s_waitcnt lgkmcnt(" #n ")" ::: "memory")
#define PG8_BAR __builtin_amdgcn_s_barrier()
#define PG8_SCHED __builtin_amdgcn_sched_barrier(0)
    Unit cur, nxt; int ui = 0;
    if (!S.next(0, cur)) return;
    f32x4 acc[2][2][4][2];
#pragma unroll
    for (int a = 0; a < 2; ++a)
#pragma unroll
        for (int b = 0; b < 2; ++b)
#pragma unroll
            for (int m = 0; m < 4; ++m)
#pragma unroll
                for (int n = 0; n < 2; ++n) acc[a][b][m][n] = (f32x4){0.f, 0.f, 0.f, 0.f};
    bf16x8 At[4][2], B0[2][2], B1[2][2];
    const char* cA = cur.a; const char* cB = cur.b;
    if constexpr (GATHER) {
#pragma unroll
        for (int h = 0; h < 2; ++h)
#pragma unroll
            for (int i = 0; i < 2; ++i) { int R, C; stage_rc(tid * 16 + i * 8192, R, C); vA[h][i] = S.row_off(cur, rowA[i] + 128 * h) + (unsigned)C * 2u; nvA[h][i] = vA[h][i]; } }
    PG8_STAGE(PG8_SB(0, 0), cB, voffB); PG8_STAGE(PG8_SB(0, 1), cB + hstepB, voffB); PG8_STAGE_A(PG8_SA(0, 0), 0, cA, false); PG8_STAGE_A(PG8_SA(0, 1), 1, cA, false);
    if (wr == 1) PG8_BAR;
    PG8_WAIT_V(2); PG8_BAR;
    PG8_STAGE(PG8_SB(1, 0), cB + kstep, voffB); PG8_STAGE_A(PG8_SA(1, 0), 0, cA + kstep, false); PG8_STAGE(PG8_SB(1, 1), cB + hstepB + kstep, voffB);
    PG8_WAIT_V(6); PG8_BAR;
    for (;;) {
        const bool has_next = S.next(ui + 1, nxt);
        if constexpr (GATHER) { if (has_next) {
#pragma unroll
            for (int h = 0; h < 2; ++h)
#pragma unroll
                for (int i = 0; i < 2; ++i) { int R, C; stage_rc(tid * 16 + i * 8192, R, C); nvA[h][i] = S.row_off(nxt, rowA[i] + 128 * h) + (unsigned)C * 2u; } } }
        const char* nA = has_next ? nxt.a : cA; const char* nB = has_next ? nxt.b : cB;
#pragma unroll 1
        for (int t = 0; t < nt; t += 2) {
            const bool last = (t == nt - 2);
            const char* a1 = cA + (size_t)(t + 1) * kstep;
            const char* a2 = last ? nA : cA + (size_t)(t + 2) * kstep; const char* b2 = last ? nB : cB + (size_t)(t + 2) * kstep;
            const char* a3 = a2 + kstep; const char* b3 = b2 + kstep;
            PG8_LDB(B0, 0, 0); PG8_LDB(B1, 0, 1); PG8_SCHED; PG8_LDA(At, 0, 0); PG8_STAGE_A(PG8_SA(1, 1), 1, a1, false);
            PG8_WAIT_V(8); PG8_WAIT_L(0); PG8_BAR; PG8_MMA(0, 0, At, B0); PG8_MMA(0, 1, At, B1); PG8_BAR; PG8_SCHED;
            PG8_LDA(At, 0, 1); PG8_STAGE(PG8_SB(0, 0), b2, voffB); PG8_STAGE(PG8_SB(0, 1), b2 + hstepB, voffB); PG8_STAGE_A(PG8_SA(0, 0), 0, a2, last);
            PG8_WAIT_V(8); PG8_WAIT_L(0); PG8_BAR; PG8_MMA(1, 0, At, B0); PG8_MMA(1, 1, At, B1); PG8_BAR; PG8_SCHED;
            PG8_LDB(B0, 1, 0); PG8_LDB(B1, 1, 1); PG8_SCHED; PG8_LDA(At, 1, 0); PG8_STAGE_A(PG8_SA(0, 1), 1, a2, last);
            PG8_WAIT_V(8); PG8_WAIT_L(0); PG8_BAR; PG8_MMA(0, 0, At, B0); PG8_MMA(0, 1, At, B1); PG8_BAR; PG8_SCHED;
            PG8_LDA(At, 1, 1); PG8_STAGE(PG8_SB(1, 0), b3, voffB); PG8_STAGE(PG8_SB(1, 1), b3 + hstepB, voffB); PG8_STAGE_A(PG8_SA(1, 0), 0, a3, last);
            PG8_WAIT_V(8); PG8_WAIT_L(0); PG8_BAR; PG8_MMA(1, 0, At, B0); PG8_MMA(1, 1, At, B1); PG8_BAR; PG8_SCHED;
            if constexpr (Epi::HAS_MID) { if (t == Epi::MID_T) E.mid(acc, cur, wr, wc, fr, fq); }
        }
        if constexpr (ALIGN_EPI) { if (wr == 0) PG8_BAR; }
        E(acc, cur, wr, wc, fr, fq);
        if (!has_next) break;
#pragma unroll
        for (int a = 0; a < 2; ++a)
#pragma unroll
            for (int b = 0; b < 2; ++b)
#pragma unroll
                for (int m = 0; m < 4; ++m)
#pragma unroll
                    for (int n = 0; n < 2; ++n) acc[a][b][m][n] = (f32x4){0.f, 0.f, 0.f, 0.f};
        cur = nxt; cA = nA; cB = nB; ++ui;
        if constexpr (GATHER) {
#pragma unroll
            for (int h = 0; h < 2; ++h) { vA[h][0] = nvA[h][0]; vA[h][1] = nvA[h][1]; } }
        if constexpr (ALIGN_EPI) { if (wr == 1) PG8_BAR; }
    }
    PG8_WAIT_V(0);
    if constexpr (!ALIGN_EPI) { if (wr == 0) PG8_BAR; }
    PG8_BAR;
#undef PG8_SA
#undef PG8_SB
#undef PG8_STAGE
#undef PG8_STAGE_A
#undef PG8_LDA
#undef PG8_LDB
#undef PG8_MMA
#undef PG8_WAIT_V
#undef PG8_WAIT_L
#undef PG8_BAR
#undef PG8_SCHED
}
}
using pg8::Unit;

struct RectSched {
    int nM, nN, nwg, G, c; const char* A; const char* B; size_t tA, tB;
    __device__ void init(int M, int N, int G_, int c_, const void* A_, unsigned lda, const void* B_, unsigned ldb) { nM = M / 256; nN = N / 256; nwg = nM * nN; G = G_; c = c_; A = (const char*)A_; B = (const char*)B_; tA = (size_t)256 * lda; tB = (size_t)256 * ldb; }
    __device__ bool next(int i, Unit& u) const {
        const long L = (long)i * G + c; if (L >= nwg) return false;
        int wgid = (int)L; { const int q = nwg / 8, r = nwg % 8, xcd = wgid % 8, off = wgid / 8; wgid = (xcd < r ? xcd * (q + 1) : r * (q + 1) + (xcd - r) * q) + off; }
        const int nig = 8 * nN, gid = wgid / nig, fm = gid * 8, gsz = (nM - fm) < 8 ? (nM - fm) : 8;
        u.pm = fm + ((wgid % nig) % gsz); u.pn = (wgid % nig) / gsz; u.a = A + (size_t)u.pm * tA; u.b = B + (size_t)u.pn * tB; return true;
    }
};
struct CmpSched {
    int vcu, G; const char* A0; const char* A1; const char* B0; const char* B1;
    __device__ bool next(int i, Unit& u) const { int c; if (G == 256) { if (i > 0 || (vcu & 3) != 0) return false; c = vcu >> 2; } else { c = vcu + i * G; if (c >= 64) return false; }
        u.pm = c & 15; u.pn = c >> 4; const int side = u.pn >> 1, kh = u.pn & 1;
        u.a = (side ? A1 : A0) + (size_t)u.pm * 256 * 2048 + kh * 2048; u.b = (side ? B1 : B0) + kh * 2048; return true; }
};
struct MixSched {
    int vcu, G; const char* A; const char* B;
    __device__ bool next(int i, Unit& u) const { if (vcu < 0) return false; const int L = i * G + vcu; if (L >= 256) return false; u.pm = L >> 2; u.pn = L & 3; u.a = A + (size_t)u.pm * 256 * 2048 + u.pn * 512; u.b = B + (size_t)u.pn * 256 * 512; return true; }
};
struct MoeTab { const LAS int* texp; const LAS int* tb; const LAS int* cn; const int* elist; const float* ewt; };
template <int NCT, int NEXP_ROWS  > struct MoeSched {
    int v, Gp, L0, L1; const char* A; const char* B; unsigned lda, ldb; MoeTab T;
    __device__ bool next(int i, Unit& u) const { if (v < 0 || v >= Gp) return false; const int L = L0 + i * Gp + v; if (L >= L1) return false; u.pm = L / NCT; u.pn = L % NCT; const int e = T.texp[u.pm];
        u.a = A + (size_t)u.pm * 256 * lda; u.b = B + ((size_t)e * NEXP_ROWS + (size_t)u.pn * 256) * ldb; return true; }
};
template <int NCT, int NEXP_ROWS> struct MoeGatherSched {
    int v, Gp, L0, L1; const char* A; const char* B; unsigned lda, ldb; MoeTab T;
    __device__ bool next(int i, Unit& u) const { if (v < 0 || v >= Gp) return false; const int L = L0 + i * Gp + v; if (L >= L1) return false; u.pm = L / NCT; u.pn = L % NCT; const int e = T.texp[u.pm];
        u.a = A; u.b = B + ((size_t)e * NEXP_ROWS + (size_t)u.pn * 256) * ldb; return true; }
    __device__ unsigned row_off(const Unit& u, int R) const { const int e = T.texp[u.pm]; const int pos = (u.pm - T.tb[e]) * 256 + R; const int tok = pos < T.cn[e] ? (T.elist[(size_t)e * NT + pos] >> 1) : 0; return (unsigned)tok * lda; }
};

struct EpiInProj {
    static constexpr bool PERM = true, HAS_MID = false;
    bf16_t* U; bf16_t* Q; bf16_t* KVb; bf16_t* GM; float* GN; const f32x4* rope;
    __device__ __forceinline__ void operator()(const f32x4 (&acc)[2][2][4][2], const Unit& u, int wr, int wc, int fr, int fq) const {
        const int pn = u.pn, row0 = u.pm * 256 + wr * 64 + fr, cit = wc * 32 + 8 * fq;
        if (pn < 4) {
#pragma unroll
            for (int ai = 0; ai < 2; ++ai)
#pragma unroll
                for (int m = 0; m < 4; ++m) { bf16_t* rp = U + (size_t)(row0 + ai * 128 + m * 16) * PW + pn * 256 + cit;
#pragma unroll
                    for (int bj = 0; bj < 2; ++bj) store8(rp + bj * 128, acc[ai][bj][m][0], acc[ai][bj][m][1]); }
        } else if (pn < 14) {
            const bool isq = pn < 8; const int kind = pn - 8; const bool dorope = isq || kind == 2 || kind == 4;
            const int p0 = 32 * (wc & 1) + 8 * fq, gI = 4 * (wc & 1) + fq;
            const size_t kvo = kind == 1 ? (WS_VC - WS_KC) : kind == 2 ? (WS_KS - WS_KC) : kind == 3 ? (WS_VS - WS_KC) : kind == 4 ? (WS_KW - WS_KC) : kind == 5 ? (WS_VW - WS_KC) : 0;
            bf16_t* base = isq ? Q : (bf16_t*)((char*)KVb + kvo);
            const float sc = isq ? C2 : 1.f;
#pragma unroll
            for (int ai = 0; ai < 2; ++ai) {
                f32x4 c0[4], c1[4];
#pragma unroll
                for (int m = 0; m < 4; ++m) { c0[m] = (f32x4){1.f, 0.f, 1.f, 0.f}; c1[m] = c0[m]; }
                if (dorope) {
#pragma unroll
                    for (int m = 0; m < 4; ++m) { const int t = (row0 + ai * 128 + m * 16) & 4095; c0[m] = rope[t * 16 + gI * 2]; c1[m] = rope[t * 16 + gI * 2 + 1]; } }
                asm volatile("" ::: "memory");
#pragma unroll
                for (int m = 0; m < 4; ++m) { const int row = row0 + ai * 128 + m * 16, b = row >> 12, t = row & 4095;
                    const f32x4 cs0 = c0[m], cs1 = c1[m];
#pragma unroll
                    for (int bj = 0; bj < 2; ++bj) { const int hit = 2 * bj + (wc >> 1);
                        const f32x4 x1 = acc[ai][bj][m][0], x2 = acc[ai][bj][m][1];
                        const f32x4 c = (f32x4){cs0[0], cs0[2], cs1[0], cs1[2]}, s = (f32x4){cs0[1], cs0[3], cs1[1], cs1[3]};
                        const f32x4 y1 = (x1 * c - x2 * s) * sc, y2 = (x2 * c + x1 * s) * sc;
                        const size_t hrow = isq ? ((size_t)(b * NH + (pn - 4) * 4 + hit) * SEQ + t) : ((size_t)(b * NG + hit) * SEQ + t);
                        store8(base + hrow * HD + p0, y1, y2); } } }
        } else if (pn < 30) {
#pragma unroll
            for (int ai = 0; ai < 2; ++ai)
#pragma unroll
                for (int m = 0; m < 4; ++m) { bf16_t* rp = GM + (size_t)(row0 + ai * 128 + m * 16) * 4096 + (pn - 14) * 256 + cit;
#pragma unroll
                    for (int bj = 0; bj < 2; ++bj) store8(rp + bj * 128, sigmoid4(acc[ai][bj][m][0]), sigmoid4(acc[ai][bj][m][1])); }
        } else {
            if (wc < 2) {
#pragma unroll
                for (int ai = 0; ai < 2; ++ai)
#pragma unroll
                    for (int m = 0; m < 4; ++m) { float* rp = GN + (size_t)(row0 + ai * 128 + m * 16) * 64;
#pragma unroll
                        for (int n = 0; n < 2; ++n) { const int col = cit + 4 * n; if (col < 48) *(f32x4*)(rp + col) = sigmoid4(acc[ai][0][m][n]); } }
            }
        }
    }
};
struct EpiCmp1 {
    static constexpr bool PERM = true, HAS_MID = false;
    float* P; const float* bias;
    __device__ __forceinline__ void operator()(const f32x4 (&acc)[2][2][4][2], const Unit& u, int wr, int wc, int fr, int fq) const {
        const int row0 = u.pm * 256 + wr * 64 + fr, cit = wc * 32 + 8 * fq; float* out = P + (size_t)u.pn * 4096 * 256; const float* bs = bias + (u.pn >> 1) * 256;
        const float bsc = (u.pn & 1) ? 0.f : 1.f;
#pragma unroll
        for (int bj = 0; bj < 2; ++bj) { const f32x4 b0 = *(const f32x4*)(bs + bj * 128 + cit) * bsc, b1 = *(const f32x4*)(bs + bj * 128 + cit + 4) * bsc;
#pragma unroll
            for (int ai = 0; ai < 2; ++ai)
#pragma unroll
                for (int m = 0; m < 4; ++m) { float* o = out + (size_t)(row0 + ai * 128 + m * 16) * 256 + bj * 128 + cit;
                    *(f32x4*)o = acc[ai][bj][m][0] + b0; *(f32x4*)(o + 4) = acc[ai][bj][m][1] + b1; } }
    }
};
struct EpiMix {
    static constexpr bool PERM = true, HAS_MID = false;
    bf16_t* out; const float* scale;
    __device__ __forceinline__ void operator()(const f32x4 (&acc)[2][2][4][2], const Unit& u, int wr, int wc, int fr, int fq) const {
        const int row0 = u.pm * 256 + wr * 64 + fr, cit = wc * 32 + 8 * fq, cb = u.pn * 256;
#pragma unroll
        for (int bj = 0; bj < 2; ++bj) { const f32x4 s0 = *(const f32x4*)(scale + cb + bj * 128 + cit), s1 = *(const f32x4*)(scale + cb + bj * 128 + cit + 4);
#pragma unroll
            for (int ai = 0; ai < 2; ++ai)
#pragma unroll
                for (int m = 0; m < 4; ++m) store8(out + (size_t)(row0 + ai * 128 + m * 16) * DM + cb + bj * 128 + cit, acc[ai][bj][m][0] * s0, acc[ai][bj][m][1] * s1); }
    }
};
struct EpiZ2 {
    static constexpr bool PERM = true, HAS_MID = true; static constexpr int MID_T = 14;
    bf16_t* Z; const bf16_t* GM;
    __device__ __forceinline__ void mid(f32x4 (&acc)[2][2][4][2], const Unit& u, int wr, int wc, int fr, int fq) const {
        int row0 = u.pm * 256 + wr * 64 + fr, col0 = u.pn * 256 + wc * 32 + 8 * fq;
        asm volatile("" : "+v"(row0), "+v"(col0));
#pragma unroll
        for (int ai = 0; ai < 2; ++ai) {
            u32x4 gp[4][2], ga[4][2];
#pragma unroll
            for (int m = 0; m < 4; ++m) { const size_t row = row0 + ai * 128 + m * 16;
#pragma unroll
                for (int bj = 0; bj < 2; ++bj) { gp[m][bj] = *(const u32x4*)(GM + row * 4096 + col0 + bj * 128); ga[m][bj] = *(const u32x4*)(GM + row * 4096 + 2048 + col0 + bj * 128); } }
            asm volatile("" ::: "memory");
#pragma unroll
            for (int m = 0; m < 4; ++m)
#pragma unroll
                for (int bj = 0; bj < 2; ++bj) { const u32x4 wp = gp[m][bj], wa = ga[m][bj];
                    const f32x4 p0 = (f32x4){bflo(wp.x), bfhi(wp.x), bflo(wp.y), bfhi(wp.y)}, p1 = (f32x4){bflo(wp.z), bfhi(wp.z), bflo(wp.w), bfhi(wp.w)};
                    const f32x4 a0 = (f32x4){bflo(wa.x), bfhi(wa.x), bflo(wa.y), bfhi(wa.y)}, a1 = (f32x4){bflo(wa.z), bfhi(wa.z), bflo(wa.w), bfhi(wa.w)};
#pragma unroll
                    for (int j = 0; j < 4; ++j) { acc[ai][bj][m][0][j] *= p0[j] * __builtin_amdgcn_rcpf(fmaxf(a0[j], 1e-20f)); acc[ai][bj][m][1][j] *= p1[j] * __builtin_amdgcn_rcpf(fmaxf(a1[j], 1e-20f)); } }
            asm volatile("" ::: "memory"); }
    }
    __device__ __forceinline__ void operator()(const f32x4 (&acc)[2][2][4][2], const Unit& u, int wr, int wc, int fr, int fq) const {
        const int row0 = u.pm * 256 + wr * 64 + fr, col0 = u.pn * 256 + wc * 32 + 8 * fq;
#pragma unroll
        for (int ai = 0; ai < 2; ++ai) {
            u32x4 ga[4][2];
#pragma unroll
            for (int m = 0; m < 4; ++m) { const size_t row = row0 + ai * 128 + m * 16;
#pragma unroll
                for (int bj = 0; bj < 2; ++bj) ga[m][bj] = *(const u32x4*)(GM + row * 4096 + 2048 + col0 + bj * 128); }
            asm volatile("" ::: "memory");
#pragma unroll
            for (int m = 0; m < 4; ++m) { const size_t row = row0 + ai * 128 + m * 16;
#pragma unroll
                for (int bj = 0; bj < 2; ++bj) { const u32x4 wa = ga[m][bj];
                    f32x4 a0 = (f32x4){bflo(wa.x), bfhi(wa.x), bflo(wa.y), bfhi(wa.y)}, a1 = (f32x4){bflo(wa.z), bfhi(wa.z), bflo(wa.w), bfhi(wa.w)};
#pragma unroll
                    for (int j = 0; j < 4; ++j) { a0[j] = fmaxf(a0[j], 1e-20f); a1[j] = fmaxf(a1[j], 1e-20f); }
                    store8(Z + row * DM + col0 + bj * 128, acc[ai][bj][m][0] * a0, acc[ai][bj][m][1] * a1); } }
        }
    }
};
struct EpiV1 {
    static constexpr bool PERM = true, HAS_MID = false;
    bf16_t* V1B; const bf16_t* x; float* PS;
    __device__ __forceinline__ void operator()(const f32x4 (&acc)[2][2][4][2], const Unit& u, int wr, int wc, int fr, int fq) const {
        const int row0 = u.pm * 256 + wr * 64 + fr, col0 = u.pn * 256 + wc * 32 + 8 * fq;
#pragma unroll
        for (int ai = 0; ai < 2; ++ai) {
            u32x4 xv[4][2];
#pragma unroll
            for (int m = 0; m < 4; ++m) { const size_t off = (size_t)(row0 + ai * 128 + m * 16) * DM + col0;
#pragma unroll
                for (int bj = 0; bj < 2; ++bj) xv[m][bj] = *(const u32x4*)(x + off + bj * 128); }
            asm volatile("" ::: "memory");
#pragma unroll
            for (int m = 0; m < 4; ++m) { const size_t row = (size_t)(row0 + ai * 128 + m * 16); float sv = 0.f, qv = 0.f;
#pragma unroll
                for (int bj = 0; bj < 2; ++bj) { const u32x4 q = xv[m][bj];
                    const f32x4 v0 = (f32x4){bflo(q.x), bfhi(q.x), bflo(q.y), bfhi(q.y)} * DN_ALPHA + acc[ai][bj][m][0], v1 = (f32x4){bflo(q.z), bfhi(q.z), bflo(q.w), bfhi(q.w)} * DN_ALPHA + acc[ai][bj][m][1];
                    sv += ((v0[0] + v0[1]) + (v0[2] + v0[3])) + ((v1[0] + v1[1]) + (v1[2] + v1[3]));
                    qv += ((v0[0] * v0[0] + v0[1] * v0[1]) + (v0[2] * v0[2] + v0[3] * v0[3])) + ((v1[0] * v1[0] + v1[1] * v1[1]) + (v1[2] * v1[2] + v1[3] * v1[3]));
                    store8(V1B + row * DM + col0 + bj * 128, v0, v1); }
                sv += __shfl_xor(sv, 16); qv += __shfl_xor(qv, 16); sv += __shfl_xor(sv, 32); qv += __shfl_xor(qv, 32);
                if (fq == 0) *(f32x2*)(PS + row * 64 + (u.pn * 4 + wc) * 2) = (f32x2){sv, qv}; }
        }
    }
};
struct EpiUp {
    static constexpr bool PERM = true, HAS_MID = false;
    bf16_t* HID;
    __device__ __forceinline__ void operator()(const f32x4 (&acc)[2][2][4][2], const Unit& u, int wr, int wc, int fr, int fq) const {
        const int row0 = u.pm * 256 + wr * 64 + fr, col0 = u.pn * 128 + wc * 32 + 8 * fq;
#pragma unroll
        for (int ai = 0; ai < 2; ++ai)
#pragma unroll
            for (int m = 0; m < 4; ++m) { f32x4 h0, h1;
#pragma unroll
                for (int j = 0; j < 4; ++j) { const float g0 = acc[ai][0][m][0][j], g1 = acc[ai][0][m][1][j]; h0[j] = g0 * sigmoidf_(g0) * acc[ai][1][m][0][j]; h1[j] = g1 * sigmoidf_(g1) * acc[ai][1][m][1][j]; }
                store8(HID + (size_t)(row0 + ai * 128 + m * 16) * EH + col0, h0, h1); }
    }
};
struct EpiDown {
    static constexpr bool PERM = true, HAS_MID = false;
    bf16_t* YB; MoeTab T;
    __device__ __forceinline__ void operator()(const f32x4 (&acc)[2][2][4][2], const Unit& u, int wr, int wc, int fr, int fq) const {
        const int col0 = u.pn * 256 + wc * 32 + 8 * fq; const int e = T.texp[u.pm], pos0 = (u.pm - T.tb[e]) * 256 + wr * 64 + fr, cn = T.cn[e];
        int slot[2][4]; float w[2][4];
#pragma unroll
        for (int ai = 0; ai < 2; ++ai)
#pragma unroll
            for (int m = 0; m < 4; ++m) { const int pos = pos0 + ai * 128 + m * 16, pc = pos < cn ? pos : cn - 1;
                slot[ai][m] = T.elist[(size_t)e * NT + pc]; w[ai][m] = T.ewt[(size_t)e * NT + pc]; }
        asm volatile("" ::: "memory");
#pragma unroll
        for (int ai = 0; ai < 2; ++ai)
#pragma unroll
            for (int m = 0; m < 4; ++m) { const int pos = pos0 + ai * 128 + m * 16;
                if (pos < cn) {
#pragma unroll
                    for (int bj = 0; bj < 2; ++bj) store8(YB + (size_t)slot[ai][m] * DM + col0 + bj * 128, acc[ai][bj][m][0] * w[ai][m], acc[ai][bj][m][1] * w[ai][m]); } }
    }
};

#define XB_TMO      128
#define XB_XCNT(j)  (256  + 64 * (j))
#define XB_XSUB(j)  (1280 + 64 * (j))
#define XB_XGEN(j)  (2304 + 64 * (j))
#define XB_TOP      3328
#define XB_TOPGEN   3392
#define XCD_BAR_WORDS 3456
#define XB_SPIN_CAP (1u << 20)
__device__ __forceinline__ unsigned xb_ld(unsigned* p)              { return __hip_atomic_load(p, __ATOMIC_RELAXED, __HIP_MEMORY_SCOPE_AGENT); }
__device__ __forceinline__ unsigned xb_add(unsigned* p, unsigned v) { return __hip_atomic_fetch_add(p, v, __ATOMIC_RELAXED, __HIP_MEMORY_SCOPE_AGENT); }
__device__ __forceinline__ unsigned xb_xcc_id() { return (unsigned)__builtin_amdgcn_s_getreg((3 << 11) | 20) & 0xFu; }
#define XB_SPIN(cond, bar) do { unsigned _sp = 0; while (cond) { __builtin_amdgcn_s_sleep(1); \
    if ((++_sp & 255u) == 0u) { if (xb_ld(&(bar)[XB_TMO])) break; if (_sp > XB_SPIN_CAP) { atomicAdd(&(bar)[XB_TMO], 1u); break; } } } } while (0)
struct XcdBarrier { unsigned* bar; unsigned x; volatile LAS unsigned* st; };
__device__ __forceinline__ XcdBarrier xcd_barrier_post(unsigned* bar, volatile LAS unsigned* st) {
    XcdBarrier b; b.bar = bar; b.x = xb_xcc_id(); b.st = st;
    if (threadIdx.x == 0) (void)xb_add(&bar[XB_XCNT(b.x)], 1u);
    return b;
}
__device__ __forceinline__ void xcd_barrier_complete(unsigned* bar, unsigned x, unsigned& nloc, unsigned& nx) {
    const unsigned G = gridDim.x * gridDim.y * gridDim.z;
    unsigned sum, cnt, mine, sp = 0u;
    for (;;) {
        sum = 0u; cnt = 0u; mine = 0u;
#pragma unroll
        for (unsigned j = 0; j < 16; ++j) { const unsigned c = xb_ld(&bar[XB_XCNT(j)]); sum += c; cnt += (c > 0u) ? 1u : 0u; mine = (j == x) ? c : mine; }
        if (sum == G) break;
        __builtin_amdgcn_s_sleep(1);
        if ((++sp & 255u) == 0u) { if (xb_ld(&bar[XB_TMO])) break; if (sp > XB_SPIN_CAP) { atomicAdd(&bar[XB_TMO], 1u); break; } }
    }
    nloc = mine > 0u ? mine : 1u; nx = cnt > 0u ? cnt : 1u;
}
__device__ __forceinline__ void xcd_barrier(const XcdBarrier& b) {
    asm volatile("s_waitcnt vmcnt(0)" ::: "memory");
    __syncthreads();
    if (threadIdx.x == 0) {
        unsigned* bar = b.bar;
        __builtin_amdgcn_s_waitcnt(0);
        unsigned nloc = b.st[0], nx = b.st[1];
        if (nloc == 0u) { xcd_barrier_complete(bar, b.x, nloc, nx); b.st[0] = nloc; b.st[1] = nx; }
        const unsigned old = xb_add(&bar[XB_XSUB(b.x)], 1u);
        const unsigned gen = old / nloc;
        if (old + 1u == (gen + 1u) * nloc) {
            __builtin_amdgcn_fence(__ATOMIC_RELEASE, "agent");
            asm volatile("s_waitcnt vmcnt(0)" ::: "memory");
            const unsigned og = xb_add(&bar[XB_TOP], 1u);
            const unsigned tg = og / nx;
            asm volatile("buffer_inv sc1" ::: "memory");
            if (og + 1u == (tg + 1u) * nx) xb_add(&bar[XB_TOPGEN], 1u);
            else XB_SPIN(xb_ld(&bar[XB_TOPGEN]) == tg, bar);
            asm volatile("s_waitcnt vmcnt(0)" ::: "memory");
        } else {
            asm volatile("buffer_inv sc1" ::: "memory");
            XB_SPIN(xb_ld(&bar[XB_TOPGEN]) == gen, bar);
            asm volatile("s_waitcnt vmcnt(0)" ::: "memory");
        }
    }
    __syncthreads();
}


__device__ __forceinline__ void group_barrier(unsigned* cnt, unsigned n, unsigned* tmo, bool leader) {
    asm volatile("s_waitcnt vmcnt(0)" ::: "memory");
    __syncthreads();
    if (leader) {
        __builtin_amdgcn_fence(__ATOMIC_RELEASE, "agent");
        asm volatile("s_waitcnt vmcnt(0)" ::: "memory");
        (void)xb_add(cnt, 1u);
        unsigned sp = 0u;
        while (xb_ld(cnt) < n) { __builtin_amdgcn_s_sleep(1); if ((++sp & 255u) == 0u) { if (xb_ld(tmo)) break; if (sp > XB_SPIN_CAP) { atomicAdd(tmo, 1u); break; } } }
        __builtin_amdgcn_fence(__ATOMIC_ACQUIRE, "agent");
        asm volatile("s_waitcnt vmcnt(0)" ::: "memory");
    }
    __syncthreads();
}

__device__ __forceinline__ void group_barrier_x(unsigned* ctl, int k, int c, unsigned x, unsigned nmem, bool leader) {
    asm volatile("s_waitcnt vmcnt(0)" ::: "memory");
    __syncthreads();
    if (leader) {
        unsigned* gx = ctl + CW_GX; unsigned* tmo = ctl + CW_BAR + XB_TMO;
        const unsigned ngx = xb_ld(gx + 16 * c + (int)x);
        unsigned* tot = gx + 256 + 16 * k;
        const unsigned old = xb_add(gx + 1024 + 16 * (16 * k + (int)x), 1u);
        if (old + 1u == ngx) { __builtin_amdgcn_fence(__ATOMIC_RELEASE, "agent"); asm volatile("s_waitcnt vmcnt(0)" ::: "memory"); (void)xb_add(tot, ngx); }
        asm volatile("buffer_inv sc1" ::: "memory");
        unsigned sp = 0u;
        while (xb_ld(tot) < nmem) { __builtin_amdgcn_s_sleep(1); if ((++sp & 255u) == 0u) { if (xb_ld(tmo)) break; if (sp > XB_SPIN_CAP) { atomicAdd(tmo, 1u); break; } } }
        asm volatile("s_waitcnt vmcnt(0)" ::: "memory");
    }
    __syncthreads();
}

struct Args { const float* in[24]; float* out; unsigned char* ws; int ph_lo, ph_hi; };
struct Frame {
    LAS unsigned char* lds; unsigned char* ws; const float* const* in; float* out;
    int tid, lane, wave, vcu, G;
};
#define WSP(T, off) ((T*)(F.ws + (off)))

__device__ __forceinline__ int ropepos(int d) { return d < 32 ? 8 * (d >> 2) + (d & 3) : 8 * ((d - 32) >> 2) + 4 + (d & 3); }
__device__ __forceinline__ int in_map(int n) {
    if (n < 1024) return n;
    if (n < 2048) { const int r = n - 1024; return 1024 + (r & ~63) + ropepos(r & 63); }
    if (n < 3584) { const int seg = (n - 2048) >> 8; if (seg == 2 || seg == 4) { const int r = n - 2048; return 2048 + (r & ~63) + ropepos(r & 63); } return n; }
    if (n < 3632) return 7680 + (n - 3584);
    return 3584 + (n - 3632);
}
struct TrItem { const float* W; bf16_t* WT; int N, ldt, map, item; };
__device__ __forceinline__ void tr_load(const TrItem& d, float (&r)[32], int lane) {
    const int nblk = (d.N + 31) / 32, kb = d.item / nblk, nb = d.item % nblk, k0 = 64 * kb, n0 = 32 * nb;
    int ncol = n0 + (lane & 31); ncol = ncol < d.N ? ncol : d.N - 1;
    const float* p = d.W + (size_t)(k0 + (lane >> 5)) * d.N + ncol; const size_t st2 = (size_t)2 * d.N;
#pragma unroll
    for (int i = 0; i < 32; ++i) r[i] = p[i * st2];
}
__device__ __forceinline__ void tr_store(const TrItem& d, const float (&r)[32], LAS float* scr, int lane) {
    const int nblk = (d.N + 31) / 32, kb = d.item / nblk, nb = d.item % nblk, k0 = 64 * kb, n0 = 32 * nb;
#pragma unroll
    for (int i = 0; i < 32; ++i) scr[(2 * i + (lane >> 5)) * 33 + (lane & 31)] = r[i];
    asm volatile("s_waitcnt lgkmcnt(0)" ::: "memory");
    const int c = lane & 7;
#pragma unroll
    for (int j = 0; j < 4; ++j) { const int nl = (lane >> 3) + 8 * j, n = n0 + nl; const LAS float* s = scr + (8 * c) * 33 + nl;
        u32x4 o; o.x = pk2(s[0 * 33], s[1 * 33]); o.y = pk2(s[2 * 33], s[3 * 33]); o.z = pk2(s[4 * 33], s[5 * 33]); o.w = pk2(s[6 * 33], s[7 * 33]);
        int dr = n; if (d.map == 1) dr = in_map(n); else if (d.map == 2) dr = (n >> 7) * 256 + (n & 127); else if (d.map == 3) dr = (n >> 7) * 256 + 128 + (n & 127);
        if (n < d.N) *(u32x4*)(d.WT + (size_t)dr * d.ldt + k0 + 8 * c) = o; }
    asm volatile("s_waitcnt lgkmcnt(0)" ::: "memory");
}
namespace p0c {
constexpr int I_IN = 32 * 242, I_PP = 16 * 64, I_NP = 16 * 64, I_WO = 32 * 64, I_PM = 4 * 4 * 8, I_C1 = 32 * 8, I_C2 = 4 * 2, I_G = 32 * 16, I_D = 8 * 64;
constexpr int NSMALL = I_IN + I_PP + I_NP + I_WO + I_PM + 2 * I_C1 + 2 * I_C2;
constexpr int NITEMS = NSMALL + NE * (2 * I_G + I_D);
}
__device__ __forceinline__ void p0_transposes(Frame& F, int it0, int it1, int gw, int NGW) {
    using namespace p0c;
    LAS float* scr = (LAS float*)(F.lds + F.wave * 16384);
    const int lane = F.lane;
    const float* const* in = F.in;
    auto decode = [&](int it) -> TrItem {
        int r = it; TrItem d;
        if (r < NSMALL) {
            if (r < I_IN) { d = TrItem{in[1], WSP(bf16_t, WS_WIN), IN_COLS, DM, 1, r}; return d; } r -= I_IN;
            if (r < I_PP) { d = TrItem{in[4], WSP(bf16_t, WS_WPP), DM, DM, 0, r}; return d; } r -= I_PP;
            if (r < I_NP) { d = TrItem{in[5], WSP(bf16_t, WS_WPP) + 1024, DM, DM, 0, r}; return d; } r -= I_NP;
            if (r < I_WO) { d = TrItem{in[12], WSP(bf16_t, WS_WO), DM, DM, 0, r}; return d; } r -= I_WO;
            if (r < I_PM) { const int g = r / 32; d = TrItem{in[2] + (size_t)g * 65536, WSP(bf16_t, WS_PM) + (size_t)g * 65536, 256, 256, 0, r % 32}; return d; } r -= I_PM;
            if (r < I_C1) { d = TrItem{in[8], WSP(bf16_t, WS_CW1K), 256, 2048, 0, r}; return d; } r -= I_C1;
            if (r < I_C1) { d = TrItem{in[10], WSP(bf16_t, WS_CW1V), 256, 2048, 0, r}; return d; } r -= I_C1;
            if (r < I_C2) { d = TrItem{in[9], WSP(bf16_t, WS_CW2K), 64, 256, 0, r}; return d; } r -= I_C2;
            d = TrItem{in[11], WSP(bf16_t, WS_CW2V), 64, 256, 0, r}; return d;
        }
        r -= NSMALL;
        const int e = r / (2 * I_G + I_D); r -= e * (2 * I_G + I_D);
        if (r < I_G) { d = TrItem{in[19] + (size_t)e * DM * EH, WSP(bf16_t, WS_WGU) + (size_t)e * 1024 * DM, EH, DM, 2, r}; return d; } r -= I_G;
        if (r < I_G) { d = TrItem{in[20] + (size_t)e * DM * EH, WSP(bf16_t, WS_WGU) + (size_t)e * 1024 * DM, EH, DM, 3, r}; return d; } r -= I_G;
        d = TrItem{in[21] + (size_t)e * EH * DM, WSP(bf16_t, WS_WD) + (size_t)e * DM * EH, DM, EH, 0, r}; return d;
    };
    if (it0 + gw < it1) {
        const int last = it0 + gw + ((it1 - 1 - it0 - gw) / NGW) * NGW;
        TrItem c0 = decode(it0 + gw); float r0[32]; tr_load(c0, r0, lane);
        TrItem c1 = decode(min(it0 + gw + NGW, last)); float r1[32]; tr_load(c1, r1, lane);
#pragma unroll 1
        for (int it = it0 + gw; it < it1; it += NGW) {
            TrItem c2 = decode(min(it + 2 * NGW, last)); float r2[32]; tr_load(c2, r2, lane);
            tr_store(c0, r0, scr, lane);
#pragma unroll
            for (int i = 0; i < 32; ++i) { r0[i] = r1[i]; r1[i] = r2[i]; }
            c0 = c1; c1 = c2;
        }
    }
}
__device__ __forceinline__ void p0_prologue(Frame& F, bool moe_weights) {
    const int lane = F.lane; const float* const* in = F.in;
    if (F.wave < 4) {
      if (moe_weights) p0_transposes(F, 0, p0c::NITEMS, F.vcu * 4 + F.wave, F.G * 4);
      else { p0_transposes(F, 0, p0c::I_IN, F.vcu * 4 + F.wave, F.G * 4);
             p0_transposes(F, p0c::I_IN + p0c::I_PP + p0c::I_NP + p0c::I_WO, p0c::NSMALL, F.vcu * 4 + F.wave, F.G * 4); }
      float* cb = WSP(float, WS_CBIAS);
      for (int o = F.vcu * 4 + F.wave; o < 512; o += F.G * 4) { const int side = o >> 8, col = o & 255; const float* pos = in[side ? 7 : 6]; const float* w1 = in[side ? 10 : 8]; float s = 0.f;
          for (int k = lane; k < 2048; k += 64) s += pos[k] * w1[(size_t)k * 256 + col];
          s = wave_sum(s); if (lane == 0) cb[o] = s; }
      return; }
    const size_t gt = (size_t)F.vcu * 256 + (F.tid - 256), TT = (size_t)F.G * 256;
    { const float* x = in[0]; bf16_t* xb = WSP(bf16_t, WS_XB);
      for (size_t i = gt; i < (size_t)NT * DM / 8; i += TT) { const f32x4 a = *(const f32x4*)(x + i * 8), b = *(const f32x4*)(x + i * 8 + 4); u32x4 o; o.x = pk2(a[0], a[1]); o.y = pk2(a[2], a[3]); o.z = pk2(b[0], b[1]); o.w = pk2(b[2], b[3]); *(u32x4*)(xb + i * 8) = o; } }
    {
      const float invf[32] = {1.f, 0.749894261f, 0.562341332f, 0.421696514f, 0.316227764f, 0.237137377f, 0.177827939f, 0.133352131f, 0.100000001f, 0.0749894157f, 0.0562341325f, 0.0421696529f, 0.0316227749f, 0.0237137377f, 0.0177827943f, 0.0133352149f, 0.00999999978f, 0.00749894185f, 0.00562341325f, 0.00421696482f, 0.00316227763f, 0.00237137359f, 0.00177827943f, 0.00133352145f, 0.00100000005f, 0.000749894243f, 0.000562341302f, 0.000421696517f, 0.000316227757f, 0.00023713737f, 0.00017782794f, 0.00013335215f};
      f32x2* rt = WSP(f32x2, WS_ROPE);
      for (size_t i = gt; i < (size_t)SEQ * 32; i += TT) { const int t = (int)(i >> 5), k = (int)(i & 31);
          float fr = 1.f;
#pragma unroll
          for (int q = 0; q < 32; ++q) fr = (k == q) ? invf[q] : fr;
          const float ang = (float)t * fr; double rev = (double)ang * 0.15915494309189535; rev -= __builtin_rint(rev); const float r = (float)rev;
          rt[i] = (f32x2){__builtin_amdgcn_cosf(r), __builtin_amdgcn_sinf(r)}; } }
    {
      bf16_t* wh = WSP(bf16_t, WS_WRH); bf16_t* wl = WSP(bf16_t, WS_WRL);
      for (size_t i = gt; i < (size_t)80 * DM; i += TT) { const int r = (int)(i / DM), k = (int)(i % DM); float v = 0.f;
          if (r < 8) v = in[15][(size_t)k * 8 + r]; else if (r < 72) { const int g = (r - 8) >> 3, e = (r - 8) & 7; v = in[17][((size_t)g * DM + k) * 8 + e]; }
          const unsigned h = f2bf(v); const float hv = __builtin_bit_cast(float, h << 16);
          const size_t d = ((size_t)((k >> 5) * 5 + (r >> 4)) * 64 + ((k >> 3) & 3) * 16 + (r & 15)) * 8 + (k & 7);
          wh[d] = (bf16_t)h; wl[d] = (bf16_t)f2bf(v - hv); } }
}

__device__ __forceinline__ void p2_pool(Frame& F) {
    const bf16_t* U = WSP(bf16_t, WS_U); bf16_t* P = WSP(bf16_t, WS_POOLED);
    const bool spread = F.G == 256;
    if (spread && (F.vcu & 3) == 0) return;
    const int pv_ = spread ? F.vcu - (F.vcu >> 2) - 1 : F.vcu, pg_ = spread ? 192 : F.G; const int gt = pv_ * 512 + F.tid, TT = pg_ * 512;
    for (int it = gt; it < (NT / 16) * 128; it += TT) {
        const int cc = it & 127, rb = it >> 7, m0 = rb * 16, t0 = m0 & 4095, g = cc >> 5, w = 2 << g;
        const bf16_t* up = U + (size_t)m0 * PW + cc * 8;
        const bool hist = t0 != 0;
        u32x4 h[15], c[16];
#pragma unroll
        for (int j = 1; j <= 15; ++j) h[j - 1] = *(const u32x4*)(up - (size_t)(hist ? j : 0) * PW);
#pragma unroll
        for (int i = 0; i < 16; ++i) c[i] = *(const u32x4*)(up + (size_t)i * PW);
#pragma unroll
        for (int j = 1; j <= 15; ++j) if (!(hist && j < w)) h[j - 1] = (u32x4){0u, 0u, 0u, 0u};
        f32x4 s0 = (f32x4){0.f, 0.f, 0.f, 0.f}, s1 = s0;
#pragma unroll
        for (int j = 1; j <= 15; ++j) { const u32x4 q = h[j - 1]; s0 += (f32x4){bflo(q.x), bfhi(q.x), bflo(q.y), bfhi(q.y)}; s1 += (f32x4){bflo(q.z), bfhi(q.z), bflo(q.w), bfhi(q.w)}; }
#pragma unroll
        for (int i = 0; i < 16; ++i) { const int t = t0 + i; const u32x4 q = c[i];
            const f32x4 a = (f32x4){bflo(q.x), bfhi(q.x), bflo(q.y), bfhi(q.y)}, b = (f32x4){bflo(q.z), bfhi(q.z), bflo(q.w), bfhi(q.w)};
            s0 += a; s1 += b;
            const float inv = 1.f / (float)((t + 1 < w) ? (t + 1) : w);
            store8(P + (size_t)(m0 + i) * PW + cc * 8, s0 * inv - a, s1 * inv - b);
            const int k2 = i - 1, k4 = i - 3, k8 = i - 7, k16 = i - 15;
            const u32x4 l2 = k2 >= 0 ? c[k2 >= 0 ? k2 : 0] : h[k2 < 0 ? -k2 - 1 : 0], l4 = k4 >= 0 ? c[k4 >= 0 ? k4 : 0] : h[k4 < 0 ? -k4 - 1 : 0];
            const u32x4 l8 = k8 >= 0 ? c[k8 >= 0 ? k8 : 0] : h[k8 < 0 ? -k8 - 1 : 0], l16 = k16 >= 0 ? c[k16 >= 0 ? k16 : 0] : h[k16 < 0 ? -k16 - 1 : 0];
            const u32x4 lv = g == 0 ? l2 : g == 1 ? l4 : g == 2 ? l8 : l16;
            s0 -= (f32x4){bflo(lv.x), bfhi(lv.x), bflo(lv.y), bfhi(lv.y)}; s1 -= (f32x4){bflo(lv.z), bfhi(lv.z), bflo(lv.w), bfhi(lv.w)}; }
    }
}

__device__ __forceinline__ void p3_cmp2(Frame& F, int wg_index, int wg_count) {
    const int gw = wg_index * 8 + F.wave, NGW = wg_count * 8, lane = F.lane, fr = lane & 15, kg = lane >> 4;
    const f32x2* rope = WSP(f32x2, WS_ROPE);
    for (int it = gw; it < 512; it += NGW) {
        const int side = it >> 8, rb = it & 255, r0 = rb * 16;
        const float* P0 = WSP(float, WS_CMPP) + ((size_t)(side * 2) * 4096 + r0 + fr) * 256 + kg * 8; const float* P1 = P0 + (size_t)4096 * 256;
        const bf16_t* W = WSP(bf16_t, side ? WS_CW2V : WS_CW2K) + (size_t)fr * 256 + kg * 8;
        f32x4 acc[4];
#pragma unroll
        for (int nb = 0; nb < 4; ++nb) acc[nb] = (f32x4){0.f, 0.f, 0.f, 0.f};
#pragma unroll
        for (int sh = 0; sh < 2; ++sh) {
            f32x4 pa[4][2], pb[4][2]; bf16x8 wf[4][4];
#pragma unroll
            for (int s4 = 0; s4 < 4; ++s4) { const int s = sh * 4 + s4; pa[s4][0] = *(const f32x4*)(P0 + s * 32); pa[s4][1] = *(const f32x4*)(P0 + s * 32 + 4); pb[s4][0] = *(const f32x4*)(P1 + s * 32); pb[s4][1] = *(const f32x4*)(P1 + s * 32 + 4);
#pragma unroll
                for (int nb = 0; nb < 4; ++nb) wf[s4][nb] = *(const bf16x8*)(W + (size_t)nb * 16 * 256 + s * 32); }
            asm volatile("" ::: "memory");
#pragma unroll
            for (int s4 = 0; s4 < 4; ++s4) { f32x4 v0 = pa[s4][0] + pb[s4][0], v1 = pa[s4][1] + pb[s4][1];
#pragma unroll
                for (int j = 0; j < 4; ++j) { v0[j] = gelu_tanh(v0[j]); v1[j] = gelu_tanh(v1[j]); }
                u32x4 aw; aw.x = cvt_pk_bf16(v0[0], v0[1]); aw.y = cvt_pk_bf16(v0[2], v0[3]); aw.z = cvt_pk_bf16(v1[0], v1[1]); aw.w = cvt_pk_bf16(v1[2], v1[3]);
                const bf16x8 a = __builtin_bit_cast(bf16x8, aw);
#pragma unroll
                for (int nb = 0; nb < 4; ++nb) acc[nb] = __builtin_amdgcn_mfma_f32_16x16x32_bf16(a, wf[s4][nb], acc[nb], 0, 0, 0); } }
        bf16_t* out = WSP(bf16_t, side ? WS_VCMP : WS_KCMP);
#pragma unroll
        for (int r = 0; r < 4; ++r) { const int row = r0 + 4 * kg + r, c = row & 255;
            if (side == 0) { const int pos = c * 16 + 31;
#pragma unroll
                for (int nb = 0; nb < 2; ++nb) { const int i = nb * 16 + fr; const f32x2 cs = rope[(size_t)(pos & 4095) * 32 + i]; const float x1 = acc[nb][r], x2 = acc[nb + 2][r];
                    out[(size_t)row * 64 + ropepos(i)] = (bf16_t)f2bf(x1 * cs.x - x2 * cs.y); out[(size_t)row * 64 + ropepos(i + 32)] = (bf16_t)f2bf(x2 * cs.x + x1 * cs.y); }
            } else {
#pragma unroll
                for (int nb = 0; nb < 4; ++nb) out[(size_t)row * 64 + nb * 16 + fr] = (bf16_t)f2bf(acc[nb][r]); } }
    }
}

#ifdef DBG_TIME
#define PSTAMP(k) do { if (F.vcu == 0 && F.tid == 0) ((unsigned long long*)(F.ws + 131072))[k] = __builtin_amdgcn_s_memrealtime(); } while (0)
#define PSTAMP1(k) do { if (F.vcu == 1 && F.tid == 0) ((unsigned long long*)(F.ws + 131072))[k] = __builtin_amdgcn_s_memrealtime(); } while (0)
#else
#define PSTAMP(k) do {} while (0)
#define PSTAMP1(k) do {} while (0)
#endif
namespace att {
constexpr int XSLOT = 143360;
constexpr int KV0 = 0, SLOTB = 16384, NSLOT = 4, IMP = 65536, IMPLD = 65, OST = 65536, WSF = 135168, SEL = 137216, UNI = 137728, IMPL = 137792;
constexpr float THR = 8.f;
__device__ __forceinline__ int crow(int r, int hi) { return (r & 3) + 8 * (r >> 2) + 4 * hi; }
__device__ __forceinline__ s16x4 vtr(const LAS char* p) { return __builtin_bit_cast(s16x4, __builtin_amdgcn_ds_read_tr16_b64_v4i16((LAS s16x4*)p)); }
__device__ __forceinline__ float swap_max(float m) { auto rr = __builtin_amdgcn_permlane32_swap(__float_as_uint(m), __float_as_uint(m), false, false); return fmaxf(__uint_as_float(rr[0]), __uint_as_float(rr[1])); }
__device__ __forceinline__ float swap_sum(float m) { auto rr = __builtin_amdgcn_permlane32_swap(__float_as_uint(m), __float_as_uint(m), false, false); return __uint_as_float(rr[0]) + __uint_as_float(rr[1]); }
__device__ __forceinline__ float swap_other(float m, int hi) { auto rr = __builtin_amdgcn_permlane32_swap(__float_as_uint(m), __float_as_uint(m), false, false); return __uint_as_float(hi ? rr[0] : rr[1]); }
__device__ __forceinline__ float rowmax32(const f32x16& p0, const f32x16& p1) {
    float a = fmaxf(p0[0], p1[0]);
#pragma unroll
    for (int r = 1; r < 16; ++r) a = fmaxf(a, fmaxf(p0[r], p1[r]));
    return swap_max(a);
}
__device__ __forceinline__ void tile_dma(const bf16_t* Kg, const bf16_t* Vg, int row0, LAS char* slot, int wid, int lane) {
    unsigned koff = (unsigned)(lane * 64 + wid * 8) * 2u;
    unsigned voff = (unsigned)((16 * (wid & 3) + (lane >> 2)) * 64 + (wid >> 2) * 32 + (lane & 3) * 8) * 2u;
    asm volatile("" : "+v"(koff), "+v"(voff));
    const char* kbase = (const char*)Kg + (size_t)row0 * 128; const char* vbase = (const char*)Vg + (size_t)row0 * 128;
    __builtin_amdgcn_global_load_lds((const unsigned*)(kbase + koff), (LAS unsigned*)(slot + wid * 1024), 16, 0, 0);
    __builtin_amdgcn_global_load_lds((const unsigned*)(vbase + voff), (LAS unsigned*)(slot + 8192 + wid * 1024), 16, 0, 0);
}
#define ATT_WAIT_V(n) asm volatile("s_waitcnt vmcnt(" #n ")" ::: "memory")
__device__ __forceinline__ void qkt(f32x16& p0, f32x16& p1, const LAS char* kslot, const bf16x8 (&qr)[4], int r32, int hi, const f32x16& cinit) {
    const LAS char* kb = kslot + hi * 1024 + r32 * 16;
    p0 = cinit; p1 = cinit;
#pragma unroll
    for (int d0 = 0; d0 < 4; ++d0) { const bf16x8 b0 = *(const LAS bf16x8*)(kb + d0 * 2048), b1 = *(const LAS bf16x8*)(kb + d0 * 2048 + 512);
        p0 = __builtin_amdgcn_mfma_f32_32x32x16_bf16(b0, qr[d0], p0, 0, 0, 0); p1 = __builtin_amdgcn_mfma_f32_32x32x16_bf16(b1, qr[d0], p1, 0, 0, 0); }
}
__device__ __forceinline__ bf16x8 pack8(const f32x16& p, int base) {
    u32x4 w; w.x = cvt_pk_bf16(p[base], p[base + 1]); w.y = cvt_pk_bf16(p[base + 2], p[base + 3]); w.z = cvt_pk_bf16(p[base + 4], p[base + 5]); w.w = cvt_pk_bf16(p[base + 6], p[base + 7]);
    return __builtin_bit_cast(bf16x8, w);
}
__device__ __forceinline__ void pv(f32x16 (&o)[2], const LAS char* vslot, const bf16x8 (&pa)[4], int lane, int hi) {
    const LAS char* vb = vslot + ((lane >> 4) & 1) * 32 + (lane & 3) * 8 + (4 * hi + ((lane & 15) >> 2)) * 64;
#pragma unroll
    for (int dh = 0; dh < 2; ++dh) {
#pragma unroll
        for (int ks = 0; ks < 4; ++ks) { const s16x4 lo = vtr(vb + dh * 4096 + ks * 1024), hh = vtr(vb + dh * 4096 + ks * 1024 + 512);
            const bf16x8 vf = (bf16x8){lo[0], lo[1], lo[2], lo[3], hh[0], hh[1], hh[2], hh[3]};
            o[dh] = __builtin_amdgcn_mfma_f32_32x32x16_bf16(pa[ks], vf, o[dh], 0, 0, 0); } }
}
__device__ __forceinline__ void kmask(f32x16& p0, f32x16& p1, int klo, int khi, int hi) {
#pragma unroll
    for (int r = 0; r < 16; ++r) { const int k0 = crow(r, hi); if (k0 < klo || k0 > khi) p0[r] = -INFINITY; if (k0 + 32 < klo || k0 + 32 > khi) p1[r] = -INFINITY; }
}
__device__ __forceinline__ void acc_scaled(f32x16 (&ofin)[2], const f32x16 (&o)[2], volatile LAS float* wsf, float scale, int r32, int hi) {
    if (hi == 0) wsf[r32] = scale;
    asm volatile("s_waitcnt lgkmcnt(0)" ::: "memory");
#pragma unroll
    for (int r = 0; r < 16; ++r) { const float f = wsf[crow(r, hi)]; ofin[0][r] += o[0][r] * f; ofin[1][r] += o[1][r] * f; }
    asm volatile("s_waitcnt lgkmcnt(0)" ::: "memory");
}
__device__ __forceinline__ void acc_scaled_lds(LAS float* stg, const f32x16 (&o)[2], volatile LAS float* wsf, float scale, int r32, int hi) {
    if (hi == 0) wsf[r32] = scale;
    asm volatile("s_waitcnt lgkmcnt(0)" ::: "memory");
#pragma unroll
    for (int r = 0; r < 16; ++r) { const int orow = crow(r, hi); const float f = wsf[orow]; stg[orow * 64 + r32] += o[0][r] * f; stg[orow * 64 + 32 + r32] += o[1][r] * f; }
    asm volatile("s_waitcnt lgkmcnt(0)" ::: "memory");
}
__device__ __forceinline__ void qk_half(f32x16& p, const LAS char* kb, const bf16x8 (&qr)[4], const bf16x8& kone, const bf16x8& qa) {
    p = __builtin_amdgcn_mfma_f32_32x32x16_bf16(kone, qa, (f32x16){}, 0, 0, 0);
#pragma unroll
    for (int d0 = 0; d0 < 4; ++d0) p = __builtin_amdgcn_mfma_f32_32x32x16_bf16(*(const LAS bf16x8*)(kb + d0 * 2048), qr[d0], p, 0, 0, 0);
}
__device__ __forceinline__ float rowmax16(const f32x16& p) {
    float a = fmaxf(p[0], p[1]);
#pragma unroll
    for (int r = 2; r < 16; r += 2) a = fmaxf(a, fmaxf(p[r], p[r + 1]));
    return swap_max(a);
}
#define ATT_TR(dst, off) asm volatile("ds_read_b64_tr_b16 %0, %1 offset:%2" : "=&v"(dst) : "v"(vb), "i"(off) : "memory")
template <int HF>
__device__ __forceinline__ void pv_half(f32x16 (&o)[2], const LAS char* vb, const bf16x8& pa0, const bf16x8& pa1) {
    s16x4 l0, h0, l1, h1, l2, h2, l3, h3;
    ATT_TR(l0, (2 * HF) * 1024); ATT_TR(h0, (2 * HF) * 1024 + 512); ATT_TR(l1, (2 * HF + 1) * 1024); ATT_TR(h1, (2 * HF + 1) * 1024 + 512);
    ATT_TR(l2, 4096 + (2 * HF) * 1024); ATT_TR(h2, 4096 + (2 * HF) * 1024 + 512); ATT_TR(l3, 4096 + (2 * HF + 1) * 1024); ATT_TR(h3, 4096 + (2 * HF + 1) * 1024 + 512);
    asm volatile("s_waitcnt lgkmcnt(4)" : "+v"(l0), "+v"(h0), "+v"(l1), "+v"(h1) :: "memory");
    o[0] = __builtin_amdgcn_mfma_f32_32x32x16_bf16(pa0, (bf16x8){l0[0], l0[1], l0[2], l0[3], h0[0], h0[1], h0[2], h0[3]}, o[0], 0, 0, 0);
    o[0] = __builtin_amdgcn_mfma_f32_32x32x16_bf16(pa1, (bf16x8){l1[0], l1[1], l1[2], l1[3], h1[0], h1[1], h1[2], h1[3]}, o[0], 0, 0, 0);
    asm volatile("s_waitcnt lgkmcnt(0)" : "+v"(l2), "+v"(h2), "+v"(l3), "+v"(h3) :: "memory");
    o[1] = __builtin_amdgcn_mfma_f32_32x32x16_bf16(pa0, (bf16x8){l2[0], l2[1], l2[2], l2[3], h2[0], h2[1], h2[2], h2[3]}, o[1], 0, 0, 0);
    o[1] = __builtin_amdgcn_mfma_f32_32x32x16_bf16(pa1, (bf16x8){l3[0], l3[1], l3[2], l3[3], h3[0], h3[1], h3[2], h3[3]}, o[1], 0, 0, 0);
}
template <int MODE>
__device__ __forceinline__ void branch(LAS float* stg, const bf16_t* Kg, const bf16_t* Vg, int dj, u64 rest, int tj, u64 selmask, float gate, int qq,
                                       const bf16x8 (&qr)[4], LAS char* lds, int wid, int lane, int r32, int hi, LAS char* slot0) {
    volatile LAS float* wsf = (volatile LAS float*)(lds + WSF) + wid * 64;
    f32x16 o[2]; o[0] = (f32x16){}; o[1] = (f32x16){};
    float m = 0.f, l = 0.f;
    const int total = 1 + __builtin_popcountll(rest);
    const unsigned onem = hi == 0 ? 0x3F803F80u : 0u;
    const bf16x8 kone = __builtin_bit_cast(bf16x8, (u32x4){onem, onem & 0xffffu, 0u, 0u});
    u32x4 qaw = (u32x4){0u, 0u, 0u, 0u};
    int j0 = dj, j1 = 0, j2 = 0;
    if (total > 1) { j1 = __builtin_ctzll(rest); rest &= rest - 1ull; tile_dma(Kg, Vg, j1 * 64, lds + KV0 + SLOTB, wid, lane); }
#pragma unroll 1
    for (int i = 0; i < total; ++i) {
        if (i + 2 < total) { j2 = __builtin_ctzll(rest); rest &= rest - 1ull; tile_dma(Kg, Vg, j2 * 64, lds + KV0 + ((i + 2) & 3) * SLOTB, wid, lane); }
        const int ahead = (total - 1 - i) < 2 ? (total - 1 - i) : 2;
        if (ahead == 2) ATT_WAIT_V(4); else if (ahead == 1) ATT_WAIT_V(2); else ATT_WAIT_V(0);
        __builtin_amdgcn_s_barrier(); asm volatile("" ::: "memory");
        const int cj = j0;
        const LAS char* ks = i == 0 ? slot0 : lds + KV0 + (i & 3) * SLOTB;
        const LAS char* kb = ks + hi * 1024 + r32 * 16;
        const LAS char* vb = ks + 8192 + ((lane >> 4) & 1) * 32 + (lane & 3) * 8 + (4 * hi + ((lane & 15) >> 2)) * 64;
        if (MODE == 0 && i > 0) qaw[1] = (hi == 0 && !((selmask >> cj) & 1ull)) ? 0x0000C6EAu : 0u;
        const bf16x8 qa = __builtin_bit_cast(bf16x8, qaw);
        f32x16 p0, p1; qk_half(p0, kb, qr, kone, qa); __builtin_amdgcn_sched_barrier(0); qk_half(p1, kb + 512, qr, kone, qa);
        if (i == 0) {
            kmask(p0, p1, 0, qq, hi);
            const float rm = rowmax32(p0, p1);
            const unsigned mh = f2bf(-rm); const float mhf = __builtin_bit_cast(float, mh << 16); const unsigned ml = f2bf(-rm - mhf);
            m = -(mhf + __builtin_bit_cast(float, ml << 16));
            qaw[0] = hi == 0 ? (mh | (ml << 16)) : 0u;
#pragma unroll
            for (int r = 0; r < 16; ++r) { p0[r] -= m; p1[r] -= m; }
        } else if (MODE == 1 && cj == tj) kmask(p0, p1, qq + 1, 63, hi);
        {
            const float rm = rowmax32(p0, p1);
            if (i > 0 && __any(rm > THR)) {
                const float mt = m + fmaxf(rm, 0.f);
                const unsigned mh = f2bf(-mt); const float mhf = __builtin_bit_cast(float, mh << 16); const unsigned ml = f2bf(-mt - mhf);
                const float mn = -(mhf + __builtin_bit_cast(float, ml << 16)), dl = mn - m, f = fast_exp2(-dl);
                m = mn; l *= f; qaw[0] = hi == 0 ? (mh | (ml << 16)) : 0u;
                if (hi == 0) wsf[r32] = f;
                asm volatile("s_waitcnt lgkmcnt(0)" ::: "memory");
#pragma unroll
                for (int r = 0; r < 16; ++r) { const float ff = wsf[crow(r, hi)]; o[0][r] *= ff; o[1][r] *= ff; p0[r] -= dl; p1[r] -= dl; }
                asm volatile("s_waitcnt lgkmcnt(0)" ::: "memory"); }
#pragma unroll
            for (int r = 0; r < 16; ++r) p0[r] = fast_exp2(p0[r]);
            { const bf16x8 pa0 = pack8(p0, 0), pa1 = pack8(p0, 8); pv_half<0>(o, vb, pa0, pa1); }
#pragma unroll
            for (int r = 0; r < 16; ++r) p1[r] = fast_exp2(p1[r]);
            { const bf16x8 pa2 = pack8(p1, 0), pa3 = pack8(p1, 8); pv_half<1>(o, vb, pa2, pa3); }
            float s0 = (p0[0] + p0[1]) + (p0[2] + p0[3]), s1 = (p0[4] + p0[5]) + (p0[6] + p0[7]), s2 = (p0[8] + p0[9]) + (p0[10] + p0[11]), s3 = (p0[12] + p0[13]) + (p0[14] + p0[15]);
            s0 += (p1[0] + p1[1]) + (p1[2] + p1[3]); s1 += (p1[4] + p1[5]) + (p1[6] + p1[7]); s2 += (p1[8] + p1[9]) + (p1[10] + p1[11]); s3 += (p1[12] + p1[13]) + (p1[14] + p1[15]);
            l += (s0 + s1) + (s2 + s3);
        }
        j0 = j1; j1 = j2;
    }
    asm volatile("s_waitcnt lgkmcnt(0)" ::: "memory");
    __builtin_amdgcn_s_barrier(); asm volatile("" ::: "memory");
    const float lt = swap_sum(l);
    acc_scaled_lds(stg, o, wsf, gate / lt, r32, hi);
}

__device__ __forceinline__ void unit(Frame& F, int b, int g, int qb) {
    LAS char* lds = (LAS char*)F.lds;
    const int lane = F.lane, wid = F.wave, r32 = lane & 31, hi = lane >> 5;
    const int hl = wid >> 1, h = g * 4 + hl, qq = (wid & 1) * 32 + r32, t = qb * 64 + qq;
    const size_t kvoff = (size_t)(b * NG + g) * SEQ * HD;
    bf16x8 qr[4];
    { const char* qbase = (const char*)(WSP(bf16_t, WS_Q) + ((size_t)(b * NH + h) * SEQ + qb * 64) * HD);
      unsigned qoff = (unsigned)(qq * HD + hi * 8) * 2u; asm volatile("" : "+v"(qoff));
#pragma unroll
      for (int d0 = 0; d0 < 4; ++d0) qr[d0] = *(const bf16x8*)(qbase + qoff + d0 * 32); }
    float g0, g1, g2;
    { const char* gbase = (const char*)(WSP(float, WS_GN) + ((size_t)b * SEQ + qb * 64) * 64 + h); unsigned goff = (unsigned)qq * 256u; asm volatile("" : "+v"(goff));
      g0 = *(const float*)(gbase + goff); g1 = *(const float*)(gbase + goff + 64); g2 = *(const float*)(gbase + goff + 128); }
    volatile LAS float* wsf = (volatile LAS float*)(lds + WSF) + wid * 64;
    f32x16 ofin[2]; ofin[0] = (f32x16){}; ofin[1] = (f32x16){};

    {
        const bf16_t* Kc = WSP(bf16_t, WS_KCMP) + (size_t)(b * NG + g) * 256 * HD; const bf16_t* Vc = WSP(bf16_t, WS_VCMP) + (size_t)(b * NG + g) * 256 * HD;
        const int nct = (4 * qb + 2) / 64 + 1;
        const int cmax = (t >= 31) ? ((t - 31) >> 4) : -1;
        float m = -INFINITY; const f32x16 zero16 = (f32x16){};
        for (int T = 0; T < nct; ++T) tile_dma(Kc, Vc, T * 64, lds + KV0 + T * SLOTB, wid, lane);
        ATT_WAIT_V(0);
        __builtin_amdgcn_s_barrier(); asm volatile("" ::: "memory");
        for (int T = 0; T < nct; ++T) {
            f32x16 p0, p1; qkt(p0, p1, lds + KV0 + T * SLOTB, qr, r32, hi, zero16);
            if (!__all(cmax - T * 64 >= 63)) kmask(p0, p1, 0, cmax - T * 64, hi);
            m = fmaxf(m, rowmax32(p0, p1));
        }
        if (m == -INFINITY) m = 0.f;
        f32x16 o[2]; o[0] = (f32x16){}; o[1] = (f32x16){}; float l = 0.f, prev_last = 0.f;
        LAS float* impl = (LAS float*)(lds + IMP) + (size_t)(hl * 64 + qq) * IMPLD;
#pragma unroll 1
        for (int T = 0; T < nct; ++T) {
            f32x16 p0, p1; qkt(p0, p1, lds + KV0 + T * SLOTB, qr, r32, hi, zero16);
            if (!__all(cmax - T * 64 >= 63)) kmask(p0, p1, 0, cmax - T * 64, hi);
            float s = 0.f;
#pragma unroll
            for (int r = 0; r < 16; ++r) { p0[r] = fast_exp2(p0[r] - m); p1[r] = fast_exp2(p1[r] - m); s += p0[r] + p1[r]; }
            l += s;
            { bf16x8 pa[4]; pa[0] = pack8(p0, 0); pa[1] = pack8(p0, 8); pa[2] = pack8(p1, 0); pa[3] = pack8(p1, 8); pv(o, lds + KV0 + T * SLOTB + 8192, pa, lane, hi); }
#pragma unroll
            for (int hf = 0; hf < 2; ++hf)
#pragma unroll
                for (int a = 0; a < 4; ++a) { const float e0 = hf ? p1[4 * a] : p0[4 * a], e1 = hf ? p1[4 * a + 1] : p0[4 * a + 1], e2 = hf ? p1[4 * a + 2] : p0[4 * a + 2], e3 = hf ? p1[4 * a + 3] : p0[4 * a + 3];
                    const float send = hi ? prev_last : e3;
                    impl[2 * (8 * T + 4 * hf + a) + hi] = ((e0 + e1) + (e2 + e3)) + swap_other(send, hi);
                    prev_last = e3; }
        }
        const float lt = swap_sum(l), inv = lt > 0.f ? 1.f / lt : 0.f;
        if (hi == 0) ((LAS float*)(lds + IMPL))[hl * 64 + qq] = inv;
        acc_scaled(ofin, o, wsf, g0 * inv, r32, hi);
    }
    __syncthreads();
    tile_dma(WSP(bf16_t, WS_KW) + kvoff, WSP(bf16_t, WS_VW) + kvoff, qb * 64, lds + XSLOT, wid, lane);
    tile_dma(WSP(bf16_t, WS_KS) + kvoff, WSP(bf16_t, WS_VS) + kvoff, qb * 64, lds + KV0, wid, lane);
    {
        u64 un = 0ull; const LAS float* impb = (const LAS float*)(lds + IMP);
        for (int i = 0; i < 8; ++i) { const int q = wid * 8 + i;
            const LAS float* il = (const LAS float*)(lds + IMPL);
            float v = ((impb[(0 * 64 + q) * IMPLD + lane] * il[q] + impb[(1 * 64 + q) * IMPLD + lane] * il[64 + q]) + impb[(2 * 64 + q) * IMPLD + lane] * il[128 + q]) + impb[(3 * 64 + q) * IMPLD + lane] * il[192 + q];
            if (lane > qb) v = 0.f;
            unsigned key = (__float_as_uint(v) & ~63u) | (unsigned)(63 - lane);
            if (lane == 0 || lane == qb || lane == qb - 1) key = 0xFFFFFFC0u | (unsigned)(63 - lane); else if (lane > qb) key = (unsigned)(63 - lane);
            volatile LAS unsigned* kq = (volatile LAS unsigned*)(lds + WSF) + wid * 64;
            kq[lane] = key;
            asm volatile("s_waitcnt lgkmcnt(0)" ::: "memory");
            int rank = 0;
#pragma unroll
            for (int c = 0; c < 16; ++c) { const u32x4 kk = *(const LAS u32x4*)((const LAS unsigned*)(lds + WSF) + wid * 64 + 4 * c); rank += (kk.x > key ? 1 : 0) + (kk.y > key ? 1 : 0) + (kk.z > key ? 1 : 0) + (kk.w > key ? 1 : 0); }
            asm volatile("s_waitcnt lgkmcnt(0)" ::: "memory");
            const u64 mk = __ballot(rank < 16);
            if (lane == 0) *(LAS u64*)(lds + SEL + q * 8) = mk;
            un |= mk; }
        if (lane == 0) *(LAS u64*)(lds + UNI + wid * 8) = un;
    }
    __syncthreads();
    LAS float* stg = (LAS float*)(lds + OST) + wid * 2048;
#pragma unroll
    for (int r = 0; r < 16; ++r) { const int orow = crow(r, hi); stg[orow * 64 + r32] = ofin[0][r]; stg[orow * 64 + 32 + r32] = ofin[1][r]; }
    const u64 selmask = *(const LAS u64*)(lds + SEL + qq * 8);
    u64 uni = 0ull;
#pragma unroll
    for (int i = 0; i < 8; ++i) uni |= *(const LAS u64*)(lds + UNI + i * 8);
    uni = ((u64)(unsigned)__builtin_amdgcn_readfirstlane((int)(uni >> 32)) << 32) | (u64)(unsigned)__builtin_amdgcn_readfirstlane((int)(uni & 0xffffffffull));
    const u64 below = (qb == 0) ? 0ull : ((1ull << qb) - 1ull);
    branch<0>(stg, WSP(bf16_t, WS_KS) + kvoff, WSP(bf16_t, WS_VS) + kvoff, qb, uni & below, -1, selmask, g1, qq, qr, lds, wid, lane, r32, hi, lds + KV0);
    { const int lo = qb >= 8 ? qb - 8 : 0; const u64 wrest = below & ~((lo == 0) ? 0ull : ((1ull << lo) - 1ull));
      branch<1>(stg, WSP(bf16_t, WS_KW) + kvoff, WSP(bf16_t, WS_VW) + kvoff, qb, wrest, qb >= 8 ? qb - 8 : -1, 0ull, g2, qq, qr, lds, wid, lane, r32, hi, lds + XSLOT); }
    { asm volatile("s_waitcnt lgkmcnt(0)" ::: "memory");
      char* obase = (char*)(WSP(bf16_t, WS_AO) + ((size_t)b * SEQ + qb * 64 + (wid & 1) * 32) * DM + 1024 + h * 64);
#pragma unroll
      for (int i = 0; i < 4; ++i) { const int row = i * 8 + (lane >> 3), ch = lane & 7; const f32x4 v0 = *(const LAS f32x4*)(stg + row * 64 + ch * 8), v1 = *(const LAS f32x4*)(stg + row * 64 + ch * 8 + 4); unsigned ooff = (unsigned)(row * DM + ch * 8) * 2u; asm volatile("" : "+v"(ooff)); store8((bf16_t*)(obase + ooff), v0, v1); } }
    __syncthreads();
}
__device__ __forceinline__ void phase(Frame& F) {
    for (int L = F.vcu; L < 256; L += F.G) { const int bg = L >> 4, s = L & 15;
        for (int i = 0; i < 4; ++i) { const int qb = (i == 0) ? s : (i == 1) ? 31 - s : (i == 2) ? 32 + s : 63 - s; unit(F, bg >> 2, bg & 3, qb); } }
}
#ifndef CONV_P1_ITEMS
#define CONV_P1_ITEMS (64 * 8 * 6)
#endif
#ifndef CONV_P2_ITEMS
#define CONV_P2_ITEMS (192 * 8 * 3)
#endif
#ifndef CONV_EVERY
#define CONV_EVERY 2
#endif
__device__ __forceinline__ void phase_dyn(Frame& F, unsigned* ctl) {
    if ((F.vcu & 1) && (F.vcu & 7) != 7) { p0_transposes(F, p0c::NSMALL + CONV_P1_ITEMS + CONV_P2_ITEMS, p0c::NITEMS, ((F.vcu >> 3) * 3 + ((F.vcu & 7) >> 1)) * 8 + F.wave, 96 * 8); __syncthreads();
#ifdef DBG_TIME
        if (F.vcu == CONV_EVERY - 1 && F.tid == 0) ((unsigned long long*)(F.ws + 131072))[13] = __builtin_amdgcn_s_memrealtime();
#endif
    }
    volatile LAS unsigned* slot = (volatile LAS unsigned*)(F.lds + MISC_OFF) + 24;
    const int q0 = F.vcu >> 5;
#pragma unroll 1
    for (int qi = 0; qi < 8; ++qi) { const int q = (q0 + qi) & 7;
#pragma unroll 1
        for (;;) {
            if (F.tid == 0) { unsigned u = 128u; if (qi == 0 || xb_ld(ctl + CW_ATQ + q) < 128u) u = xb_add(ctl + CW_ATQ + q, 1u); *slot = u; }
            __syncthreads();
            const int u = __builtin_amdgcn_readfirstlane((int)*slot);
            __syncthreads();
            if (u >= 128) break;
            const int bg = 2 * q + (u & 1), qb = 63 - (u >> 1);
            unit(F, bg >> 2, bg & 3, qb);
        }
    }
}
}

__device__ __forceinline__ void p7_router(Frame& F, unsigned* ctl) {
    constexpr int CLD = 260;
    LAS float* chunk = (LAS float*)F.lds;
    LAS float* slab = (LAS float*)F.lds;
    LAS float* lgs = (LAS float*)(F.lds + 81920);
    LAS float* st = (LAS float*)(F.lds + 110592);
    const int tid = F.tid, lane = F.lane, wid = F.wave, fr = lane & 15, kg = lane >> 4;
    const bf16_t* V1B = WSP(bf16_t, WS_V1B); const float* g1 = F.in[13]; const float* b1 = F.in[14];
    bf16_t* H1B = WSP(bf16_t, WS_H1B); const float* PS = WSP(float, WS_PS);
    const bf16_t* WRH = WSP(bf16_t, WS_WRH); const bf16_t* WRL = WSP(bf16_t, WS_WRL);
    for (int ub = F.vcu; ub < NT / 64; ub += F.G) {
        const int m0 = ub * 64;
        if (tid < 64) { const float* pr = PS + (size_t)(m0 + tid) * 64; float sv = 0.f, qv = 0.f;
#pragma unroll
            for (int j = 0; j < 16; ++j) { const f32x4 t4 = *(const f32x4*)(pr + j * 4); sv += t4[0] + t4[2]; qv += t4[1] + t4[3]; }
            const float mean = sv * (1.f / DM), var = fmaxf(qv * (1.f / DM) - mean * mean, 0.f);
            st[tid * 2] = mean; st[tid * 2 + 1] = 1.f / sqrtf(var + LN_EPS); }
        __syncthreads();
        PSTAMP(14);
        float mu[4], rsd[4];
#pragma unroll
        for (int rg = 0; rg < 4; ++rg) { mu[rg] = st[(rg * 16 + fr) * 2]; rsd[rg] = st[(rg * 16 + fr) * 2 + 1]; }
        f32x4 acc[4][5];
#pragma unroll
        for (int rg = 0; rg < 4; ++rg)
#pragma unroll
            for (int nb = 0; nb < 5; ++nb) acc[rg][nb] = (f32x4){0.f, 0.f, 0.f, 0.f};
        const bf16_t* xl = V1B + (size_t)(m0 + fr) * DM + wid * 32 + kg * 8;
        bf16_t* hl = H1B + (size_t)(m0 + fr) * DM + wid * 32 + kg * 8;
        u32x4 xv[4];
#pragma unroll
        for (int rg = 0; rg < 4; ++rg) xv[rg] = *(const u32x4*)(xl + (size_t)rg * 16 * DM);
#pragma unroll 1
        for (int c = 0; c < 8; ++c) {
            const int k0 = c * 256, kn = (c < 7 ? c + 1 : 7) * 256, kk = k0 + wid * 32 + kg * 8;
            bf16x8 Bh[5], Bl[5];
#pragma unroll
            for (int nb = 0; nb < 5; ++nb) { const size_t fo = ((size_t)((c * 8 + wid) * 5 + nb) * 64 + lane) * 8; Bh[nb] = *(const bf16x8*)(WRH + fo); Bl[nb] = *(const bf16x8*)(WRL + fo); }
            const f32x4 ga0 = *(const f32x4*)(g1 + kk), ga1 = *(const f32x4*)(g1 + kk + 4), be0 = *(const f32x4*)(b1 + kk), be1 = *(const f32x4*)(b1 + kk + 4);
            u32x4 xn[4];
#pragma unroll
            for (int rg = 0; rg < 4; ++rg) xn[rg] = *(const u32x4*)(xl + (size_t)rg * 16 * DM + kn);
#pragma unroll
            for (int rg = 0; rg < 4; ++rg) { const u32x4 q = xv[rg];
                const f32x4 x0 = (f32x4){bflo(q.x), bfhi(q.x), bflo(q.y), bfhi(q.y)}, x1 = (f32x4){bflo(q.z), bfhi(q.z), bflo(q.w), bfhi(q.w)};
                const f32x4 h0 = (x0 - mu[rg]) * rsd[rg] * ga0 + be0, h1 = (x1 - mu[rg]) * rsd[rg] * ga1 + be1;
                u32x4 ah, al;
                ah.x = cvt_pk_bf16(h0[0], h0[1]); ah.y = cvt_pk_bf16(h0[2], h0[3]); ah.z = cvt_pk_bf16(h1[0], h1[1]); ah.w = cvt_pk_bf16(h1[2], h1[3]);
                *(u32x4*)(hl + (size_t)rg * 16 * DM + k0) = ah;
                al.x = cvt_pk_bf16(h0[0] - bflo(ah.x), h0[1] - bfhi(ah.x)); al.y = cvt_pk_bf16(h0[2] - bflo(ah.y), h0[3] - bfhi(ah.y));
                al.z = cvt_pk_bf16(h1[0] - bflo(ah.z), h1[1] - bfhi(ah.z)); al.w = cvt_pk_bf16(h1[2] - bflo(ah.w), h1[3] - bfhi(ah.w));
                const bf16x8 Ah = __builtin_bit_cast(bf16x8, ah), Al = __builtin_bit_cast(bf16x8, al);
#pragma unroll
                for (int nb = 0; nb < 5; ++nb) { acc[rg][nb] = __builtin_amdgcn_mfma_f32_16x16x32_bf16(Ah, Bh[nb], acc[rg][nb], 0, 0, 0); acc[rg][nb] = __builtin_amdgcn_mfma_f32_16x16x32_bf16(Al, Bh[nb], acc[rg][nb], 0, 0, 0); acc[rg][nb] = __builtin_amdgcn_mfma_f32_16x16x32_bf16(Ah, Bl[nb], acc[rg][nb], 0, 0, 0); } }
#pragma unroll
            for (int rg = 0; rg < 4; ++rg) xv[rg] = xn[rg];
        }
        PSTAMP(15);
        if (wid < 4) {
#pragma unroll
            for (int rg = 0; rg < 4; ++rg)
#pragma unroll
                for (int nb = 0; nb < 5; ++nb)
#pragma unroll
                    for (int r = 0; r < 4; ++r) slab[(wid * 64 + rg * 16 + 4 * kg + r) * 80 + nb * 16 + fr] = acc[rg][nb][r]; }
        __syncthreads();
        if (wid >= 4) {
#pragma unroll
            for (int rg = 0; rg < 4; ++rg)
#pragma unroll
                for (int nb = 0; nb < 5; ++nb)
#pragma unroll
                    for (int r = 0; r < 4; ++r) slab[((wid - 4) * 64 + rg * 16 + 4 * kg + r) * 80 + nb * 16 + fr] += acc[rg][nb][r]; }
        __syncthreads();
        for (int idx = tid; idx < 64 * 80; idx += 512) lgs[idx] = (slab[idx] + slab[64 * 80 + idx]) + (slab[2 * 64 * 80 + idx] + slab[3 * 64 * 80 + idx]);
        __syncthreads();
        if (tid < 64) { const int m = m0 + tid;
            const float* gb = F.in[16]; const float* eb = F.in[18];
            float gl[8]; int grp = 0; float gmax = -INFINITY;
#pragma unroll
            for (int i = 0; i < 8; ++i) { gl[i] = lgs[tid * 80 + i] + gb[i]; if (gl[i] > gmax) { gmax = gl[i]; grp = i; } }
            float gs = 0.f;
#pragma unroll
            for (int i = 0; i < 8; ++i) gs += __expf(gl[i] - gmax);
            const float ggate = 1.f / gs;
            float el[8];
#pragma unroll
            for (int i = 0; i < 8; ++i) el[i] = lgs[tid * 80 + 8 + grp * 8 + i] + eb[grp * 8 + i];
            int i0 = 0; float v0 = -INFINITY;
#pragma unroll
            for (int i = 0; i < 8; ++i) if (el[i] > v0) { v0 = el[i]; i0 = i; }
            int i1 = 0; float v1 = -INFINITY;
#pragma unroll
            for (int i = 0; i < 8; ++i) if (i != i0 && el[i] > v1) { v1 = el[i]; i1 = i; }
            const float e1 = __expf(v1 - v0), w0 = ggate / (1.f + e1), w1 = ggate * e1 / (1.f + e1);
            const int ea = grp * 8 + i0, ebx = grp * 8 + i1;
            const unsigned pa = __hip_atomic_fetch_add(ctl + CW_CNT + 16 * ea, 1u, RLX_AGENT), pb = __hip_atomic_fetch_add(ctl + CW_CNT + 16 * ebx, 1u, RLX_AGENT);
            int* elist = WSP(int, WS_ELIST); float* ewt = WSP(float, WS_EWT);
            elist[(size_t)ea * NT + pa] = m * 2; ewt[(size_t)ea * NT + pa] = w0; elist[(size_t)ebx * NT + pb] = m * 2 + 1; ewt[(size_t)ebx * NT + pb] = w1; }
        __syncthreads();
        PSTAMP(16);
    }
}
__device__ __forceinline__ int expert_tables(Frame& F, unsigned* ctl, MoeTab& T) {
    LAS int* tb = (LAS int*)(F.lds + TAB_OFF + 256); LAS int* cn = tb + 64; LAS int* texp = cn + 64; LAS int* ntl = texp + 200;
    __syncthreads();
    if (F.tid < 64) { const int e = F.tid; const int c = (int)__hip_atomic_load(ctl + CW_CNT + 16 * e, RLX_AGENT); const int nt = (c + 255) >> 8;
        int pre = nt;
#pragma unroll
        for (int o = 1; o < 64; o <<= 1) { const int x = __shfl_up(pre, o); if (e >= o) pre += x; }
        const int base = pre - nt; tb[e] = base; cn[e] = c;
        for (int i = 0; i < nt; ++i) texp[base + i] = e;
        if (e == 63) ntl[0] = pre; }
    __syncthreads();
    T.texp = texp; T.tb = tb; T.cn = cn; T.elist = WSP(const int, WS_ELIST); T.ewt = WSP(const float, WS_EWT);
    return ntl[0];
}
__device__ __forceinline__ void p11_final(Frame& F) {
    const int gw = F.vcu * 8 + F.wave, NGW = F.G * 8, lane = F.lane;
    const float* g2 = F.in[22]; const float* b2 = F.in[23];
    const bf16_t* H1B = WSP(bf16_t, WS_H1B); const bf16_t* YB = WSP(bf16_t, WS_YB); float* out = F.out;
    for (int mp = gw * 2; mp < NT; mp += NGW * 2) {
        f32x4 v[2][8]; float mu[2], rs[2];
#pragma unroll
        for (int rr = 0; rr < 2; ++rr) { const int m = mp + rr;
            const bf16_t* hr = H1B + (size_t)m * DM; const bf16_t* y0 = YB + (size_t)(2 * m) * DM; const bf16_t* y1 = y0 + DM;
#pragma unroll
            for (int j = 0; j < 4; ++j) { const int c = j * 512 + lane * 8; f32x4 a0, a1, c0, c1, h0, h1; load8(y0 + c, a0, a1); load8(y1 + c, c0, c1); load8(hr + c, h0, h1);
                v[rr][2 * j] = h0 * DN_ALPHA + (a0 + c0); v[rr][2 * j + 1] = h1 * DN_ALPHA + (a1 + c1); } }
#pragma unroll
        for (int rr = 0; rr < 2; ++rr) { float s = 0.f;
#pragma unroll
            for (int j = 0; j < 8; ++j) s += (v[rr][j][0] + v[rr][j][1]) + (v[rr][j][2] + v[rr][j][3]);
            mu[rr] = wave_sum(s) * (1.f / DM); float q = 0.f;
#pragma unroll
            for (int j = 0; j < 8; ++j) { v[rr][j] = v[rr][j] - mu[rr]; q += (v[rr][j][0] * v[rr][j][0] + v[rr][j][1] * v[rr][j][1]) + (v[rr][j][2] * v[rr][j][2] + v[rr][j][3] * v[rr][j][3]); }
            rs[rr] = 1.f / sqrtf(wave_sum(q) * (1.f / DM) + LN_EPS); }
#pragma unroll
        for (int rr = 0; rr < 2; ++rr) { const int m = mp + rr;
#pragma unroll
            for (int j = 0; j < 4; ++j) { const int c = j * 512 + lane * 8;
                *(f32x4*)(out + (size_t)m * DM + c) = v[rr][2 * j] * rs[rr] * *(const f32x4*)(g2 + c) + *(const f32x4*)(b2 + c);
                *(f32x4*)(out + (size_t)m * DM + c + 4) = v[rr][2 * j + 1] * rs[rr] * *(const f32x4*)(g2 + c + 4) + *(const f32x4*)(b2 + c + 4); } }
    }
}

__global__ void __launch_bounds__(512, 2) mk_fwd(Args args) {
    extern __shared__ __attribute__((aligned(16))) unsigned char lds_raw[];
    Frame F;
    F.lds = (LAS unsigned char*)lds_raw; F.ws = args.ws; F.in = args.in; F.out = args.out;
    F.tid = threadIdx.x; F.lane = F.tid & 63; F.wave = __builtin_amdgcn_readfirstlane(F.tid >> 6);
    F.G = gridDim.x; { const int bx = blockIdx.x; F.vcu = (F.G % 8 == 0) ? (bx % 8) * (F.G / 8) + bx / 8 : bx; }
    unsigned* ctl = (unsigned*)(args.ws + WS_CTL);
    volatile LAS unsigned* MISC = (volatile LAS unsigned*)(F.lds + MISC_OFF);
    if (F.tid < 32) MISC[F.tid] = 0u;
    __syncthreads();
    const int lo = args.ph_lo, hi = args.ph_hi;
    const bool multi = (hi - lo) > 1;
    XcdBarrier bar; bar.bar = ctl + CW_BAR; bar.x = 0; bar.st = MISC + 8;
    if (multi) { bar = xcd_barrier_post(ctl + CW_BAR, MISC + 8); if (F.tid == 0) { (void)xb_add(ctl + CW_GX + 16 * (F.vcu >> 5 & 7) + (int)bar.x, 1u); (void)xb_add(ctl + CW_GX + 16 * ((F.vcu & 3) == 0 ? 8 : 9) + (int)bar.x, 1u); } }
#ifndef PHASE_MASK
#define PHASE_MASK 0xFFF
#endif
#define IN(k) (((PHASE_MASK >> (k)) & 1) && lo <= (k) && (k) < hi)
#ifdef DBG_TIME
#ifndef DBG_TIME_B
#define DBG_TIME_B (DBG_TIME_A + 1)
#endif
#define STAMP(k) do { if (blockIdx.x == 0 && F.tid == 0) ((unsigned long long*)(args.ws + 131072))[k] = __builtin_amdgcn_s_memrealtime(); } while (0)
#else
#define STAMP(k) do {} while (0)
#endif
#ifndef MK_CG_FIRST
#define MK_CG_FIRST 0
#endif
#define SEAM(k) do { if (IN(k) && IN((k) + 1)) { if (MK_CG_FIRST && (k) == 0) { __threadfence(); cg::this_grid().sync(); } else xcd_barrier(bar); } STAMP((k) + 1); } while (0)
    LAS unsigned char* ring = F.lds;
#ifndef REPEAT_PHASE
#define REPEAT_PHASE -1
#endif
#define REPS(k) ((REPEAT_PHASE == (k)) ? 2 : 1)

    STAMP(0);
    if (IN(0)) { _Pragma("unroll 1") for (int rep_ = 0; rep_ < REPS(0); ++rep_) p0_prologue(F, !(multi && F.G == 256)); SEAM(0); }
    if (IN(1)) {
        pg8::Gemm g{DM, DM * 2, DM * 2}; RectSched S; S.init(NT, IN_PAD, F.G, (int)blockIdx.x, WSP(bf16_t, WS_XB), DM * 2, WSP(bf16_t, WS_WIN), DM * 2);
        EpiInProj E; E.U = WSP(bf16_t, WS_U); E.Q = WSP(bf16_t, WS_Q); E.KVb = WSP(bf16_t, WS_KC);
        E.GM = WSP(bf16_t, WS_GM); E.GN = WSP(float, WS_GN); E.rope = WSP(const f32x4, WS_ROPE);
        pg8::gemm_phase<EpiInProj, RectSched, true>(ring, g, S, E);
        if (REPS(1) == 2) { pg8::gemm_phase<EpiInProj, RectSched, true>(ring, g, S, E); }
        if (multi && F.G == 256 && (int)blockIdx.x >= 192) { __syncthreads(); p0_transposes(F, p0c::I_IN, p0c::I_IN + p0c::I_PP + p0c::I_NP + p0c::I_WO, ((int)blockIdx.x - 192) * 8 + F.wave, 64 * 8);
            p0_transposes(F, p0c::NSMALL, p0c::NSMALL + CONV_P1_ITEMS, ((int)blockIdx.x - 192) * 8 + F.wave, 64 * 8); }
        SEAM(1);
    }
    if (IN(2)) {
        const bool spread = multi && F.G == 256;
        const bool cmpwg = spread ? ((F.vcu & 3) == 0) : true;
        if (!spread || !cmpwg) p2_pool(F);
        __syncthreads(); PSTAMP1(17);
        if (cmpwg) {
            pg8::Gemm g{1024, 2048, 4096}; CmpSched S; S.vcu = F.vcu; S.G = F.G; S.A0 = (const char*)WSP(bf16_t, WS_KC); S.A1 = (const char*)WSP(bf16_t, WS_VC); S.B0 = (const char*)WSP(bf16_t, WS_CW1K); S.B1 = (const char*)WSP(bf16_t, WS_CW1V);
            EpiCmp1 E; E.P = WSP(float, WS_CMPP); E.bias = WSP(float, WS_CBIAS);
            pg8::gemm_phase<EpiCmp1, CmpSched, false>(ring, g, S, E); PSTAMP(20);
        }
        if (spread) {
            const bool leader = F.wave == 0 && F.lane == 0;
            if (cmpwg) { group_barrier_x(ctl, 16, 8, bar.x, 64u, leader); PSTAMP(21); p3_cmp2(F, F.vcu >> 2, 64); PSTAMP(22); }
            else { group_barrier_x(ctl, 17, 9, bar.x, 192u, leader); PSTAMP1(18);
                pg8::Gemm g{256, 2048, 512}; MixSched S; S.vcu = F.vcu - (F.vcu >> 2) - 1; S.G = 192; S.A = (const char*)WSP(bf16_t, WS_POOLED); S.B = (const char*)WSP(bf16_t, WS_PM);
                EpiMix E; E.out = WSP(bf16_t, WS_AO); E.scale = F.in[3];
                pg8::gemm_phase<EpiMix, MixSched, true>(ring, g, S, E); PSTAMP1(19);
                __syncthreads(); p0_transposes(F, p0c::NSMALL + CONV_P1_ITEMS, p0c::NSMALL + CONV_P1_ITEMS + CONV_P2_ITEMS, (F.vcu - (F.vcu >> 2) - 1) * 8 + F.wave, 192 * 8); }
            if (IN(4)) { xcd_barrier(bar); STAMP(3); STAMP(4); }
        } else SEAM(2);
    }
    if (IN(3) && !(multi && F.G == 256)) {
        pg8::Gemm g{256, 2048, 512}; MixSched S; S.vcu = F.vcu; S.G = F.G; S.A = (const char*)WSP(bf16_t, WS_POOLED); S.B = (const char*)WSP(bf16_t, WS_PM);
        EpiMix E; E.out = WSP(bf16_t, WS_AO); E.scale = F.in[3];
        pg8::gemm_phase<EpiMix, MixSched, true>(ring, g, S, E);
        p3_cmp2(F, F.vcu, F.G);
        SEAM(3);
    }
    if (IN(4)) {
        if (multi && F.G == 256) att::phase_dyn(F, ctl); else att::phase(F);
        SEAM(4);
    }
    if (IN(5)) {
        pg8::Gemm g{DM, DM * 2, DM * 2}; RectSched S; S.init(NT, DM, F.G, (int)blockIdx.x, WSP(bf16_t, WS_AO), DM * 2, WSP(bf16_t, WS_WPP), DM * 2);
        EpiZ2 E; E.Z = WSP(bf16_t, WS_Z); E.GM = WSP(bf16_t, WS_GM);
        pg8::gemm_phase<EpiZ2, RectSched, true>(ring, g, S, E);
        if (REPS(5) == 2) { pg8::gemm_phase<EpiZ2, RectSched, true>(ring, g, S, E); }
        if (multi && F.G == 256 && IN(6)) { group_barrier_x(ctl, F.vcu >> 5, F.vcu >> 5, bar.x, 32u, F.wave == 0 && F.lane == 0); STAMP(6); } else SEAM(5);
    }
    if (IN(6)) {
        pg8::Gemm g{DM, DM * 2, DM * 2}; RectSched S; S.init(NT, DM, F.G, (int)blockIdx.x, WSP(bf16_t, WS_Z), DM * 2, WSP(bf16_t, WS_WO), DM * 2);
        EpiV1 E; E.V1B = WSP(bf16_t, WS_V1B); E.x = WSP(const bf16_t, WS_XB); E.PS = WSP(float, WS_PS);
        _Pragma("unroll 1") for (int rep_ = 0; rep_ < REPS(6); ++rep_) pg8::gemm_phase<EpiV1, RectSched, true>(ring, g, S, E);
        if (multi && F.G == 256 && IN(7)) { group_barrier_x(ctl, 8 + (F.vcu >> 5), F.vcu >> 5, bar.x, 32u, F.wave == 0 && F.lane == 0); STAMP(7); } else SEAM(6);
    }
    if (IN(7)) { p7_router(F, ctl); if (IN(9)) { xcd_barrier(bar); STAMP(8); STAMP(9); } }
#ifndef KD9B
#define KD9B 3
#endif
    if (IN(9)) {
        MoeTab T; const int ntile = expert_tables(F, ctl, T);
        const int nU = 4 * ntile, nD = 8 * ntile, RA = multi ? ((nU + F.G - 1) / F.G - 1) : (nU + F.G - 1) / F.G, nA = RA * F.G < nU ? RA * F.G : nU;
        pg8::Gemm gu{DM, DM * 2, DM * 2}, gd{EH, EH * 2, EH * 2};
        MoeGatherSched<4, 1024> S; S.A = (const char*)WSP(bf16_t, WS_H1B); S.B = (const char*)WSP(bf16_t, WS_WGU); S.lda = DM * 2; S.ldb = DM * 2; S.T = T;
        EpiUp E; E.HID = WSP(bf16_t, WS_HID);
        S.v = F.vcu; S.Gp = F.G; S.L0 = 0; S.L1 = nA;
        pg8::gemm_phase<EpiUp, MoeGatherSched<4, 1024>, true, true>(ring, gu, S, E);
        if (REPS(9) == 2) { pg8::gemm_phase<EpiUp, MoeGatherSched<4, 1024>, true, true>(ring, gu, S, E); }
        if (multi && nA < nU) {
            xcd_barrier(bar);
            const int nrem = nU - nA, Gp2 = F.G - nrem, cap = (8 * (nA / 4) < nD) ? 8 * (nA / 4) : nD; int nB1 = KD9B * Gp2; if (nB1 > cap) nB1 = cap; if (nB1 < 0) nB1 = 0; int nB = nB1 + nrem; if (nB > cap) nB = cap;
            S.v = F.vcu; S.Gp = F.G; S.L0 = nA; S.L1 = nU;
            pg8::gemm_phase<EpiUp, MoeGatherSched<4, 1024>, true, true>(ring, gu, S, E);
            MoeSched<8, 2048> D; D.A = (const char*)WSP(bf16_t, WS_HID); D.B = (const char*)WSP(bf16_t, WS_WD); D.lda = EH * 2; D.ldb = EH * 2; D.T = T;
            if (F.vcu >= nrem) { D.v = F.vcu - nrem; D.Gp = Gp2; D.L0 = 0; D.L1 = nB1; } else { D.v = F.vcu; D.Gp = nrem; D.L0 = nB1; D.L1 = nB; }
            EpiDown ED; ED.YB = WSP(bf16_t, WS_YB); ED.T = T;
            pg8::gemm_phase<EpiDown, MoeSched<8, 2048>, true>(ring, gd, D, ED);
        }
        SEAM(9);
    }
    if (IN(10)) {
        MoeTab T; const int ntile = expert_tables(F, ctl, T);
        const int nU = 4 * ntile, nD = 8 * ntile, RA = multi ? ((nU + F.G - 1) / F.G - 1) : (nU + F.G - 1) / F.G, nA = RA * F.G < nU ? RA * F.G : nU;
        int nB = 0; if (multi && nA < nU) { const int nrem = nU - nA, Gp2 = F.G - nrem, cap = (8 * (nA / 4) < nD) ? 8 * (nA / 4) : nD; int nB1 = KD9B * Gp2; if (nB1 > cap) nB1 = cap; if (nB1 < 0) nB1 = 0; nB = nB1 + nrem; if (nB > cap) nB = cap; }
        pg8::Gemm g{EH, EH * 2, EH * 2}; MoeSched<8, 2048> S; S.v = F.vcu; S.Gp = F.G; S.L0 = nB; S.L1 = nD; S.A = (const char*)WSP(bf16_t, WS_HID); S.B = (const char*)WSP(bf16_t, WS_WD); S.lda = EH * 2; S.ldb = EH * 2; S.T = T;
        EpiDown E; E.YB = WSP(bf16_t, WS_YB); E.T = T;
        pg8::gemm_phase<EpiDown, MoeSched<8, 2048>, true>(ring, g, S, E);
        if (REPS(10) == 2) { pg8::gemm_phase<EpiDown, MoeSched<8, 2048>, true>(ring, g, S, E); }
        SEAM(10);
    }
    if (IN(11)) { p11_final(F); }
#ifdef DBG_TIME
    xcd_barrier(bar); STAMP(12);
    xcd_barrier(bar);
    { unsigned* mark = (unsigned*)(args.ws + WS_END + 4096);
      const bool fresh = __hip_atomic_load(mark, RLX_AGENT) == 0xAAAAAAAAu;
      const unsigned long long* st_ = (const unsigned long long*)(args.ws + 131072);
      const float ta = (float)(__hip_atomic_load(st_ + DBG_TIME_B, RLX_AGENT) - __hip_atomic_load(st_ + DBG_TIME_A, RLX_AGENT)) * 0.01f;
      const float v = fresh ? ta : 1.0f;
      for (size_t i = (size_t)blockIdx.x * 512 + F.tid; i < (size_t)NT * DM; i += (size_t)F.G * 512) F.out[i] = v;
      xcd_barrier(bar);
      if (blockIdx.x == 0 && F.tid == 0) __hip_atomic_store(mark, 0x12345678u, RLX_AGENT); }
#endif
#undef IN
#undef SEAM
}


#ifdef DBG_DUMP
__global__ void __launch_bounds__(512) dbg_dump(const unsigned char* ws, float* out) {
    const bf16_t* src = (const bf16_t*)(ws + (size_t)DBG_OFF);
    for (size_t i = (size_t)blockIdx.x * 512 + threadIdx.x; i < (size_t)NT * DM; i += (size_t)gridDim.x * 512) { const size_t m = i / DM, c = i % DM; out[i] = bf2f(src[(m % DBG_ROWS) * DBG_LD + (c % DBG_COLS)]); }
}
#endif

#ifdef DBG_CHECK
__global__ void __launch_bounds__(256) dbg_check(const float* x, const float* w_in, const unsigned char* ws, unsigned* errbits) {
    const int s = blockIdx.x * 256 + threadIdx.x;
    unsigned h = (unsigned)s * 2654435761u; h ^= h >> 15; h *= 2246822519u; h ^= h >> 13;
    const int m = h % NT; const int c = (h >> 14) % 4096;
    float acc = 0.f, accu = 0.f; const int cu = c % 1024;
    for (int k = 0; k < DM; ++k) { const float xv = x[(size_t)m * DM + k]; acc += xv * w_in[(size_t)k * IN_COLS + 3632 + c]; accu += xv * w_in[(size_t)k * IN_COLS + cu]; }
    const float ref = 1.f / (1.f + __expf(-acc));
    const float got = bf2f(((const bf16_t*)(ws + WS_GM))[(size_t)m * 4096 + c]);
    const float gotu = bf2f(((const bf16_t*)(ws + WS_U))[(size_t)m * PW + cu]);
    const float e = fabsf(got - ref), eu = fabsf(gotu - accu);
#if DBG_CHECK == 1
    if (!(eu < 0.06f)) atomicAdd(errbits, 1u);
#elif DBG_CHECK == 3
    { const int n = 3632 + c, k = (h >> 3) % DM; const float wv = w_in[(size_t)k * IN_COLS + n]; const float gw_ = bf2f(((const bf16_t*)(ws + WS_WIN))[(size_t)in_map(n) * DM + k]);
      if (!(fabsf(gw_ - wv) <= 0.01f * fabsf(wv) + 1e-6f)) atomicAdd(errbits, 1u); }
#else
    if (!(e < 0.02f)) atomicAdd(errbits, 1u);
#endif
}
__global__ void __launch_bounds__(512) dbg_fill(float* out, const unsigned* errbits) {
    const float v = 1.f + (float)(*errbits);
    for (size_t i = (size_t)blockIdx.x * 512 + threadIdx.x; i < (size_t)NT * DM; i += (size_t)gridDim.x * 512) out[i] = v;
}
#endif
extern "C" void kernel_launch(void* const* d_in, const int* in_sizes, int n_in, void* d_out, int out_size, void* d_ws, size_t ws_size, hipStream_t stream) {
    static int grid = 0;
    if (grid == 0) {
        if (n_in != 24 || out_size != NT * DM || ws_size < WS_END) { fprintf(stderr, "kernel_launch: unexpected problem (n_in %d, out %d, ws %zu < %zu)\n", n_in, out_size, ws_size, (size_t)WS_END); grid = -1; return; }
        int dev = 0, cus = 0, per_cu = 0;
        hipGetDevice(&dev); hipDeviceGetAttribute(&cus, hipDeviceAttributeMultiprocessorCount, dev);
        if (hipFuncSetAttribute((const void*)mk_fwd, hipFuncAttributeMaxDynamicSharedMemorySize, LDS_BYTES) != hipSuccess) { fprintf(stderr, "kernel_launch: hipFuncSetAttribute failed\n"); grid = -1; return; }
        if (hipOccupancyMaxActiveBlocksPerMultiprocessor(&per_cu, (const void*)mk_fwd, 512, LDS_BYTES) != hipSuccess || per_cu < 1) { fprintf(stderr, "kernel_launch: occupancy query says %d blocks per CU\n", per_cu); grid = -1; (void)hipGetLastError(); return; }
        grid = cus;
    }
    if (grid < 0) return;
    hipMemsetAsync((char*)d_ws + WS_CTL, 0, CTL_ZERO_BYTES, stream);
    Args a{};
    for (int i = 0; i < 24; ++i) a.in[i] = (const float*)d_in[i];
    a.out = (float*)d_out; a.ws = (unsigned char*)d_ws;
#if MK_PER_PHASE_LAUNCH
    for (int p = 0; p < DBG_NPH; ++p) { a.ph_lo = p; a.ph_hi = p + 1; hipLaunchKernelGGL(mk_fwd, dim3(grid), dim3(512), LDS_BYTES, stream, a); }
#ifdef DBG_CHECK
    hipMemsetAsync((char*)d_ws + 65536, 0, 4, stream);
    hipLaunchKernelGGL(dbg_check, dim3(16), dim3(256), 0, stream, (const float*)d_in[0], (const float*)d_in[1], (const unsigned char*)d_ws, (unsigned*)((char*)d_ws + 65536));
    hipLaunchKernelGGL(dbg_fill, dim3(1024), dim3(512), 0, stream, (float*)d_out, (const unsigned*)((char*)d_ws + 65536));
#endif
#ifdef DBG_DUMP
    hipLaunchKernelGGL(dbg_dump, dim3(1024), dim3(512), 0, stream, (const unsigned char*)d_ws, (float*)d_out);
#endif
#else
    a.ph_lo = 0; a.ph_hi = NPHASE;
    void* kargs[] = {&a};
    hipError_t e = hipLaunchCooperativeKernel((const void*)mk_fwd, dim3(grid), dim3(512), kargs, LDS_BYTES, stream);
    if (e != hipSuccess) fprintf(stderr, "kernel_launch: cooperative launch failed: %s (grid %d)\n", hipGetErrorString(e), grid);
#endif
}
```
